# Optimizing an MI355X kernel written in HIP

```python
import math
import jax, jax.numpy as jnp
from jax import lax
import numpy as np

D_MODEL = 2048
BATCH = 1
SEQ = 8192
DEPTH = 4

HEAD_DIM = 128
ROPE_THETA = 10000.0
NORM_EPS = 1e-6
D_FF = 4 * D_MODEL
N_MIX_HEADS = D_MODEL // HEAD_DIM
MOBA_HEADS = N_MIX_HEADS // 2
MOBA_BLOCK = 256
MOBA_TOPK = 3
SWA_HEADS = N_MIX_HEADS - MOBA_HEADS
SWA_KV_HEADS = 2
SWA_WINDOW = 128
FOX_HEADS = N_MIX_HEADS // 2
FOX_Q_BLOCK = 128
NSA_HEADS = N_MIX_HEADS - FOX_HEADS
NSA_KV_HEADS = 2
NSA_CMP_LEN = 32
NSA_CMP_STRIDE = 16
NSA_SLC_BLOCK = 64
NSA_SLC_TOPK = 16
NSA_WINDOW = 512
BAND_BLOCK = 128
Q_CHUNK = 64
NEG_INF = -1e30
N_EVEN = (DEPTH + 1) // 2
N_ODD = DEPTH // 2

EVEN_WIDTHS = (MOBA_HEADS * HEAD_DIM,) * 3 + (SWA_HEADS * HEAD_DIM, SWA_KV_HEADS * HEAD_DIM, SWA_KV_HEADS * HEAD_DIM)
ODD_WIDTHS = ((FOX_HEADS * HEAD_DIM,) * 3 + (FOX_HEADS, NSA_HEADS * HEAD_DIM)
              + (NSA_KV_HEADS * HEAD_DIM,) * 6 + (NSA_HEADS * 3,))
EVEN_IN = sum(EVEN_WIDTHS)
ODD_IN = sum(ODD_WIDTHS)
MIX_OUT = N_MIX_HEADS * HEAD_DIM

kernel_name = 'hybrid_moba_swa_fox_nsa_trunk'


def rms_norm(x, g):
    xf = x.astype(jnp.float32)
    y = xf * lax.rsqrt(jnp.mean(xf * xf, axis=-1, keepdims=True) + NORM_EPS)
    return (y * g.astype(jnp.float32)).astype(x.dtype)


def rope_tables(seq, dim):
    inv = 1.0 / (ROPE_THETA ** (jnp.arange(0, dim, 2, dtype=jnp.float32) / dim))
    ang = jnp.arange(seq, dtype=jnp.float32)[:, None] * inv[None, :]
    return jnp.cos(ang), jnp.sin(ang)


def apply_rope(x, cos, sin):
    x1, x2 = jnp.split(x.astype(jnp.float32), 2, axis=-1)
    c = cos[None, :, None, :]
    s = sin[None, :, None, :]
    return jnp.concatenate([x1 * c - x2 * s, x1 * s + x2 * c], axis=-1).astype(x.dtype)


def masked_softmax(s, mask):
    s = jnp.where(mask, s, NEG_INF)
    m = jnp.max(s, axis=-1, keepdims=True)
    p = jnp.where(mask, jnp.exp(s - m), 0.0)
    return p / jnp.maximum(jnp.sum(p, axis=-1, keepdims=True), 1e-30)


def split_cols(a, widths):
    cuts = [int(v) for v in np.cumsum(widths)[:-1]]
    return jnp.split(a, cuts, axis=-1)


def heads(a, n):
    return a.reshape(a.shape[0], a.shape[1], n, HEAD_DIM)


def banded_attention(q, k, v, window, sinks):
    B, S, Hq, hd = q.shape
    Hkv = k.shape[2]
    G = Hq // Hkv
    nb = S // BAND_BLOCK
    n_prev = -(-(window - 1) // BAND_BLOCK)
    pad = n_prev * BAND_BLOCK

    def band(a):
        ap = jnp.pad(a, ((0, 0), (pad, 0), (0, 0), (0, 0))).reshape(B, nb + n_prev, BAND_BLOCK, Hkv, hd)
        return jnp.concatenate([ap[:, i:i + nb] for i in range(n_prev + 1)], axis=2)

    kb, vb = band(k), band(v)
    qb = q.reshape(B, nb, BAND_BLOCK, Hkv, G, hd)
    s = jnp.einsum('bnqhgd,bnkhd->bnhgqk', qb, kb, preferred_element_type=jnp.float32) * (hd ** -0.5)
    t = jnp.arange(nb)[:, None] * BAND_BLOCK + jnp.arange(BAND_BLOCK)[None, :]
    spos = (jnp.arange(nb)[:, None] - n_prev) * BAND_BLOCK + jnp.arange((n_prev + 1) * BAND_BLOCK)[None, :]
    mask = (spos[:, None, :] <= t[:, :, None]) & (spos[:, None, :] > t[:, :, None] - window) & (spos[:, None, :] >= 0)
    mask = mask[None, :, None, None]
    s = jnp.where(mask, s, NEG_INF)
    m = jnp.max(s, axis=-1, keepdims=True)
    if sinks is not None:
        sk = sinks.astype(jnp.float32).reshape(1, 1, Hkv, G, 1, 1)
        m = jnp.maximum(m, sk)
    p = jnp.where(mask, jnp.exp(s - m), 0.0)
    den = jnp.sum(p, axis=-1, keepdims=True)
    if sinks is not None:
        den = den + jnp.exp(sk - m)
    p = p / den
    o = jnp.einsum('bnhgqk,bnkhd->bnqhgd', p.astype(v.dtype), vb)
    return o.reshape(B, S, Hq, hd)


def moba_attention(q, k, v):
    B, S, H, hd = q.shape
    nb = -(-S // MOBA_BLOCK)
    sp = nb * MOBA_BLOCK
    kpad = jnp.pad(k, ((0, 0), (0, sp - S), (0, 0), (0, 0)))
    vpad = jnp.pad(v, ((0, 0), (0, sp - S), (0, 0), (0, 0)))
    kbt = kpad.reshape(B, nb, MOBA_BLOCK, H, hd).transpose(0, 3, 1, 2, 4)
    vbt = vpad.reshape(B, nb, MOBA_BLOCK, H, hd).transpose(0, 3, 1, 2, 4)
    kmean = jnp.mean(kbt.astype(jnp.float32), axis=3)
    topk = min(MOBA_TOPK, nb)
    scale = hd ** -0.5
    n_chunks = S // Q_CHUNK
    qc = q.reshape(B, n_chunks, Q_CHUNK, H, hd).transpose(1, 0, 2, 3, 4)
    bi = jnp.arange(B)[:, None, None, None]
    hi = jnp.arange(H)[None, None, :, None]
    blk = jnp.arange(nb)

    def step(args):
        ci, qi = args
        t = ci * Q_CHUNK + jnp.arange(Q_CHUNK)
        own = (ci * Q_CHUNK) // MOBA_BLOCK
        gate = jnp.einsum('bqhd,bhnd->bqhn', qi.astype(jnp.float32), kmean)
        gate = jnp.where(blk < own, gate, NEG_INF)
        _, idx = lax.top_k(gate, topk)
        valid = idx < own
        ks = kbt[bi, hi, idx]
        vs = vbt[bi, hi, idx]
        s_sel = jnp.einsum('bqhd,bqhnkd->bqhnk', qi, ks, preferred_element_type=jnp.float32) * scale
        s_sel = jnp.where(valid[..., None], s_sel, NEG_INF).reshape(B, Q_CHUNK, H, topk * MOBA_BLOCK)
        ko = lax.dynamic_slice_in_dim(kpad, own * MOBA_BLOCK, MOBA_BLOCK, axis=1)
        vo = lax.dynamic_slice_in_dim(vpad, own * MOBA_BLOCK, MOBA_BLOCK, axis=1)
        s_own = jnp.einsum('bqhd,bkhd->bqhk', qi, ko, preferred_element_type=jnp.float32) * scale
        kpos = own * MOBA_BLOCK + jnp.arange(MOBA_BLOCK)
        s_own = jnp.where((kpos[None, :] <= t[:, None])[None, :, None, :], s_own, NEG_INF)
        p = jax.nn.softmax(jnp.concatenate([s_sel, s_own], axis=-1), axis=-1)
        p_sel = p[..., :topk * MOBA_BLOCK].reshape(B, Q_CHUNK, H, topk, MOBA_BLOCK).astype(v.dtype)
        p_own = p[..., topk * MOBA_BLOCK:].astype(v.dtype)
        return jnp.einsum('bqhnk,bqhnkd->bqhd', p_sel, vs) + jnp.einsum('bqhk,bkhd->bqhd', p_own, vo)

    o = lax.map(step, (jnp.arange(n_chunks), qc))
    return o.transpose(1, 0, 2, 3, 4).reshape(B, S, H, hd)


def forgetting_attention(q, k, v, log_f):
    B, S, H, hd = q.shape
    scale = hd ** -0.5
    cum = jnp.cumsum(log_f, axis=1).transpose(0, 2, 1)
    n_blk = S // FOX_Q_BLOCK
    qb = q.reshape(B, n_blk, FOX_Q_BLOCK, H, hd).transpose(1, 0, 2, 3, 4)
    kpos = jnp.arange(S)

    def step(args):
        bi, qi = args
        t = bi * FOX_Q_BLOCK + jnp.arange(FOX_Q_BLOCK)
        cq = lax.dynamic_slice_in_dim(cum, bi * FOX_Q_BLOCK, FOX_Q_BLOCK, axis=2)
        s = jnp.einsum('bqhd,bkhd->bhqk', qi, k, preferred_element_type=jnp.float32) * scale
        s = s + cq[..., :, None] - cum[..., None, :]
        p = masked_softmax(s, kpos[None, :] <= t[:, None])
        return jnp.einsum('bhqk,bkhd->bqhd', p.astype(v.dtype), v)

    o = lax.map(step, (jnp.arange(n_blk), qb))
    return o.transpose(1, 0, 2, 3, 4).reshape(B, S, H, hd)


def nsa_compress(a, pos, w1, w2):
    B, S, H, hd = a.shape
    n_cmp = (S - NSA_CMP_LEN) // NSA_CMP_STRIDE + 1
    idx = jnp.arange(n_cmp)[:, None] * NSA_CMP_STRIDE + jnp.arange(NSA_CMP_LEN)[None, :]
    blocks = a[:, idx] + pos[:, None, :]
    flat = blocks.transpose(0, 1, 3, 2, 4).reshape(B, n_cmp, H, NSA_CMP_LEN * hd)
    return jax.nn.gelu(flat @ w1) @ w2


def nsa_compressed_selected(q, k_cmp, v_cmp, k_slc, v_slc):
    B, S, Hq, hd = q.shape
    Hkv = k_slc.shape[2]
    G = Hq // Hkv
    n_cmp = k_cmp.shape[1]
    n_slc = S // NSA_SLC_BLOCK
    topk = min(NSA_SLC_TOPK, n_slc)
    scale = hd ** -0.5
    cmp_end = jnp.arange(n_cmp) * NSA_CMP_STRIDE + NSA_CMP_LEN - 1
    c_start = jnp.arange(n_cmp)[:, None] * NSA_CMP_STRIDE
    s_start = jnp.arange(n_slc)[None, :] * NSA_SLC_BLOCK
    overlap = ((c_start < s_start + NSA_SLC_BLOCK) & (c_start + NSA_CMP_LEN > s_start)).astype(jnp.float32)
    ksb = k_slc.reshape(B, n_slc, NSA_SLC_BLOCK, Hkv, hd).transpose(0, 3, 1, 2, 4)
    vsb = v_slc.reshape(B, n_slc, NSA_SLC_BLOCK, Hkv, hd).transpose(0, 3, 1, 2, 4)
    bi = jnp.arange(B)[:, None, None, None]
    hi = jnp.arange(Hkv)[None, :, None, None]
    blk = jnp.arange(n_slc)
    n_chunks = S // Q_CHUNK
    qc = q.reshape(B, n_chunks, Q_CHUNK, Hkv, G, hd).transpose(1, 0, 2, 3, 4, 5)

    def step(args):
        ci, qi = args
        t = ci * Q_CHUNK + jnp.arange(Q_CHUNK)
        s_c = jnp.einsum('bqhgd,bnhd->bhgqn', qi, k_cmp, preferred_element_type=jnp.float32) * scale
        p_c = masked_softmax(s_c, cmp_end[None, :] <= t[:, None])
        o_c = jnp.einsum('bhgqn,bnhd->bqhgd', p_c.astype(v_cmp.dtype), v_cmp)
        imp = jnp.einsum('bhgqn,nj->bhqj', p_c, overlap)
        cur = (t // NSA_SLC_BLOCK)[:, None]
        forced = (blk == 0) | (blk == cur) | (blk == cur - 1)
        imp = jnp.where(forced, jnp.inf, imp)
        imp = jnp.where(blk > cur, -jnp.inf, imp)
        _, sel = lax.top_k(imp, topk)
        ks = ksb[bi, hi, sel]
        vs = vsb[bi, hi, sel]
        s_s = jnp.einsum('bqhgd,bhqnkd->bhgqnk', qi, ks, preferred_element_type=jnp.float32) * scale
        kpos = sel[..., None] * NSA_SLC_BLOCK + jnp.arange(NSA_SLC_BLOCK)
        m_s = (kpos <= t[:, None, None])[:, :, None]
        p_s = masked_softmax(s_s.reshape(B, Hkv, G, Q_CHUNK, topk * NSA_SLC_BLOCK),
                             m_s.reshape(B, Hkv, 1, Q_CHUNK, topk * NSA_SLC_BLOCK)).reshape(s_s.shape)
        o_s = jnp.einsum('bhgqnk,bhqnkd->bqhgd', p_s.astype(vs.dtype), vs)
        return o_c, o_s

    o_c, o_s = lax.map(step, (jnp.arange(n_chunks), qc))
    back = lambda o: o.transpose(1, 0, 2, 3, 4, 5).reshape(B, S, Hq, hd)
    return back(o_c), back(o_s)


def even_mixer(h, w_in, sinks, w_out, cos, sin):
    B, S, _ = h.shape
    qa, ka, va, qb, kb, vb = split_cols(h @ w_in, EVEN_WIDTHS)
    qa = apply_rope(heads(qa, MOBA_HEADS), cos, sin)
    ka = apply_rope(heads(ka, MOBA_HEADS), cos, sin)
    qb = apply_rope(heads(qb, SWA_HEADS), cos, sin)
    kb = apply_rope(heads(kb, SWA_KV_HEADS), cos, sin)
    oa = moba_attention(qa, ka, heads(va, MOBA_HEADS))
    ob = banded_attention(qb, kb, heads(vb, SWA_KV_HEADS), SWA_WINDOW, sinks)
    o = jnp.concatenate([oa.reshape(B, S, -1), ob.reshape(B, S, -1)], axis=-1)
    return o @ w_out


def odd_mixer(h, w_in, forget_b, k_pos, k_w1, k_w2, v_pos, v_w1, v_w2, w_out, cos, sin):
    B, S, _ = h.shape
    qc, kc, vc, fc, qd, kcmp, vcmp, kslc, vslc, kwin, vwin, gd = split_cols(h @ w_in, ODD_WIDTHS)
    log_f = jax.nn.log_sigmoid(fc.astype(jnp.float32) + forget_b.astype(jnp.float32))
    oc = forgetting_attention(heads(qc, FOX_HEADS), heads(kc, FOX_HEADS), heads(vc, FOX_HEADS), log_f)
    qd = apply_rope(heads(qd, NSA_HEADS), cos, sin)
    k_c = nsa_compress(apply_rope(heads(kcmp, NSA_KV_HEADS), cos, sin), k_pos, k_w1, k_w2)
    v_c = nsa_compress(heads(vcmp, NSA_KV_HEADS), v_pos, v_w1, v_w2)
    o_cmp, o_slc = nsa_compressed_selected(qd, k_c, v_c,
                                           apply_rope(heads(kslc, NSA_KV_HEADS), cos, sin),
                                           heads(vslc, NSA_KV_HEADS))
    o_win = banded_attention(qd, apply_rope(heads(kwin, NSA_KV_HEADS), cos, sin),
                             heads(vwin, NSA_KV_HEADS), NSA_WINDOW, None)
    g = jax.nn.sigmoid(gd.reshape(B, S, NSA_HEADS, 3).astype(jnp.float32)).astype(qd.dtype)
    od = g[..., 0:1] * o_cmp + g[..., 1:2] * o_slc + g[..., 2:3] * o_win
    o = jnp.concatenate([oc.reshape(B, S, -1), od.reshape(B, S, -1)], axis=-1)
    return o @ w_out


def setup_inputs(seed: int = 0) -> dict:
    key = jax.random.key(seed)
    ks = jax.random.split(key, 21)
    nrm = lambda k, shape, scale: jax.random.normal(k, shape, jnp.float32) * scale
    L, hd = NSA_CMP_LEN, HEAD_DIM
    return {
        'x': nrm(ks[0], (BATCH, SEQ, D_MODEL), 1.0),
        'c': nrm(ks[1], (BATCH, D_MODEL), 1.0),
        'norm_mix_g': 1.0 + nrm(ks[2], (DEPTH, D_MODEL), 0.02),
        'norm_mlp_g': 1.0 + nrm(ks[3], (DEPTH, D_MODEL), 0.02),
        'ada_w': nrm(ks[4], (DEPTH, D_MODEL, 6 * D_MODEL), 0.5 * D_MODEL ** -0.5),
        'ada_b': nrm(ks[5], (DEPTH, 6 * D_MODEL), 0.02),
        'mlp_up': nrm(ks[6], (DEPTH, D_MODEL, D_FF), D_MODEL ** -0.5),
        'mlp_down': nrm(ks[7], (DEPTH, D_FF, D_MODEL), D_FF ** -0.5),
        'even_w_in': nrm(ks[8], (N_EVEN, D_MODEL, EVEN_IN), D_MODEL ** -0.5),
        'even_sinks': nrm(ks[9], (N_EVEN, SWA_HEADS), 0.5),
        'even_w_out': nrm(ks[10], (N_EVEN, MIX_OUT, D_MODEL), MIX_OUT ** -0.5),
        'odd_w_in': nrm(ks[11], (N_ODD, D_MODEL, ODD_IN), D_MODEL ** -0.5),
        'fox_forget_b': 3.0 + nrm(ks[12], (N_ODD, FOX_HEADS), 0.5),
        'nsa_k_pos': nrm(ks[13], (N_ODD, L, hd), 0.1),
        'nsa_k_w1': nrm(ks[14], (N_ODD, L * hd, hd), (L * hd) ** -0.5),
        'nsa_k_w2': nrm(ks[15], (N_ODD, hd, hd), hd ** -0.5),
        'nsa_v_pos': nrm(ks[16], (N_ODD, L, hd), 0.1),
        'nsa_v_w1': nrm(ks[17], (N_ODD, L * hd, hd), (L * hd) ** -0.5),
        'nsa_v_w2': nrm(ks[18], (N_ODD, hd, hd), hd ** -0.5),
        'odd_w_out': nrm(ks[19], (N_ODD, MIX_OUT, D_MODEL), MIX_OUT ** -0.5),
        'final_norm_g': 1.0 + nrm(ks[20], (D_MODEL,), 0.02),
    }


def reference(x, c, norm_mix_g, norm_mlp_g, ada_w, ada_b, mlp_up, mlp_down, even_w_in, even_sinks,
              even_w_out, odd_w_in, fox_forget_b, nsa_k_pos, nsa_k_w1, nsa_k_w2, nsa_v_pos, nsa_v_w1,
              nsa_v_w2, odd_w_out, final_norm_g):
    S = x.shape[1]
    cos, sin = rope_tables(S, HEAD_DIM)
    cond = jax.nn.silu(c)
    for i in range(DEPTH):
        mod = cond @ ada_w[i] + ada_b[i]
        sh1, sc1, g1, sh2, sc2, g2 = [m[:, None, :] for m in jnp.split(mod, 6, axis=-1)]
        h = rms_norm(x, norm_mix_g[i]) * (1.0 + sc1) + sh1
        if i % 2 == 0:
            j = i // 2
            y = even_mixer(h, even_w_in[j], even_sinks[j], even_w_out[j], cos, sin)
        else:
            j = i // 2
            y = odd_mixer(h, odd_w_in[j], fox_forget_b[j], nsa_k_pos[j], nsa_k_w1[j], nsa_k_w2[j],
                          nsa_v_pos[j], nsa_v_w1[j], nsa_v_w2[j], odd_w_out[j], cos, sin)
        x = x + g1 * y
        h = rms_norm(x, norm_mlp_g[i]) * (1.0 + sc2) + sh2
        x = x + g2 * (jnp.square(jax.nn.relu(h @ mlp_up[i])) @ mlp_down[i])
    return rms_norm(x, final_norm_g)
```

```cpp
#include <hip/hip_runtime.h>
#include <hip/hip_bf16.h>
#include <cstdio>
#include <cstdint>
#include <cmath>
__device__ __forceinline__ int tid_fresh() { int t = threadIdx.x; asm volatile("" : "+v"(t)); return t; }
#ifndef CHECK
#define CHECK 0
#endif
#ifndef BREAK
#define BREAK 0
#endif
namespace pg8 {
#define PG8_LAS __attribute__((address_space(3)))
typedef unsigned short bf16_t;
typedef short bf16x8 __attribute__((ext_vector_type(8)));
typedef float f32x4 __attribute__((ext_vector_type(4)));
typedef unsigned u32x4 __attribute__((ext_vector_type(4)));
constexpr int BM = 256, BK = 64, HALF = 128, HTB = HALF * BK * 2  , STAGE_BYTES = 8 * HTB, NXCD = 8, WGM = 4;

__host__ __device__ __forceinline__ int lds_byte(int r, int c) { const int st = (r >> 4) * 2 + (c >> 5), rr = r & 15, cc = c & 31, ob = rr * 64 + cc * 2; return st * 1024 + (ob ^ (((ob >> 9) & 1) << 5)); }
__host__ __device__ __forceinline__ void stage_rc(int b, int& R, int& C) { const int st = b / 1024, sb = b % 1024, swz = sb ^ (((sb >> 9) & 1) << 5); R = (st >> 1) * 16 + swz / 64; C = (st & 1) * 32 + (swz % 64) / 2; }
__host__ __device__ __forceinline__ int perm32(int rho) { const int n = rho >> 4, i = rho & 15; return 8 * (i >> 2) + 4 * n + (i & 3); }

struct Unit { int pm, pn; };
struct Gemm { const bf16_t* A; const bf16_t* Bt; int M, N, K; };

struct StaticOrder {
    int nM, nN, nwg, G, c;
    __host__ __device__ void init(int M, int N, int G_, int c_) { nM = M / BM; nN = N / BM; nwg = nM * nN; G = G_; c = c_; }
    __host__ __device__ bool next(int i, Unit& u) const {
        const long L = (long)i * G + c; if (L >= nwg) return false;
        int wgid = (int)L; { const int q = nwg / NXCD, r = nwg % NXCD, xcd = wgid % NXCD, off = wgid / NXCD; wgid = (xcd < r ? xcd * (q + 1) : r * (q + 1) + (xcd - r) * q) + off; }
        const int nig = WGM * nN, gid = wgid / nig, fm = gid * WGM, gsz = (nM - fm) < WGM ? (nM - fm) : WGM;
        u.pm = fm + ((wgid % nig) % gsz); u.pn = (wgid % nig) / gsz; return true;
    }
    __device__ __forceinline__ void a_ready(const Unit&) const {}
    __device__ __forceinline__ void done(const Unit&) const {}
};

__device__ __forceinline__ unsigned cvt_pk_bf16(float lo, float hi) { unsigned r; asm volatile("v_cvt_pk_bf16_f32 %0, %1, %2" : "=v"(r) : "v"(lo), "v"(hi)); return r; }
typedef float f32x2 __attribute__((ext_vector_type(2)));


struct EpiIn {
    static constexpr bool PERM = true, AFTER_DRAIN = false;
    bf16_t* O; int ldc; float* FG; int odd; const PG8_LAS float* tab;
    __device__ __forceinline__ void operator()(const f32x4 (&acc)[2][2][4][2], const Unit& u, int ui, int wr, int wc, int fr, int fq) const {
        asm volatile("" : "+v"(fr), "+v"(fq));
        const int pn = u.pn;
        int mode;
        if (!odd) mode = (pn < 8 || (pn >= 12 && pn <= 16)) ? 1 : 0;
        else mode = (pn == 22) ? 2 : (((pn >= 12 && pn <= 16) || pn == 18 || pn == 20) ? 1 : 0);
        const int row0 = u.pm * BM + wr * 64 + fr;
        const int hh = wc >> 1, dd = (wc & 1) * 32 + 8 * fq;
        const int cl0 = hh * 128 + dd, col0 = pn * BM + cl0;
        const PG8_LAS float* tb = tab + ui * 512;
        if (mode == 2) {
            if (wc == 0) { const f32x4 bb0 = *(const PG8_LAS f32x4*)(tb + 256 + cl0), bb1 = *(const PG8_LAS f32x4*)(tb + 256 + cl0 + 4);
#pragma unroll
                for (int ai = 0; ai < 2; ++ai)
#pragma unroll
                    for (int m = 0; m < 4; ++m) { const int row = row0 + ai * HALF + m * 16; const float rs = tb[wr * 64 + fr + ai * HALF + m * 16]; float* p = FG + (size_t)(8 * fq) * 8192 + row;
                        const f32x4 v0 = acc[ai][0][m][0] * rs + bb0, v1 = acc[ai][0][m][1] * rs + bb1;
#pragma unroll
                        for (int e = 0; e < 4; ++e) { p[(size_t)e * 8192] = v0[e]; p[(size_t)(4 + e) * 8192] = v1[e]; } }
            }
            return;
        }
        const f32x4 ir0 = *(const PG8_LAS f32x4*)(tab + 2048 + dd), ir1 = *(const PG8_LAS f32x4*)(tab + 2048 + dd + 4);
        const f32x4 ba0 = *(const PG8_LAS f32x4*)(tb + 256 + cl0), ba1 = *(const PG8_LAS f32x4*)(tb + 256 + cl0 + 4), bb0 = *(const PG8_LAS f32x4*)(tb + 256 + cl0 + 64), bb1 = *(const PG8_LAS f32x4*)(tb + 256 + cl0 + 68);
#pragma unroll
        for (int ai = 0; ai < 2; ++ai)
#pragma unroll
            for (int m = 0; m < 4; ++m) { const int row = row0 + ai * HALF + m * 16; const float rs = tb[wr * 64 + fr + ai * HALF + m * 16];
                f32x4 a0 = acc[ai][0][m][0] * rs + ba0, a1 = acc[ai][0][m][1] * rs + ba1, b0 = acc[ai][1][m][0] * rs + bb0, b1 = acc[ai][1][m][1] * rs + bb1;
                if (mode == 1) {
                    const float tf = (float)row; f32x4 c0, c1, s0, s1;
#pragma unroll
                    for (int e = 0; e < 4; ++e) { float r0 = tf * ir0[e], r1 = tf * ir1[e]; r0 = __builtin_amdgcn_fractf(r0); r1 = __builtin_amdgcn_fractf(r1);
                        c0[e] = __builtin_amdgcn_cosf(r0); s0[e] = __builtin_amdgcn_sinf(r0); c1[e] = __builtin_amdgcn_cosf(r1); s1[e] = __builtin_amdgcn_sinf(r1); }
                    const f32x4 x0 = a0 * c0 - b0 * s0, x1 = a1 * c1 - b1 * s1, y0 = a0 * s0 + b0 * c0, y1 = a1 * s1 + b1 * c1;
                    a0 = x0; a1 = x1; b0 = y0; b1 = y1; }
                bf16_t* rowp = O + (size_t)row * ldc + col0;
                u32x4 w; w.x = cvt_pk_bf16(a0[0], a0[1]); w.y = cvt_pk_bf16(a0[2], a0[3]); w.z = cvt_pk_bf16(a1[0], a1[1]); w.w = cvt_pk_bf16(a1[2], a1[3]);
                *(u32x4*)rowp = w;
                u32x4 v; v.x = cvt_pk_bf16(b0[0], b0[1]); v.y = cvt_pk_bf16(b0[2], b0[3]); v.z = cvt_pk_bf16(b1[0], b1[1]); v.w = cvt_pk_bf16(b1[2], b1[3]);
                *(u32x4*)(rowp + 64) = v; }
    }
};
struct EpiRes {
    static constexpr bool PERM = true, AFTER_DRAIN = false;
    const float* base; float* out; int ldc; const float* gate; bf16_t* Hn  ; const float* An; float* ss;
    __device__ __forceinline__ void operator()(const f32x4 (&acc)[2][2][4][2], const Unit& u, int ui, int wr, int wc, int fr, int fq) const {
        asm volatile("" : "+v"(fr), "+v"(fq));
        const int row0 = u.pm * BM + wr * 64 + fr, col0 = u.pn * BM + wc * 32 + 8 * fq;
        f32x4 gv[2][2], av[2][2];
#pragma unroll
        for (int bj = 0; bj < 2; ++bj)
#pragma unroll
            for (int n = 0; n < 2; ++n) { gv[bj][n] = *(const f32x4*)(gate + col0 + bj * HALF + 4 * n); av[bj][n] = Hn ? *(const f32x4*)(An + col0 + bj * HALF + 4 * n) : (f32x4){0.f, 0.f, 0.f, 0.f}; }
#pragma unroll
        for (int ai = 0; ai < 2; ++ai)
#pragma unroll
            for (int m = 0; m < 4; ++m) { const int row = row0 + ai * HALF + m * 16; const size_t off = (size_t)row * ldc + col0; float sq = 0.f;
#pragma unroll
                for (int bj = 0; bj < 2; ++bj) { f32x4 x[2];
#pragma unroll
                    for (int n = 0; n < 2; ++n) { const f32x4 b = *(const f32x4*)(base + off + bj * HALF + 4 * n); x[n] = b + gv[bj][n] * acc[ai][bj][m][n];
                        *(f32x4*)(out + off + bj * HALF + 4 * n) = x[n]; sq += (x[n][0] * x[n][0] + x[n][1] * x[n][1]) + (x[n][2] * x[n][2] + x[n][3] * x[n][3]); }
                    if (Hn) { const f32x4 h0 = x[0] * av[bj][0], h1 = x[1] * av[bj][1];
                        u32x4 w; w.x = cvt_pk_bf16(h0[0], h0[1]); w.y = cvt_pk_bf16(h0[2], h0[3]); w.z = cvt_pk_bf16(h1[0], h1[1]); w.w = cvt_pk_bf16(h1[2], h1[3]);
                        *(u32x4*)(Hn + off + bj * HALF) = w; } }
                if (Hn) { sq += __shfl_xor(sq, 16); sq += __shfl_xor(sq, 32); if (fq == 0) ss[(size_t)row * 32 + u.pn * 4 + wc] = sq; } }
    }
};
struct EpiRelu2 {
    static constexpr bool PERM = true, AFTER_DRAIN = false;
    bf16_t* O; int ldc; const PG8_LAS float* tab;
    __device__ __forceinline__ void operator()(const f32x4 (&acc)[2][2][4][2], const Unit& u, int ui, int wr, int wc, int fr, int fq) const {
        asm volatile("" : "+v"(fr), "+v"(fq));
        const int row0 = u.pm * BM + wr * 64 + fr, col0 = u.pn * BM + wc * 32 + 8 * fq;
        const PG8_LAS float* tb = tab + ui * 512; const int cl0 = wc * 32 + 8 * fq;
        f32x4 bv[2][2];
#pragma unroll
        for (int bj = 0; bj < 2; ++bj)
#pragma unroll
            for (int n = 0; n < 2; ++n) bv[bj][n] = *(const PG8_LAS f32x4*)(tb + 256 + cl0 + bj * HALF + 4 * n);
#pragma unroll
        for (int ai = 0; ai < 2; ++ai)
#pragma unroll
            for (int m = 0; m < 4; ++m) { const int row = row0 + ai * HALF + m * 16; const float rs = tb[wr * 64 + fr + ai * HALF + m * 16]; bf16_t* rowp = O + (size_t)row * ldc + col0;
#pragma unroll
                for (int bj = 0; bj < 2; ++bj) { f32x4 v0 = acc[ai][bj][m][0] * rs + bv[bj][0], v1 = acc[ai][bj][m][1] * rs + bv[bj][1];
#pragma unroll
                    for (int e = 0; e < 4; ++e) { const float a = fmaxf(v0[e], 0.f), b = fmaxf(v1[e], 0.f); v0[e] = a * a; v1[e] = b * b; }
                    u32x4 w; w.x = cvt_pk_bf16(v0[0], v0[1]); w.y = cvt_pk_bf16(v0[2], v0[3]); w.z = cvt_pk_bf16(v1[0], v1[1]); w.w = cvt_pk_bf16(v1[2], v1[3]);
                    *(u32x4*)(rowp + bj * HALF) = w; } }
    }
};

struct MapOrder {
    StaticOrder b; int cut, shift;
    __device__ void init(int M, int nTiles, int G_, int c_, int cut_, int shift_) { b.init(M, nTiles * BM, G_, c_); cut = cut_; shift = shift_; }
    __device__ bool next(int i, Unit& u) const { if (!b.next(i, u)) return false; u.pn += (u.pn >= cut) ? shift : 0; return true; }
    __device__ __forceinline__ void a_ready(const Unit&) const {}
    __device__ __forceinline__ void done(const Unit&) const {}
};

template <class Sched>
__device__ __forceinline__ void epi_preload(const Sched& S, const float* ss, const float* bias, PG8_LAS float* tab) {
    const int tid = tid_fresh();
    if (tid < 64) tab[2048 + tid] = 0.15915494309189535f / powf(10000.f, (float)tid * (1.f / 64.f));
    Unit u;
    for (int i = 0; i < 4 && S.next(i, u); ++i) {
        if (tid < 256) { const float* sp = ss + (size_t)(u.pm * BM + tid) * 32; float t = 0.f;
#pragma unroll
            for (int q = 0; q < 8; ++q) { const f32x4 a = *(const f32x4*)(sp + 4 * q); t += (a[0] + a[1]) + (a[2] + a[3]); }
            tab[i * 512 + tid] = 1.f / sqrtf(t * (1.f / 2048.f) + 1e-6f); }
        else tab[i * 512 + tid] = bias[u.pn * BM + (tid - 256)];
    }
    __syncthreads();
}
template <class Epi, class Sched, bool ALIGN_EPI = false, bool SP2 = false>
__device__ __forceinline__ void gemm_phase(PG8_LAS unsigned char* lds, const Gemm g, const Sched& S, const Epi& E) {
    const int tid = tid_fresh(), wid = __builtin_amdgcn_readfirstlane(tid >> 6), lane = tid & 63, wr = wid >> 2, wc = wid & 3, fr = lane & 15, fq = lane >> 4;
    const int K = g.K, nt = K / BK;
    unsigned voffA[2], voffB[2];
#pragma unroll
    for (int i = 0; i < 2; ++i) { int R, C; stage_rc(tid * 16 + i * 8192, R, C); const int Rb = Epi::PERM ? ((R & ~31) + perm32(R & 31)) : R;
        voffA[i] = (unsigned)(R * K + C) * 2u; voffB[i] = (unsigned)(Rb * K + C) * 2u; }
    const size_t kstep = (size_t)(BK * 2);
    const size_t hstep = (size_t)HALF * K * 2;
    const size_t tstep = 2 * hstep;
    const unsigned ldsw = (unsigned)wid * 1024u;
    const int aoff = lds_byte(wr * 64 + fr, fq * 8), boff = lds_byte(wc * 32 + fr, fq * 8);
#define PG8_SA(b, h) (((b) * 2 + (h)) * HTB)
#define PG8_SB(b, h) ((4 + (b) * 2 + (h)) * HTB)
#define PG8_STAGE(bufoff, gbase, voff) do { _Pragma("unroll") for (int _i = 0; _i < 2; ++_i) \
        __builtin_amdgcn_global_load_lds((const unsigned*)((const char*)(gbase) + (voff)[_i]), (PG8_LAS unsigned*)(lds + (bufoff) + ldsw + _i * 8192), 16, 0, 0); } while (0)
#define PG8_LDA(dst, b, h) do { _Pragma("unroll") for (int m = 0; m < 4; ++m) _Pragma("unroll") for (int k = 0; k < 2; ++k) dst[m][k] = *(const PG8_LAS bf16x8*)(lds + PG8_SA(b, h) + aoff + m * 2048 + k * 1024); } while (0)
#define PG8_LDB(dst, b, h) do { _Pragma("unroll") for (int n = 0; n < 2; ++n) _Pragma("unroll") for (int k = 0; k < 2; ++k) dst[n][k] = *(const PG8_LAS bf16x8*)(lds + PG8_SB(b, h) + boff + n * 2048 + k * 1024); } while (0)
#define PG8_MMA(ai, bj, At, Bt) do { __builtin_amdgcn_s_setprio(1); _Pragma("unroll") for (int m = 0; m < 4; ++m) _Pragma("unroll") for (int n = 0; n < 2; ++n) _Pragma("unroll") for (int k = 0; k < 2; ++k) \
        acc[ai][bj][m][n] = __builtin_amdgcn_mfma_f32_16x16x32_bf16(Bt[n][k], At[m][k], acc[ai][bj][m][n], 0, 0, 0); __builtin_amdgcn_s_setprio(0); } while (0)
#define PG8_WAIT_V(n) asm volatile("s_waitcnt vmcnt(" #n ")" ::: "memory")
#define PG8_WAIT_L(n) asm volatile("s_waitcnt lgkmcnt(" #n ")" ::: "memory")
#define PG8_BAR __builtin_amdgcn_s_barrier()
#define PG8_SCHED __builtin_amdgcn_sched_barrier(0)
    Unit cur, nxt; int ui = 0;
    if (!S.next(0, cur)) return;
    f32x4 acc[2][2][4][2];
#pragma unroll
    for (int a = 0; a < 2; ++a)
#pragma unroll
        for (int b = 0; b < 2; ++b)
#pragma unroll
            for (int m = 0; m < 4; ++m)
#pragma unroll
                for (int n = 0; n < 2; ++n) acc[a][b][m][n] = (f32x4){0.f, 0.f, 0.f, 0.f};
    bf16x8 At[4][2], B0[2][2], B1[2][2];
    const char* cA = (const char*)g.A + (size_t)cur.pm * tstep; const char* cB = (const char*)g.Bt + (size_t)cur.pn * tstep;
    S.a_ready(cur);
    if constexpr (SP2) {
        PG8_STAGE(PG8_SB(0, 0), cB, voffB); PG8_STAGE(PG8_SB(0, 1), cB + hstep, voffB); PG8_STAGE(PG8_SA(0, 0), cA, voffA); PG8_STAGE(PG8_SA(0, 1), cA + hstep, voffA);
        if (wr == 1) PG8_BAR;
        PG8_WAIT_V(2); PG8_BAR;
        PG8_STAGE(PG8_SB(1, 0), cB + kstep, voffB); PG8_STAGE(PG8_SA(1, 0), cA + kstep, voffA); PG8_STAGE(PG8_SB(1, 1), cB + hstep + kstep, voffB);
        PG8_WAIT_V(6); PG8_BAR;
    } else {
        PG8_STAGE(PG8_SB(0, 0), cB, voffB); PG8_STAGE(PG8_SA(0, 0), cA, voffA); PG8_STAGE(PG8_SB(0, 1), cB + hstep, voffB); PG8_STAGE(PG8_SA(0, 1), cA + hstep, voffA);
        if (wr == 1) PG8_BAR;
        PG8_WAIT_V(4); PG8_BAR;
        PG8_STAGE(PG8_SB(1, 0), cB + kstep, voffB); PG8_STAGE(PG8_SA(1, 0), cA + kstep, voffA); PG8_STAGE(PG8_SB(1, 1), cB + hstep + kstep, voffB);
        PG8_WAIT_V(6); PG8_BAR;
    }
    for (;;) {
        const bool has_next = S.next(ui + 1, nxt);
        const char* nA = has_next ? (const char*)g.A + (size_t)nxt.pm * tstep : cA; const char* nB = has_next ? (const char*)g.Bt + (size_t)nxt.pn * tstep : cB;
        for (int t = 0; t < nt; t += 2) {
            const bool last = (t == nt - 2);
            const char* a1 = cA + (size_t)(t + 1) * kstep;
            const char* a2 = last ? nA : cA + (size_t)(t + 2) * kstep; const char* b2 = last ? nB : cB + (size_t)(t + 2) * kstep;
            const char* a3 = a2 + kstep; const char* b3 = b2 + kstep;
            if (last && has_next) S.a_ready(nxt);
            if constexpr (SP2) {
            PG8_LDB(B0, 0, 0); PG8_LDB(B1, 0, 1); PG8_SCHED; PG8_LDA(At, 0, 0); PG8_STAGE(PG8_SA(1, 1), a1 + hstep, voffA);
            PG8_WAIT_V(8); PG8_WAIT_L(0); PG8_BAR; PG8_MMA(0, 0, At, B0); PG8_MMA(0, 1, At, B1); PG8_BAR; PG8_SCHED;
            PG8_LDA(At, 0, 1); PG8_STAGE(PG8_SB(0, 0), b2, voffB); PG8_STAGE(PG8_SB(0, 1), b2 + hstep, voffB); PG8_STAGE(PG8_SA(0, 0), a2, voffA);
            PG8_WAIT_V(8); PG8_WAIT_L(0); PG8_BAR; PG8_MMA(1, 0, At, B0); PG8_MMA(1, 1, At, B1); PG8_BAR; PG8_SCHED;
            PG8_LDB(B0, 1, 0); PG8_LDB(B1, 1, 1); PG8_SCHED; PG8_LDA(At, 1, 0); PG8_STAGE(PG8_SA(0, 1), a2 + hstep, voffA);
            PG8_WAIT_V(8); PG8_WAIT_L(0); PG8_BAR; PG8_MMA(0, 0, At, B0); PG8_MMA(0, 1, At, B1); PG8_BAR; PG8_SCHED;
            PG8_LDA(At, 1, 1); PG8_STAGE(PG8_SB(1, 0), b3, voffB); PG8_STAGE(PG8_SB(1, 1), b3 + hstep, voffB); PG8_STAGE(PG8_SA(1, 0), a3, voffA);
            PG8_WAIT_V(8); PG8_WAIT_L(0); PG8_BAR; PG8_MMA(1, 0, At, B0); PG8_MMA(1, 1, At, B1); PG8_BAR; PG8_SCHED;
            } else {
            PG8_LDB(B0, 0, 0); PG8_SCHED; PG8_LDA(At, 0, 0); PG8_STAGE(PG8_SA(1, 1), a1 + hstep, voffA);
            PG8_WAIT_L(8); PG8_BAR; PG8_WAIT_L(0); PG8_MMA(0, 0, At, B0); PG8_BAR; PG8_SCHED;
            PG8_LDB(B1, 0, 1); PG8_STAGE(PG8_SB(0, 0), b2, voffB);
            PG8_BAR; PG8_WAIT_L(0); PG8_MMA(0, 1, At, B1); PG8_BAR;
            PG8_LDA(At, 0, 1); PG8_STAGE(PG8_SA(0, 0), a2, voffA);
            PG8_BAR; PG8_WAIT_L(0); PG8_MMA(1, 0, At, B0); PG8_BAR; PG8_SCHED;
            PG8_STAGE(PG8_SB(0, 1), b2 + hstep, voffB);
            PG8_WAIT_V(6); PG8_BAR; PG8_MMA(1, 1, At, B1); PG8_BAR;
            PG8_LDB(B0, 1, 0); PG8_SCHED; PG8_LDA(At, 1, 0); PG8_STAGE(PG8_SA(0, 1), a2 + hstep, voffA);
            PG8_WAIT_L(8); PG8_BAR; PG8_WAIT_L(0); PG8_MMA(0, 0, At, B0); PG8_BAR; PG8_SCHED;
            PG8_LDB(B1, 1, 1); PG8_STAGE(PG8_SB(1, 0), b3, voffB);
            PG8_BAR; PG8_WAIT_L(0); PG8_MMA(0, 1, At, B1); PG8_BAR;
            PG8_LDA(At, 1, 1); PG8_STAGE(PG8_SA(1, 0), a3, voffA);
            PG8_BAR; PG8_WAIT_L(0); PG8_MMA(1, 0, At, B0); PG8_BAR; PG8_SCHED;
            PG8_STAGE(PG8_SB(1, 1), b3 + hstep, voffB);
            PG8_WAIT_V(6); PG8_BAR; PG8_MMA(1, 1, At, B1); PG8_BAR;
            }
        }
        if constexpr (ALIGN_EPI) { if (wr == 0) PG8_BAR; }
        if constexpr (!Epi::AFTER_DRAIN) { E(acc, cur, ui, wr, wc, fr, fq); S.done(cur); }
        if (!has_next) break;
#pragma unroll
        for (int a = 0; a < 2; ++a)
#pragma unroll
            for (int b = 0; b < 2; ++b)
#pragma unroll
                for (int m = 0; m < 4; ++m)
#pragma unroll
                    for (int n = 0; n < 2; ++n) acc[a][b][m][n] = (f32x4){0.f, 0.f, 0.f, 0.f};
        cur = nxt; cA = nA; cB = nB; ++ui;
        if constexpr (ALIGN_EPI) { if (wr == 1) PG8_BAR; }
    }
    PG8_WAIT_V(0);
    if constexpr (!ALIGN_EPI) { if (wr == 0) PG8_BAR; }
    PG8_BAR;
    if constexpr (Epi::AFTER_DRAIN) { E.fused(acc, cur, wr, wc, fr, fq, lds, wid, lane); S.done(cur); }
#undef PG8_SA
#undef PG8_SB
#undef PG8_STAGE
#undef PG8_LDA
#undef PG8_LDB
#undef PG8_MMA
#undef PG8_WAIT_V
#undef PG8_WAIT_L
#undef PG8_BAR
#undef PG8_SCHED
}
}

constexpr int S = 8192, DM = 2048, HD = 128, DFF = 8192, DEPTH = 4;
constexpr int NE = 4608, NO = 5888, NO_SRC = 5664;
constexpr float NORM_EPS = 1e-6f;
constexpr int NWAVES = 8;
constexpr int E_QA = 0, E_KA = 1024, E_VA = 2048, E_QB = 3072, E_KB = 4096, E_VB = 4352;
constexpr int O_QC = 0, O_KC = 1024, O_VC = 2048, O_QD = 3072, O_KCMP = 4096, O_VCMP = 4352, O_KSLC = 4608, O_VSLC = 4864, O_KWIN = 5120, O_VWIN = 5376, O_FG = 5632;
constexpr int NCMP = 511;

constexpr size_t MiB = 1u << 20;
constexpr size_t WS_CTL = 0, CTL_ZERO_BYTES = 1 * MiB;
constexpr size_t WS_MODS = 1 * MiB;
constexpr size_t WS_KMH = 6 * MiB, WS_KML = 6 * MiB + 128 * 1024;
constexpr size_t WS_CUM = 7 * MiB;
constexpr size_t WS_FOXN = 7 * MiB + 512 * 1024;
constexpr size_t WS_FG = 8 * MiB;
constexpr size_t WS_KC = 9 * MiB, WS_VC = 9 * MiB + 512 * 1024;
constexpr size_t WS_W1T = 10 * MiB;
constexpr size_t WS_W2T = 14 * MiB;
constexpr size_t WS_W = 16 * MiB, W_LAYER = 96 * MiB, W_IN = 0, W_OUT = 24 * MiB, W_UP = 32 * MiB, W_DOWN = 64 * MiB;
constexpr size_t WS_H = 400 * MiB;
constexpr size_t WS_QKV = 432 * MiB;
constexpr size_t WS_O = 528 * MiB;
constexpr size_t WS_U = 560 * MiB;
constexpr size_t WS_NSASCR = 688 * MiB;
constexpr size_t WS_MPO = WS_NSASCR;
constexpr size_t WS_MML = 752 * MiB;
constexpr size_t WS_MLIST = 754 * MiB;
constexpr size_t WS_SS = 762 * MiB;
constexpr size_t WS_BIAS = 763 * MiB;
constexpr size_t WS_END = 764 * MiB;
constexpr int CW_BAR = 4096;
constexpr int CW_Q = 8192;
constexpr int CW_FOXN = 13312;
constexpr int CW_MCNT = 10240;

constexpr int RING_OFF = 0, RING_BYTES = 135168;
constexpr int LDSCTL_OFF = RING_BYTES, MISC_OFF = LDSCTL_OFF + 320;
constexpr int LDS_BYTES = 147456;
constexpr int EPITAB_OFF = MISC_OFF + 128;
static_assert(EPITAB_OFF + (4 * 512 + 64) * 4 <= LDS_BYTES, "LDS map");

#define GAS __attribute__((address_space(1)))
#define LAS __attribute__((address_space(3)))
#define DI __device__ __forceinline__
typedef unsigned short bf16;
typedef unsigned v4u __attribute__((ext_vector_type(4)));
typedef float f32x4 __attribute__((ext_vector_type(4)));
typedef float f32x16 __attribute__((ext_vector_type(16)));
typedef short bf16x8 __attribute__((ext_vector_type(8)));
typedef short s16x4 __attribute__((ext_vector_type(4)));
typedef GAS unsigned gu32;
#define RLX_AGENT __ATOMIC_RELAXED, __HIP_MEMORY_SCOPE_AGENT
#define LDS_WAIT() asm volatile("s_waitcnt lgkmcnt(0)" ::: "memory")
DI unsigned f2bf(float f) { unsigned u = __builtin_bit_cast(unsigned, f); return (u + 0x7fffu + ((u >> 16) & 1u)) >> 16; }
DI float bf2f(unsigned b) { return __builtin_bit_cast(float, b << 16); }
DI unsigned pk2(float lo, float hi) { return f2bf(lo) | (f2bf(hi) << 16); }
DI float wave_sum(float v) {
#pragma unroll
    for (int o = 1; o < 64; o <<= 1) v += __shfl_xor(v, o);
    return v;
}
#define XB_TMO      128
#define XB_XCNT(j)  (256  + 64 * (j))
#define XB_XSUB(j)  (1280 + 64 * (j))
#define XB_XGEN(j)  (2304 + 64 * (j))
#define XB_TOP      3328
#define XB_TOPGEN   3392
#define XCD_BAR_WORDS 3456
#define XB_SPIN_CAP (1u << 18)

__device__ __forceinline__ unsigned xb_ld(unsigned* p)              { return __hip_atomic_load(p, __ATOMIC_RELAXED, __HIP_MEMORY_SCOPE_AGENT); }
__device__ __forceinline__ unsigned xb_add(unsigned* p, unsigned v) { return __hip_atomic_fetch_add(p, v, __ATOMIC_RELAXED, __HIP_MEMORY_SCOPE_AGENT); }
__device__ __forceinline__ unsigned xb_xcc_id() { return (unsigned)__builtin_amdgcn_s_getreg((3 << 11) | 20) & 0xFu; }
#define XB_SPIN(cond, bar) do { unsigned _sp = 0; while (cond) { __builtin_amdgcn_s_sleep(1); \
    if ((++_sp & 255u) == 0u) { if (xb_ld(&(bar)[XB_TMO])) break; if (_sp > XB_SPIN_CAP) { atomicAdd(&(bar)[XB_TMO], 1u); break; } } } } while (0)

struct XcdBarrier {
    unsigned* bar; unsigned x;
    volatile LAS unsigned* st;
};

__device__ __forceinline__ XcdBarrier xcd_barrier_post(unsigned* bar, volatile LAS unsigned* st) {
    XcdBarrier b; b.bar = bar; b.x = xb_xcc_id(); b.st = st;
    if (threadIdx.x == 0) (void)xb_add(&bar[XB_XCNT(b.x)], 1u);
    return b;
}
__device__ __forceinline__ void xcd_barrier_complete(unsigned* bar, unsigned x, unsigned& nloc, unsigned& nx) {
    const unsigned G = gridDim.x * gridDim.y * gridDim.z;
    unsigned sum, cnt, mine, sp = 0u;
    for (;;) {
        sum = 0u; cnt = 0u; mine = 0u;
#pragma unroll
        for (unsigned j = 0; j < 16; ++j) { const unsigned c = xb_ld(&bar[XB_XCNT(j)]); sum += c; cnt += (c > 0u) ? 1u : 0u; mine = (j == x) ? c : mine; }
        if (sum == G) break;
        __builtin_amdgcn_s_sleep(1);
        if ((++sp & 255u) == 0u) { if (xb_ld(&bar[XB_TMO])) break; if (sp > XB_SPIN_CAP) { atomicAdd(&bar[XB_TMO], 1u); break; } }
    }
    nloc = mine > 0u ? mine : 1u; nx = cnt > 0u ? cnt : 1u;
}

__device__ __forceinline__ void xcd_barrier(const XcdBarrier& b) {
    asm volatile("s_waitcnt vmcnt(0)" ::: "memory");
    __syncthreads();
    if (threadIdx.x == 0) {
        unsigned* bar = b.bar;
        __builtin_amdgcn_s_waitcnt(0);
        unsigned nloc = b.st[0], nx = b.st[1];
        if (nloc == 0u) { xcd_barrier_complete(bar, b.x, nloc, nx); b.st[0] = nloc; b.st[1] = nx; }
        const unsigned old = xb_add(&bar[XB_XSUB(b.x)], 1u);
        const unsigned gen = old / nloc;
        if (old + 1u == (gen + 1u) * nloc) {
            __builtin_amdgcn_fence(__ATOMIC_RELEASE, "agent");
            asm volatile("s_waitcnt vmcnt(0)" ::: "memory");
            const unsigned og = xb_add(&bar[XB_TOP], 1u);
            const unsigned tg = og / nx;
            if (og + 1u == (tg + 1u) * nx) xb_add(&bar[XB_TOPGEN], 1u);
            else XB_SPIN(xb_ld(&bar[XB_TOPGEN]) == tg, bar);
            __builtin_amdgcn_fence(__ATOMIC_ACQUIRE, "agent");
            xb_add(&bar[XB_XGEN(b.x)], 1u);
            asm volatile("s_waitcnt vmcnt(0)" ::: "memory");
        } else {
            XB_SPIN(xb_ld(&bar[XB_XGEN(b.x)]) == gen, bar);
            __builtin_amdgcn_fence(__ATOMIC_ACQUIRE, "agent");
            asm volatile("s_waitcnt vmcnt(0)" ::: "memory");
        }
    }
    __syncthreads();
}

struct Args {
    const float* x; const float* c; const float* norm_mix_g; const float* norm_mlp_g; const float* ada_w; const float* ada_b;
    const float* mlp_up; const float* mlp_down; const float* even_w_in; const float* even_sinks; const float* even_w_out;
    const float* odd_w_in; const float* fox_forget_b; const float* nsa_k_pos; const float* nsa_k_w1; const float* nsa_k_w2;
    const float* nsa_v_pos; const float* nsa_v_w1; const float* nsa_v_w2; const float* odd_w_out; const float* final_norm_g;
    float* out; unsigned char* ws; int ph_lo, ph_hi;
};
typedef const __attribute__((address_space(4))) Args* KA;
DI KA kargs() { KA p = (KA)__builtin_amdgcn_kernarg_segment_ptr(); asm volatile("" : "+s"(p)); return p; }
struct Ctx {
    LAS unsigned char* lds; int tid, lane, wave, G, gw, NGW;
};
DI Ctx make_ctx(LAS unsigned char* lds) { Ctx C; C.lds = lds; C.tid = tid_fresh(); C.lane = C.tid & 63; C.wave = __builtin_amdgcn_readfirstlane(C.tid >> 6);
    C.G = gridDim.x; C.gw = blockIdx.x * NWAVES + C.wave; C.NGW = C.G * NWAVES; return C; }

DI int tile_perm_row(int nd) { const int q = nd & 255, hh = q >> 7, d = q & 127; return (nd & ~255) + (d < 64 ? hh * 64 + d : 128 + hh * 64 + (d - 64)); }
DI int odd_src_col(int nd) { return nd < 3072 ? nd : (nd < 5632 ? nd + 8 : (nd < 5640 ? 3072 + (nd - 5632) : (nd < 5664 ? nd : -1))); }
struct TJob { const float* W; int K, Nsrc, Ndst; bf16* WT; int mode; };
DI void tr_load(const TJob& J, int item, int lane, float (&v)[64], int& sc) {
    const int nblk = J.Ndst / 64, kb = item / nblk, nb = item % nblk, k0 = 64 * kb, n0 = 64 * nb;
    const int ndl = n0 + lane;
    sc = (J.mode == 2) ? odd_src_col(ndl) : ndl;
    const int scl = sc >= 0 ? sc : 0;
#pragma unroll
    for (int i = 0; i < 64; ++i) { const float* rowp = J.W + (size_t)(k0 + i) * J.Nsrc; v[i] = __builtin_nontemporal_load(rowp + scl); }
}
DI void tr_store(const TJob& J, int item, int lane, const float (&v)[64], int sc, LAS float* scr) {
    const int nblk = J.Ndst / 64, kb = item / nblk, nb = item % nblk, k0 = 64 * kb, n0 = 64 * nb;
#pragma unroll
    for (int i = 0; i < 64; ++i) scr[i * 65 + lane] = (sc >= 0) ? v[i] : 0.f;
    LDS_WAIT(); asm volatile("" ::: "memory");
    const int c = lane & 7;
#pragma unroll
    for (int j = 0; j < 8; ++j) { const int n = (lane >> 3) + 8 * j; const LAS float* s = scr + (8 * c) * 65 + n;
        v4u o; o.x = pk2(s[0 * 65], s[1 * 65]); o.y = pk2(s[2 * 65], s[3 * 65]); o.z = pk2(s[4 * 65], s[5 * 65]); o.w = pk2(s[6 * 65], s[7 * 65]);
        const int drow = (J.mode == 0) ? (n0 + n) : tile_perm_row(n0 + n);
        *(GAS v4u*)(J.WT + (size_t)drow * J.K + k0 + 8 * c) = o; }
    LDS_WAIT(); asm volatile("" ::: "memory");
}
DI void p0_transpose_item(const float* W, int K, int Nsrc, int Ndst, bf16* WT, LAS float* scr, int item, int lane, int mode) {
    const TJob J{W, K, Nsrc, Ndst, WT, mode}; float v[64]; int sc; tr_load(J, item, lane, v, sc); tr_store(J, item, lane, v, sc, scr);
}
DI void transpose_items4(const TJob& J, int item0, int lane, LAS float* scr) {
    float va[64], vb[64]; int sa, sb;
    tr_load(J, item0, lane, va, sa);
    tr_load(J, item0 + 1, lane, vb, sb); tr_store(J, item0, lane, va, sa, scr);
    tr_load(J, item0 + 2, lane, va, sa); tr_store(J, item0 + 1, lane, vb, sb, scr);
    tr_load(J, item0 + 3, lane, vb, sb); tr_store(J, item0 + 2, lane, va, sa, scr);
    tr_store(J, item0 + 3, lane, vb, sb, scr);
}
DI float silu_f(float v) { return v / (1.f + expf(-v)); }

DI int conv_items(int l, int x) { return x == 0 ? (DM / 64) * (((l & 1) ? NO : NE) / 64) : (x == 1 ? (DM / 64) * (DM / 64) : (DM / 64) * (DFF / 64)); }
DI TJob conv_job(KA a, unsigned char* ws, int l, int x) {
    const int j = l >> 1; const bool odd = l & 1;
    unsigned char* wl = ws + WS_W + (size_t)l * W_LAYER;
    if (x == 0) { if (!odd) return TJob{a->even_w_in + (size_t)j * DM * NE, DM, NE, NE, (bf16*)(wl + W_IN), 1};
                  return TJob{a->odd_w_in + (size_t)j * DM * NO_SRC, DM, NO_SRC, NO, (bf16*)(wl + W_IN), 2}; }
    if (x == 1) return TJob{(odd ? a->odd_w_out : a->even_w_out) + (size_t)j * DM * DM, DM, DM, DM, (bf16*)(wl + W_OUT), 0};
    if (x == 2) return TJob{a->mlp_up + (size_t)l * DM * DFF, DM, DFF, DFF, (bf16*)(wl + W_UP), 0};
    return TJob{a->mlp_down + (size_t)l * DFF * DM, DFF, DM, DM, (bf16*)(wl + W_DOWN), 0};
}
DI void conv_item(KA a, unsigned char* ws, int l, int x, int item, LAS float* scr, int lane) { const TJob J = conv_job(a, ws, l, x); p0_transpose_item(J.W, J.K, J.Nsrc, J.Ndst, J.WT, scr, item, lane, J.mode); }
DI void p0_prologue(KA a, const Ctx& C) {
    unsigned char* ws = a->ws;
    {
        LAS float* red = (LAS float*)(C.lds + RING_OFF);
        LAS float* sil = (LAS float*)(C.lds + RING_OFF + 8192);
        if ((int)blockIdx.x < 4 * 48) { for (int k = C.tid; k < DM; k += NWAVES * 64) sil[k] = silu_f(a->c[k]); __syncthreads(); }
        for (int u = blockIdx.x; u < 4 * 48; u += C.G) {
            const int l = u / 48, cg = u % 48;
            const float* Wb = a->ada_w + (size_t)l * DM * (6 * DM) + cg * 256 + 4 * C.lane;
            f32x4 acc = {0.f, 0.f, 0.f, 0.f};
            const int kbeg = C.wave * 256;
#pragma unroll 8
            for (int k = 0; k < 256; ++k) { const float sc = sil[kbeg + k]; const f32x4 w = *(const f32x4*)(Wb + (size_t)(kbeg + k) * (6 * DM)); acc += w * sc; }
            __syncthreads();
            *(LAS f32x4*)(red + C.wave * 256 + 4 * C.lane) = acc;
            __syncthreads();
            if (C.tid < 256) { float v = 0.f;
#pragma unroll
                for (int w = 0; w < 8; ++w) v += red[w * 256 + C.tid];
                const int j = cg * 256 + C.tid, sec = j / DM, col = j % DM;
                v += a->ada_b[(size_t)l * 6 * DM + j];
                if (sec == 1) v = a->norm_mix_g[l * DM + col] * (1.f + v);
                if (sec == 4) v = a->norm_mlp_g[l * DM + col] * (1.f + v);
                ((float*)(ws + WS_MODS))[(size_t)l * 6 * DM + j] = v; }
        }
        __syncthreads();
    }
    {
        LAS float* scr = (LAS float*)(C.lds + RING_OFF + C.wave * 16640);
        constexpr int I_W1 = (4096 / 64) * (128 / 64), I_W2 = (128 / 64) * (128 / 64);
        const int n0 = conv_items(0, 0) + conv_items(0, 1) + conv_items(0, 2) + conv_items(0, 3), n1 = conv_items(1, 0);
        const int total = n0 + n1 + 4 * (I_W1 + I_W2);
        for (int it = C.gw; it < total; it += C.NGW) {
            if (it < n0) { int r = it, x = 0; while (r >= conv_items(0, x)) { r -= conv_items(0, x); ++x; } conv_item(a, ws, 0, x, r, scr, C.lane); }
            else if (it < n0 + n1) conv_item(a, ws, 1, 0, it - n0, scr, C.lane);
            else { int r = it - n0 - n1; const int q = r / (I_W1 + I_W2); r %= (I_W1 + I_W2); const int j = q >> 1, kind = q & 1;
                if (r < I_W1) p0_transpose_item((kind ? a->nsa_v_w1 : a->nsa_k_w1) + (size_t)j * 4096 * 128, 4096, 128, 128, (bf16*)(ws + WS_W1T) + (size_t)q * 128 * 4096, scr, r, C.lane, 0);
                else p0_transpose_item((kind ? a->nsa_v_w2 : a->nsa_k_w2) + (size_t)j * 128 * 128, 128, 128, 128, (bf16*)(ws + WS_W2T) + (size_t)q * 128 * 128, scr, r - I_W1, C.lane, 0); }
        }
    }
}

DI void norm_phase(const Ctx& C, const float* X, const float* A, bf16* H, float* ss) {
    for (int m = C.gw; m < S; m += C.NGW) {
        const GAS f32x4* xr = (const GAS f32x4*)(X + (size_t)m * DM) + C.lane;
        f32x4 v[8]; float s = 0.f;
#pragma unroll
        for (int j = 0; j < 8; ++j) { v[j] = xr[64 * j]; s += (v[j].x * v[j].x + v[j].y * v[j].y) + (v[j].z * v[j].z + v[j].w * v[j].w); }
        const float tot = wave_sum(s);
        if (C.lane < 32) ss[(size_t)m * 32 + C.lane] = C.lane == 0 ? tot : 0.f;
        GAS unsigned long long* o8 = (GAS unsigned long long*)(H + (size_t)m * DM) + C.lane;
#pragma unroll
        for (int j = 0; j < 8; ++j) { const f32x4 av = *((const f32x4*)A + 64 * j + C.lane);
            const f32x4 r = v[j] * av;
            o8[64 * j] = (unsigned long long)pk2(r.x, r.y) | ((unsigned long long)pk2(r.z, r.w) << 32); }
    }
}
DI void bias_item(unsigned char* ws, int l, int kind, int item) {
    const int tid = tid_fresh(), lane = tid & 63, wave = tid >> 6;
    const float* mods = (const float*)(ws + WS_MODS) + (size_t)l * 6 * DM;
    const float* sh = mods + (kind ? 3 : 0) * DM;
    f32x4 s0[4], s1[4];
#pragma unroll
    for (int q = 0; q < 4; ++q) { const int k = q * 512 + lane * 8; s0[q] = *(const f32x4*)(sh + k); s1[q] = *(const f32x4*)(sh + k + 4); }
    v4u wv[8][4];
#pragma unroll
    for (int c = 0; c < 8; ++c) { const int n = item * 64 + wave * 8 + c;
        const bf16* wrow = kind ? (const bf16*)(ws + WS_W + (size_t)l * W_LAYER + W_UP) + (size_t)n * DM : (const bf16*)(ws + WS_W + (size_t)l * W_LAYER + W_IN) + (size_t)tile_perm_row(n) * DM;
#pragma unroll
        for (int q = 0; q < 4; ++q) wv[c][q] = *(const GAS v4u*)(wrow + q * 512 + lane * 8); }
#pragma unroll
    for (int c = 0; c < 8; ++c) { const int n = item * 64 + wave * 8 + c;
        float acc = 0.f;
#pragma unroll
        for (int q = 0; q < 4; ++q) { const v4u w = wv[c][q];
            acc += s0[q].x * bf2f(w.x & 0xffffu) + s0[q].y * bf2f(w.x >> 16) + s0[q].z * bf2f(w.y & 0xffffu) + s0[q].w * bf2f(w.y >> 16);
            acc += s1[q].x * bf2f(w.z & 0xffffu) + s1[q].y * bf2f(w.z >> 16) + s1[q].z * bf2f(w.w & 0xffffu) + s1[q].w * bf2f(w.w >> 16); }
        acc = wave_sum(acc);
        if (lane == 0) ((float*)(ws + WS_BIAS))[(size_t)l * (NO + DFF) + (kind ? NO : 0) + n] = acc; }
}
DI int bias_in_items(int l) { return ((l & 1) ? NO : NE) / 64; }
DI bool tail_item(KA a, unsigned char* ws, LAS unsigned char* lds, int l, int which, int ti) {
    const bool n1 = l + 1 < DEPTH, n2 = l + 2 < DEPTH;
    if (which != 0) {
        if (ti < 128) { bias_item(ws, l, 1, ti); return true; } ti -= 128;
        const int nb = n1 ? bias_in_items(l + 1) : 0;
        if (ti < nb) { bias_item(ws, l + 1, 0, ti); return true; } ti -= nb;
    }
    int jl[4], jx[4], nj = 0;
    if (which == 0) { if (n1) { jl[nj] = l + 1; jx[nj++] = 1; jl[nj] = l + 1; jx[nj++] = 2; jl[nj] = l + 1; jx[nj++] = 3; } }
    else if (which == 1) { if (n2) { jl[nj] = l + 2; jx[nj++] = 0; } }
    else { if (n1) { jl[nj] = l + 1; jx[nj++] = 1; jl[nj] = l + 1; jx[nj++] = 2; jl[nj] = l + 1; jx[nj++] = 3; } if (n2) { jl[nj] = l + 2; jx[nj++] = 0; } }
    const int tid = tid_fresh(), lane = tid & 63, wave = __builtin_amdgcn_readfirstlane(tid >> 6);
    LAS float* scr = (LAS float*)(lds + RING_OFF + wave * 16640);
#pragma unroll
    for (int q = 0; q < 4; ++q) { if (q < nj) { const int cnt = conv_items(jl[q], jx[q]) >> 3; if (ti < cnt) { conv_item(a, ws, jl[q], jx[q], ti * 8 + wave, scr, lane); return true; } ti -= cnt; } }
    return false;
}
DI void final_norm_phase(const Ctx& C, float* X, const float* g) {
    for (int m = C.gw; m < S; m += C.NGW) {
        GAS f32x4* xr = (GAS f32x4*)(X + (size_t)m * DM) + C.lane;
        f32x4 v[8]; float s = 0.f;
#pragma unroll
        for (int j = 0; j < 8; ++j) { v[j] = xr[64 * j]; s += (v[j].x * v[j].x + v[j].y * v[j].y) + (v[j].z * v[j].z + v[j].w * v[j].w); }
        const float rstd = 1.f / sqrtf(wave_sum(s) * (1.f / DM) + NORM_EPS);
#pragma unroll
        for (int j = 0; j < 8; ++j) { const f32x4 gv = *((const f32x4*)g + 64 * j + C.lane); xr[64 * j] = v[j] * rstd * gv; }
    }
}


DI void kmean_phase(const Ctx& C, const bf16* QKV, bf16* KMH, bf16* KML) {
    LAS float* part = (LAS float*)(C.lds + RING_OFF);
    for (int u = blockIdx.x; u < 256; u += C.G) {
        const int h = u >> 5, blk = u & 31;
        const int dch = C.tid & 15, kg = C.tid >> 4;
        float s[8];
#pragma unroll
        for (int e = 0; e < 8; ++e) s[e] = 0.f;
#pragma unroll
        for (int i = 0; i < 8; ++i) { const v4u w = *(const GAS v4u*)(QKV + (size_t)(blk * 256 + kg * 8 + i) * NE + E_KA + h * 128 + dch * 8);
            s[0] += bf2f(w.x & 0xffffu); s[1] += bf2f(w.x >> 16); s[2] += bf2f(w.y & 0xffffu); s[3] += bf2f(w.y >> 16);
            s[4] += bf2f(w.z & 0xffffu); s[5] += bf2f(w.z >> 16); s[6] += bf2f(w.w & 0xffffu); s[7] += bf2f(w.w >> 16); }
        __syncthreads();
#pragma unroll
        for (int e = 0; e < 8; ++e) part[kg * 128 + dch * 8 + e] = s[e];
        __syncthreads();
        if (C.tid < 128) { float v = 0.f;
#pragma unroll
            for (int g = 0; g < 32; ++g) v += part[g * 128 + C.tid];
            v *= (1.f / 256.f);
            const unsigned hb = f2bf(v); const float lo = v - bf2f(hb);
            KMH[(size_t)u * 128 + C.tid] = (bf16)hb; KML[(size_t)u * 128 + C.tid] = (bf16)f2bf(lo); }
    }
    __syncthreads();
}

DI float log_sigmoid_f(float x) { const float t = __builtin_amdgcn_exp2f(-fabsf(x) * 1.4426950408889634f); return fminf(x, 0.f) - 0.6931471805599453f * __builtin_amdgcn_logf(1.f + t); }
DI float gelu_tanh_f(float x) { return 0.5f * x * (1.f + tanhf(0.7978845608028654f * (x + 0.044715f * x * x * x))); }
DI f32x4 mfma16(bf16x8 a, bf16x8 b, f32x4 c) { return __builtin_amdgcn_mfma_f32_16x16x32_bf16(a, b, c, 0, 0, 0); }

#ifndef OP_DUP
#define OP_DUP 0
#endif
DI void oddprep_phase(KA a, const Ctx& C, int j  ) {
    unsigned char* ws = a->ws;
    const float* FG = (const float*)(ws + WS_FG); float* CUM = (float*)(ws + WS_CUM);
    const bf16* QKV = (const bf16*)(ws + WS_QKV);
    for (int u = blockIdx.x; u < 8 + 128 + 64; u += C.G) {
      for (int oprep_ = 0; oprep_ < ((u >= 136 ? (OP_DUP & 4) : (u < 8 ? (OP_DUP & 1) : (OP_DUP & 2))) ? 2 : 1); ++oprep_) {
        if (u >= 8 + 128) {
            const int hw = (u - 136) >> 2, part = (u - 136) & 3, h = hw >> 1, which = hw & 1; const int col = (which ? O_KC : O_QC) + h * 128;
            LAS float* wm = (LAS float*)(C.lds + RING_OFF);
            float mx = 0.f;
#pragma unroll 2
            for (int r = part * 2048 + C.tid; r < part * 2048 + 2048; r += NWAVES * 64) { float ss = 0.f;
#pragma unroll
                for (int i = 0; i < 16; ++i) { const v4u w = *(const GAS v4u*)(QKV + (size_t)r * NO + col + 8 * i);
                    const float a0 = bf2f(w.x & 0xffffu), a1 = bf2f(w.x >> 16), a2 = bf2f(w.y & 0xffffu), a3 = bf2f(w.y >> 16), a4 = bf2f(w.z & 0xffffu), a5 = bf2f(w.z >> 16), a6 = bf2f(w.w & 0xffffu), a7 = bf2f(w.w >> 16);
                    ss += (a0 * a0 + a1 * a1) + (a2 * a2 + a3 * a3) + (a4 * a4 + a5 * a5) + (a6 * a6 + a7 * a7); }
                mx = fmaxf(mx, ss); }
#pragma unroll
            for (int o = 1; o < 64; o <<= 1) mx = fmaxf(mx, __shfl_xor(mx, o));
            __syncthreads();
            if (C.lane == 0) wm[C.wave] = mx;
            __syncthreads();
            if (C.tid == 0) { float m = 0.f; for (int w = 0; w < NWAVES; ++w) m = fmaxf(m, wm[w]);
                __hip_atomic_fetch_max((gu32*)(ws + WS_CTL) + CW_FOXN + 16 * j + h * 2 + which, __builtin_bit_cast(unsigned, sqrtf(m)), RLX_AGENT); }
            __syncthreads();
        } else if (u < 8) {
            const int h = u; const float fb = a->fox_forget_b[j * 8 + h];
            LAS float* wtot = (LAS float*)(C.lds + RING_OFF);
            float v[16]; float run = 0.f;
#pragma unroll
            for (int i = 0; i < 16; ++i) { run += log_sigmoid_f(FG[(size_t)h * S + C.tid * 16 + i] + fb); v[i] = run; }
            float sc = run;
#pragma unroll
            for (int o = 1; o < 64; o <<= 1) { const float n = __shfl_up(sc, o); if (C.lane >= o) sc += n; }
            __syncthreads();
            if (C.lane == 63) wtot[C.wave] = sc;
            __syncthreads();
            float base = sc - run;
            for (int w = 0; w < C.wave; ++w) base += wtot[w];
#pragma unroll
            for (int i = 0; i < 16; ++i) CUM[(size_t)h * S + C.tid * 16 + i] = base + v[i];
            __syncthreads();
        } else {
            const int cu = u - 8, kind = cu >> 6, hd = (cu >> 5) & 1, n0 = (cu & 31) * 16;
            const int srccol = (kind ? O_VCMP : O_KCMP) + hd * 128;
            const float* pos = (kind ? a->nsa_v_pos : a->nsa_k_pos) + (size_t)j * 32 * 128;
            const bf16* w1t = (const bf16*)(ws + WS_W1T) + (size_t)(j * 2 + kind) * 128 * 4096;
            const bf16* w2t = (const bf16*)(ws + WS_W2T) + (size_t)(j * 2 + kind) * 128 * 128;
            bf16* dst = (bf16*)(ws + (kind ? WS_VC : WS_KC));
            LAS float* red = (LAS float*)(C.lds + RING_OFF);
            LAS bf16* h1b = (LAS bf16*)(C.lds + RING_OFF + 65536);
            const int row = C.lane & 15, kg = C.lane >> 4;
            f32x4 acc[8];
#pragma unroll
            for (int cb = 0; cb < 8; ++cb) acc[cb] = (f32x4){0.f, 0.f, 0.f, 0.f};
#define CMP_LOAD(step_, w_, q0_, q1_, b_) do { const int l_ = C.wave * 4 + ((step_) >> 2), d_ = 32 * ((step_) & 3) + 8 * kg; int tok_ = 16 * (n0 + row) + l_; if (tok_ > S - 1) tok_ = S - 1; \
                w_ = *(const GAS v4u*)(QKV + (size_t)tok_ * NO + srccol + d_); q0_ = *(const f32x4*)(pos + l_ * 128 + d_); q1_ = *(const f32x4*)(pos + l_ * 128 + d_ + 4);          \
                _Pragma("unroll") for (int cb = 0; cb < 8; ++cb) b_[cb] = *(const GAS bf16x8*)(w1t + (size_t)(cb * 16 + row) * 4096 + l_ * 128 + d_); } while (0)
#define CMP_MMA(w_, q0_, q1_, b_) do { v4u aw; aw.x = pk2(bf2f(w_.x & 0xffffu) + q0_.x, bf2f(w_.x >> 16) + q0_.y); aw.y = pk2(bf2f(w_.y & 0xffffu) + q0_.z, bf2f(w_.y >> 16) + q0_.w);                 \
                aw.z = pk2(bf2f(w_.z & 0xffffu) + q1_.x, bf2f(w_.z >> 16) + q1_.y); aw.w = pk2(bf2f(w_.w & 0xffffu) + q1_.z, bf2f(w_.w >> 16) + q1_.w);                                            \
                const bf16x8 af = __builtin_bit_cast(bf16x8, aw); _Pragma("unroll") for (int cb = 0; cb < 8; ++cb) acc[cb] = mfma16(af, b_[cb], acc[cb]); } while (0)
            { v4u wa, wb; f32x4 pa0, pa1, pb0, pb1; bf16x8 ba[8], bb[8];
              CMP_LOAD(0, wa, pa0, pa1, ba);
#pragma unroll 1
              for (int st = 0; st < 16; st += 2) { CMP_LOAD(st + 1, wb, pb0, pb1, bb); CMP_MMA(wa, pa0, pa1, ba); if (st + 2 < 16) CMP_LOAD(st + 2, wa, pa0, pa1, ba); CMP_MMA(wb, pb0, pb1, bb); } }
#undef CMP_LOAD
#undef CMP_MMA
            __syncthreads();
#pragma unroll
            for (int cb = 0; cb < 8; ++cb)
#pragma unroll
                for (int e = 0; e < 4; ++e) red[(C.wave * 16 + 4 * kg + e) * 128 + cb * 16 + row] = acc[cb][e];
            __syncthreads();
            for (int e = C.tid; e < 16 * 128; e += NWAVES * 64) { float v = 0.f;
#pragma unroll
                for (int w = 0; w < 8; ++w) v += red[w * 2048 + e];
                h1b[(e >> 7) * 136 + (e & 127)] = (bf16)f2bf(gelu_tanh_f(v)); }
            __syncthreads();
            {
                f32x4 o = {0.f, 0.f, 0.f, 0.f};
#pragma unroll
                for (int ks = 0; ks < 4; ++ks) { const bf16x8 af = *(const LAS bf16x8*)(h1b + row * 136 + 32 * ks + 8 * kg);
                    const bf16x8 bfr = *(const GAS bf16x8*)(w2t + (size_t)(C.wave * 16 + row) * 128 + 32 * ks + 8 * kg);
                    o = mfma16(af, bfr, o); }
#pragma unroll
                for (int e = 0; e < 4; ++e) { const int n = n0 + 4 * kg + e; dst[(size_t)n * 256 + hd * 128 + C.wave * 16 + row] = (n < NCMP) ? (bf16)f2bf(o[e]) : (bf16)0; }
            }
            __syncthreads();
        }
      }
    }
}

DI void moba_combine_phase(const Ctx& C, const bf16* PO, const float* PML, bf16* O) {
    constexpr float C2 = 0.08838834764831845f * 1.4426950408889634f;
    for (int item = C.gw; item < 8 * S; item += C.NGW) {
        const int token = item >> 3, h = item & 7; const int nsel = (token >> 8) < 3 ? (token >> 8) : 3;
        const size_t pb = ((size_t)h * S + token) * 4;
        const f32x4 ml01 = *(const f32x4*)(PML + pb * 2), ml23 = *(const f32x4*)(PML + pb * 2 + 4);
        const float m0 = ml01.x, l0 = ml01.y, m1 = ml01.z, l1 = ml01.w, m2 = ml23.x, l2 = ml23.y, m3 = ml23.z, l3 = ml23.w;
        float M = m3; if (nsel > 0) M = fmaxf(M, m0); if (nsel > 1) M = fmaxf(M, m1); if (nsel > 2) M = fmaxf(M, m2);
        const float w3 = l3 * __builtin_amdgcn_exp2f((m3 - M) * C2);
        const float w0 = nsel > 0 ? l0 * __builtin_amdgcn_exp2f((m0 - M) * C2) : 0.f, w1 = nsel > 1 ? l1 * __builtin_amdgcn_exp2f((m1 - M) * C2) : 0.f, w2 = nsel > 2 ? l2 * __builtin_amdgcn_exp2f((m2 - M) * C2) : 0.f;
        const GAS unsigned* po = (const GAS unsigned*)(PO + pb * 128) + C.lane;
        const unsigned u3 = po[3 * 64]; float a0 = w3 * bf2f(u3 & 0xffffu), a1 = w3 * bf2f(u3 >> 16);
        if (nsel > 0) { const unsigned u = po[0]; a0 += w0 * bf2f(u & 0xffffu); a1 += w0 * bf2f(u >> 16); }
        if (nsel > 1) { const unsigned u = po[64]; a0 += w1 * bf2f(u & 0xffffu); a1 += w1 * bf2f(u >> 16); }
        if (nsel > 2) { const unsigned u = po[128]; a0 += w2 * bf2f(u & 0xffffu); a1 += w2 * bf2f(u >> 16); }
        const float inv = 1.f / (w0 + w1 + w2 + w3);
        *((GAS unsigned*)(O + (size_t)token * DM + h * 128) + C.lane) = pk2(a0 * inv, a1 * inv);
    }
}

namespace att {
#ifndef FOX_SKIP
#define FOX_SKIP 1
#endif
#ifndef NSA_DUP
#define NSA_DUP 0
#endif
constexpr float SCALE = 0.08838834764831845f, LOG2E = 1.4426950408889634f, C2 = SCALE * LOG2E, INV_SCALE = 11.313708498984761f;
constexpr float THR = 8.f;
constexpr int KVBLK = 64, SHM_K = 16384, SHM_V = 16384;
constexpr int L_V = 0, L_K = 2 * SHM_V, L_WS = 65536, L_BIAS = L_WS + 2048, L_MISC = L_BIAS + 512, L_IMP = L_MISC + 1536, IMP_STRIDE = 132, L_SEL = L_IMP + 64 * IMP_STRIDE * 4, L_END = L_SEL + 1024;
static_assert(L_END <= RING_BYTES, "attention LDS map");
#define KSWZ(row, colB) ((row) * 256 + ((colB) ^ (((row) & 15) << 4)))
#define SBAR() __builtin_amdgcn_sched_barrier(0)
DI int v_st(int k, int c) { const int kk = (k & ~0xC) | ((k & 4) << 1) | ((k & 8) >> 1); return ((kk >> 3) * 4 + (c >> 5)) * 512 + ((kk & 7) * 32 + (c & 31)) * 2; }
DI int v_rd_base(int lane) { return ((lane & 3) << 3) | (((lane >> 2) & 3) << 6) | (((lane >> 4) & 1) << 5) | (((lane >> 5) & 1) << 8); }
constexpr int v_rd_off(int d0, int ks, int half) { return d0 * 512 + ks * 4096 + half * 2048; }
DI int crow(int r, int hi) { return (r & 3) + 8 * (r >> 2) + 4 * hi; }
DI unsigned cvtpk(float lo, float hi) { unsigned r; asm volatile("v_cvt_pk_bf16_f32 %0, %1, %2" : "=v"(r) : "v"(lo), "v"(hi)); return r; }

struct Cx {
    LAS char* lds; int tid, wid, lane, r32, hi, sr, sc, kws, vst0, vst1, vb0; LAS float* li_l; LAS float* al_l;
};
DI Cx make_cx(LAS unsigned char* lds_) {
    Cx c; c.lds = (LAS char*)lds_; c.tid = tid_fresh(); c.wid = __builtin_amdgcn_readfirstlane(c.tid >> 6); c.lane = c.tid & 63; c.r32 = c.lane & 31; c.hi = c.lane >> 5;
    c.sr = c.tid >> 4; c.sc = (c.tid & 15) * 8; c.kws = KSWZ(c.sr, c.sc * 2); c.vst0 = v_st(c.sr, c.sc); c.vst1 = v_st(32 + c.sr, c.sc);
    c.vb0 = (int)(unsigned)(uintptr_t)(c.lds + L_V) + v_rd_base(c.lane);
    c.li_l = (LAS float*)(c.lds + L_WS) + c.wid * 64; c.al_l = c.li_l + 32;
    return c;
}
struct Stage { bf16x8 k0, k1, v0, v1; float ex; };

DI void qkt(f32x16& p0, f32x16& p1, const LAS char* Kb, int r32, int hi, const bf16x8* qr) {
#pragma unroll
    for (int r = 0; r < 16; ++r) { p0[r] = 0.f; p1[r] = 0.f; }
    const LAS char* kbase = Kb + r32 * 256; const int xs = ((r32 & 15) ^ hi) << 4;
#pragma unroll
    for (int d0 = 0; d0 < 8; ++d0) { const LAS char* a = kbase + ((d0 * 32) ^ xs);
        const bf16x8 b0 = *(const LAS bf16x8*)a, b1 = *(const LAS bf16x8*)(a + 32 * 256);
        p0 = __builtin_amdgcn_mfma_f32_32x32x16_bf16(b0, qr[d0], p0, 0, 0, 0);
        p1 = __builtin_amdgcn_mfma_f32_32x32x16_bf16(b1, qr[d0], p1, 0, 0, 0); }
}
DI void partialSM(f32x16& p0, f32x16& p1, float& m_reg, float& mn, float& alpha) {
    float pmax = p0[0];
#pragma unroll
    for (int r = 1; r < 16; ++r) pmax = fmaxf(pmax, p0[r]);
#pragma unroll
    for (int r = 0; r < 16; ++r) pmax = fmaxf(pmax, p1[r]);
    { auto rr = __builtin_amdgcn_permlane32_swap(__float_as_uint(pmax), __float_as_uint(pmax), false, false);
      pmax = fmaxf(__uint_as_float(rr[0]), __uint_as_float(rr[1])); }
    if (__builtin_expect(__all((pmax - m_reg) * SCALE <= THR), 1)) { mn = m_reg; alpha = 1.f; }
    else { mn = fmaxf(m_reg, pmax); alpha = __builtin_amdgcn_exp2f((m_reg - mn) * C2); m_reg = mn; }
    const float mnL = -mn * C2;
#pragma unroll
    for (int r = 0; r < 16; ++r) p0[r] = fmaf(p0[r], C2, mnL);
#pragma unroll
    for (int r = 0; r < 16; ++r) p1[r] = fmaf(p1[r], C2, mnL);
#pragma unroll
    for (int r = 0; r < 16; ++r) p0[r] = __builtin_amdgcn_exp2f(p0[r]);
}
DI void pack_p(const f32x16& p0, const f32x16& p1, bf16x8& pa0, bf16x8& pa1, bf16x8& pa2, bf16x8& pa3) {
#define PK4(P, B_, OUT) do { unsigned a0 = cvtpk(P[B_+0], P[B_+1]), a1 = cvtpk(P[B_+2], P[B_+3]);                          \
        unsigned b0 = cvtpk(P[B_+4], P[B_+5]), b1 = cvtpk(P[B_+6], P[B_+7]);                                             \
        auto r0 = __builtin_amdgcn_permlane32_swap(a0, b0, false, false); auto r1 = __builtin_amdgcn_permlane32_swap(a1, b1, false, false); \
        v4u w = {r0[0], r1[0], r0[1], r1[1]}; OUT = __builtin_bit_cast(bf16x8, w); } while (0)
    PK4(p0, 0, pa0); PK4(p0, 8, pa1); PK4(p1, 0, pa2); PK4(p1, 8, pa3);
#undef PK4
}
DI void finishSM(f32x16& p0, f32x16& p1, float alpha, float& l_reg, bf16x8& pa0, bf16x8& pa1, bf16x8& pa2, bf16x8& pa3) {
#pragma unroll
    for (int r = 0; r < 16; ++r) p1[r] = __builtin_amdgcn_exp2f(p1[r]);
    float ps = 0;
#pragma unroll
    for (int r = 0; r < 16; ++r) ps += p0[r];
#pragma unroll
    for (int r = 0; r < 16; ++r) ps += p1[r];
    { auto rr = __builtin_amdgcn_permlane32_swap(__float_as_uint(ps), __float_as_uint(ps), false, false);
      ps = __uint_as_float(rr[0]) + __uint_as_float(rr[1]); }
    l_reg = l_reg * alpha + ps;
    pack_p(p0, p1, pa0, pa1, pa2, pa3);
}
DI void pv_tile(f32x16* o, int vb0, bf16x8 pa0, bf16x8 pa1, bf16x8 pa2, bf16x8 pa3) {
#define TRRD(dst, off) asm volatile("ds_read_b64_tr_b16 %0, %1 offset:%2" : "=&v"(dst) : "v"(vb0), "i"(off) : "memory")
#define PV_D0(d0) do { s16x4 l0, l1, l2, l3, h0, h1, h2, h3; constexpr int b_ = v_rd_off(d0, 0, 0); \
        TRRD(l0, b_); TRRD(h0, b_ + 2048); TRRD(l1, b_ + 4096); TRRD(h1, b_ + 6144); TRRD(l2, b_ + 8192); TRRD(h2, b_ + 10240); TRRD(l3, b_ + 12288); TRRD(h3, b_ + 14336); \
        asm volatile("s_waitcnt lgkmcnt(0)" ::: "memory"); SBAR();   \
        o[d0] = __builtin_amdgcn_mfma_f32_32x32x16_bf16(pa0, (bf16x8){l0[0], l0[1], l0[2], l0[3], h0[0], h0[1], h0[2], h0[3]}, o[d0], 0, 0, 0);   \
        o[d0] = __builtin_amdgcn_mfma_f32_32x32x16_bf16(pa1, (bf16x8){l1[0], l1[1], l1[2], l1[3], h1[0], h1[1], h1[2], h1[3]}, o[d0], 0, 0, 0);   \
        o[d0] = __builtin_amdgcn_mfma_f32_32x32x16_bf16(pa2, (bf16x8){l2[0], l2[1], l2[2], l2[3], h2[0], h2[1], h2[2], h2[3]}, o[d0], 0, 0, 0);   \
        o[d0] = __builtin_amdgcn_mfma_f32_32x32x16_bf16(pa3, (bf16x8){l3[0], l3[1], l3[2], l3[3], h3[0], h3[1], h3[2], h3[3]}, o[d0], 0, 0, 0); } while (0)
    PV_D0(0); PV_D0(1); PV_D0(2); PV_D0(3);
#undef PV_D0
#undef TRRD
}
DI void rescale_o(const Cx& c, f32x16* o, float alpha) {
    if (__any(alpha < 1.f)) { if (c.hi == 0) c.al_l[c.r32] = alpha; asm volatile("s_waitcnt lgkmcnt(0)" ::: "memory");
#pragma unroll
        for (int d = 0; d < 4; ++d)
#pragma unroll
            for (int r = 0; r < 16; ++r) o[d][r] *= c.al_l[crow(r, c.hi)];
    }
}
DI void mask_tile(f32x16& p0, f32x16& p1, int dq, unsigned W) {
    const float NEG = -__builtin_inff();
#pragma unroll
    for (int r = 0; r < 16; ++r) { const int cc = (r & 3) + 8 * (r >> 2);
        if ((unsigned)(dq - cc) >= W) p0[r] = NEG;
        if ((unsigned)(dq - cc - 32) >= W) p1[r] = NEG; }
}
DI void kill_tile(f32x16& p0, f32x16& p1) { const float NEG = -__builtin_inff();
#pragma unroll
    for (int r = 0; r < 16; ++r) { p0[r] = NEG; p1[r] = NEG; } }

template <int MODE, class P>
DI void run(const Cx& c, P& prob, const bf16x8* qr, float& m_reg, float& l_reg, f32x16* o) {
    const int nt = prob.ntiles();
    if (nt <= 0) return;
    Stage st;
    { const bf16 *kp, *vp; int kpitch, vpitch; prob.src(0, kp, vp, kpitch, vpitch);
      st.k0 = *(const GAS bf16x8*)(kp + (size_t)c.sr * kpitch + c.sc); st.k1 = *(const GAS bf16x8*)(kp + (size_t)(32 + c.sr) * kpitch + c.sc);
      if (MODE == 0) { st.v0 = *(const GAS bf16x8*)(vp + (size_t)c.sr * vpitch + c.sc); st.v1 = *(const GAS bf16x8*)(vp + (size_t)(32 + c.sr) * vpitch + c.sc); }
      st.ex = prob.extra(0); }
    const float inv_l = (MODE == 1) ? (l_reg > 0.f ? 1.f / l_reg : 0.f) : 0.f;
    for (int t = 0; t < nt; ++t) {
        const int buf = t & 1;
        *(LAS bf16x8*)(c.lds + L_K + buf * SHM_K + c.kws) = st.k0; *(LAS bf16x8*)(c.lds + L_K + buf * SHM_K + c.kws + 32 * 256) = st.k1;
        if (MODE == 0) { *(LAS bf16x8*)(c.lds + L_V + buf * SHM_V + c.vst0) = st.v0; *(LAS bf16x8*)(c.lds + L_V + buf * SHM_V + c.vst1) = st.v1; }
        prob.put_extra(t, buf, st.ex);
        __syncthreads();
        if (t + 1 < nt) { const bf16 *kp, *vp; int kpitch, vpitch; prob.src(t + 1, kp, vp, kpitch, vpitch);
            st.k0 = *(const GAS bf16x8*)(kp + (size_t)c.sr * kpitch + c.sc); st.k1 = *(const GAS bf16x8*)(kp + (size_t)(32 + c.sr) * kpitch + c.sc);
            if (MODE == 0) { st.v0 = *(const GAS bf16x8*)(vp + (size_t)c.sr * vpitch + c.sc); st.v1 = *(const GAS bf16x8*)(vp + (size_t)(32 + c.sr) * vpitch + c.sc); }
            st.ex = prob.extra(t + 1); }
        if (prob.active(t)) {
            f32x16 p0, p1;
            qkt(p0, p1, c.lds + L_K + buf * SHM_K, c.r32, c.hi, qr);
            prob.mask(p0, p1, t, buf);
            if (MODE == 0) {
                float mn, alpha; partialSM(p0, p1, m_reg, mn, alpha);
                rescale_o(c, o, alpha);
                bf16x8 pa0, pa1, pa2, pa3; finishSM(p0, p1, alpha, l_reg, pa0, pa1, pa2, pa3);
                pv_tile(o, c.vb0 + buf * SHM_V, pa0, pa1, pa2, pa3);
            } else {
                const float mnL = -m_reg * C2;
#pragma unroll
                for (int r = 0; r < 16; ++r) { p0[r] = __builtin_amdgcn_exp2f(fmaf(p0[r], C2, mnL)) * inv_l; p1[r] = __builtin_amdgcn_exp2f(fmaf(p1[r], C2, mnL)) * inv_l; }
                prob.post(p0, p1, t, true);
            }
        } else if (MODE == 1) { f32x16 z0, z1; prob.post(z0, z1, t, false); }
    }
    __syncthreads();
}

DI void load_q(bf16x8* qr, const bf16* Q, int pitch, int token, int col, int hi) {
#pragma unroll
    for (int d0 = 0; d0 < 8; ++d0) qr[d0] = *(const GAS bf16x8*)(Q + (size_t)token * pitch + col + d0 * 16 + hi * 8);
}
DI void row_coefs(const Cx& c, float coef, float* rc) {
    if (c.hi == 0) c.li_l[c.r32] = coef; asm volatile("s_waitcnt lgkmcnt(0)" ::: "memory");
#pragma unroll
    for (int r = 0; r < 16; ++r) rc[r] = c.li_l[crow(r, c.hi)];
    asm volatile("s_waitcnt lgkmcnt(0)" ::: "memory");
}
template <bool GQA>
DI void store_o(const Cx& c, const f32x16* o, const float* rc, bf16* O, int tok0  , int col0  ) {
#pragma unroll
    for (int r = 0; r < 16; ++r) { const int rr = crow(r, c.hi);
        const int token = GQA ? tok0 + (rr >> 2) : tok0 + rr; const int col = GQA ? col0 + (rr & 3) * 128 : col0;
#pragma unroll
        for (int d0 = 0; d0 < 4; ++d0) { const float v = o[d0][r] * rc[r]; const float vn = __shfl_xor(v, 1);
            if ((c.r32 & 1) == 0) *(GAS unsigned*)(O + (size_t)token * DM + col + d0 * 32 + c.r32) = cvtpk(v, vn); } }
}

DI void moba_gate_unit(LAS unsigned char* lds_, const bf16* QKV, const bf16* KMH, const bf16* KML, gu32* cnt  , unsigned* list  , int h, int qb) {
    if (qb == 0) return;
    const Cx c = make_cx(lds_);
    const int P0 = qb * 256, token = P0 + c.wid * 32 + c.r32;
    bf16x8 qr[8]; load_q(qr, QKV, NE, token, E_QA + h * 128, c.hi);
    unsigned taken = 0u;
    {
        f32x16 g;
#pragma unroll
        for (int r = 0; r < 16; ++r) g[r] = 0.f;
#pragma unroll
        for (int d0 = 0; d0 < 8; ++d0) { const size_t off = ((size_t)h * 32 + c.r32) * 128 + d0 * 16 + c.hi * 8;
            const bf16x8 kh = *(const GAS bf16x8*)(KMH + off), kl = *(const GAS bf16x8*)(KML + off);
            g = __builtin_amdgcn_mfma_f32_32x32x16_bf16(kh, qr[d0], g, 0, 0, 0); g = __builtin_amdgcn_mfma_f32_32x32x16_bf16(kl, qr[d0], g, 0, 0, 0); }
        const float NEG = -__builtin_inff();
#pragma unroll
        for (int it = 0; it < (BREAK == 6 ? 2 : 3); ++it) { float best = NEG; int bi = 99;
#pragma unroll
            for (int r = 0; r < 16; ++r) { const int b = crow(r, c.hi); const float v = (b < qb && !((taken >> b) & 1u)) ? g[r] : NEG; if (v > best) { best = v; bi = b; } }
            const float ob = __shfl_xor(best, 32); const int obi = __shfl_xor(bi, 32);
            if (ob > best || (ob == best && obi < bi)) { best = ob; bi = obi; }
            if (best > NEG) taken |= 1u << bi; }
    }
    const unsigned lt = (1u << c.r32) - 1u;
    unsigned my_n = 0u;
    for (int j = 0; j < qb; ++j) { const unsigned long long b = __ballot(c.hi == 0 && ((taken >> j) & 1u)); if (c.lane == j) my_n = (unsigned)__popcll(b); }
    unsigned base = 0u;
    if (c.lane < qb && my_n) base = __hip_atomic_fetch_add(cnt + h * 32 + c.lane, my_n, RLX_AGENT);
    for (int j = 0; j < qb; ++j) { const bool sl = c.hi == 0 && ((taken >> j) & 1u); const unsigned m = (unsigned)__ballot(sl); const unsigned bj = __shfl(base, j);
        if (sl) list[((size_t)h * 32 + j) * 8192 + bj + __popc(m & lt)] = (unsigned)token | ((unsigned)__popc(taken & ((1u << j) - 1u)) << 16); }
}
struct BlkProb {
    const bf16* QKV; int h, key0, causal, qlo, qpos, hi; bool wact  ;
    DI int ntiles() const { return 4; }
    DI void src(int t, const bf16*& k, const bf16*& v, int& kp, int& vp) const { const size_t kk = (size_t)(key0 + t * 64); k = QKV + kk * NE + E_KA + h * 128; v = QKV + kk * NE + E_VA + h * 128; kp = NE; vp = NE; }
    DI float extra(int) const { return 0.f; }
    DI void put_extra(int, int, float) const {}
    DI bool active(int t) const { return causal ? (key0 + t * 64 <= qlo + 31) : wact; }
    DI void mask(f32x16& p0, f32x16& p1, int t, int) const { if (causal) { const int kb = key0 + t * 64; if (kb + 63 > qlo) mask_tile(p0, p1, qpos - 4 * hi - kb, 0x7fffffffu); } }
    DI void post(f32x16&, f32x16&, int, bool) const {}
};
DI void moba_blk_unit(LAS unsigned char* lds_, const bf16* QKV, const gu32* cnt, const unsigned* list, bf16* PO, float* PML, int h, int j, int r) {
    const Cx c = make_cx(lds_);
    int token, slot; bool valid = true;
    if (r < 0) { token = j * 256 + c.wid * 32 + c.r32; slot = 3; }
    else { const int n = (int)cnt[h * 32 + j], row = r * 256 + c.wid * 32 + c.r32; valid = row < n;
        const unsigned e = list[((size_t)h * 32 + j) * 8192 + (valid ? row : 0)]; token = (int)(e & 0xffffu); slot = (int)(e >> 16); }
    bf16x8 qr[8]; load_q(qr, QKV, NE, token, E_QA + h * 128, c.hi);
    BlkProb pr; pr.QKV = QKV; pr.h = h; pr.key0 = j * 256; pr.causal = r < 0 ? 1 : 0; pr.qlo = j * 256 + c.wid * 32; pr.qpos = token; pr.hi = c.hi; pr.wact = __any(valid);
    float m_reg = -1e30f, l_reg = 0.f; f32x16 o[4];
#pragma unroll
    for (int d = 0; d < 4; ++d)
#pragma unroll
        for (int q = 0; q < 16; ++q) o[d][q] = 0.f;
    run<0>(c, pr, qr, m_reg, l_reg, o);
    const int dest = valid ? (((h * 8192 + token) << 2) + slot) : -1;
    if (valid && c.hi == 0) { GAS float* ml = (GAS float*)PML + (size_t)dest * 2; ml[0] = m_reg; ml[1] = l_reg; }
    float rc[16]; row_coefs(c, l_reg > 0.f ? 1.f / l_reg : 0.f, rc);
    int dst[16];
    { LAS int* il = (LAS int*)c.li_l; if (c.hi == 0) il[c.r32] = dest; asm volatile("s_waitcnt lgkmcnt(0)" ::: "memory");
#pragma unroll
      for (int q = 0; q < 16; ++q) dst[q] = il[crow(q, c.hi)];
      asm volatile("s_waitcnt lgkmcnt(0)" ::: "memory"); }
#pragma unroll
    for (int q = 0; q < 16; ++q) {
#pragma unroll
        for (int d0 = 0; d0 < 4; ++d0) { const float v = o[d0][q] * rc[q]; const float vn = __shfl_xor(v, 1);
            if ((c.r32 & 1) == 0 && dst[q] >= 0) *(GAS unsigned*)(PO + (size_t)dst[q] * 128 + d0 * 32 + c.r32) = cvtpk(v, vn); } }
}

struct WinProb {
    const bf16* QKV; int pitch, kcol, vcol, t0  , nt, qlo  , qpos, hi; unsigned W;
    DI int ntiles() const { return nt; }
    DI void src(int t, const bf16*& k, const bf16*& v, int& kp, int& vp) const { const size_t key0 = (size_t)(t0 + t) * 64; k = QKV + key0 * pitch + kcol; v = QKV + key0 * pitch + vcol; kp = pitch; vp = pitch; }
    DI float extra(int) const { return 0.f; }
    DI void put_extra(int, int, float) const {}
    DI bool active(int t) const { const int kb = (t0 + t) * 64; return kb <= qlo + 7 && kb + 63 >= qlo - (int)W + 1; }
    DI void mask(f32x16& p0, f32x16& p1, int t, int) const { const int kb = (t0 + t) * 64; if (kb + 63 > qlo || kb <= qlo + 7 - (int)W) mask_tile(p0, p1, qpos - 4 * hi - kb, W); }
    DI void post(f32x16&, f32x16&, int, bool) const {}
};
DI void swa_unit(LAS unsigned char* lds_, const bf16* QKV, const float* sinks, bf16* O, int kvh, int ch) {
    const Cx c = make_cx(lds_);
    const int T0 = ch * 64, token = T0 + c.wid * 8 + (c.r32 >> 2), hq = kvh * 4 + (c.r32 & 3);
    bf16x8 qr[8]; load_q(qr, QKV, NE, token, E_QB + hq * 128, c.hi);
    WinProb pr; pr.QKV = QKV; pr.pitch = NE; pr.kcol = E_KB + kvh * 128; pr.vcol = E_VB + kvh * 128; pr.t0 = ch >= 2 ? ch - 2 : 0; pr.nt = ch + 1 - pr.t0;
    pr.qlo = T0 + c.wid * 8; pr.qpos = token; pr.hi = c.hi; pr.W = 128u;
    float m_reg = sinks[hq] * INV_SCALE, l_reg = 1.f; f32x16 o[4];
#pragma unroll
    for (int d = 0; d < 4; ++d)
#pragma unroll
        for (int r = 0; r < 16; ++r) o[d][r] = 0.f;
    run<0>(c, pr, qr, m_reg, l_reg, o);
    float rc[16]; row_coefs(c, 1.f / l_reg, rc);
    store_o<true>(c, o, rc, O, T0 + c.wid * 8, 1024 + kvh * 512);
}

struct FoxProb {
    const bf16* QKV; const float* cum  ; float cb; int h, qb, qlo, qpos, hi, tid, a0  ; const LAS float* bias;
    DI int ntiles() const { return 4 * (qb + 1) - a0; }
    DI void src(int t, const bf16*& k, const bf16*& v, int& kp, int& vp) const { const size_t key0 = (size_t)(a0 + t) * 64; k = QKV + key0 * NO + O_KC + h * 128; v = QKV + key0 * NO + O_VC + h * 128; kp = NO; vp = NO; }
    DI float extra(int t) const { return tid < 64 ? cum[(a0 + t) * 64 + tid] : 0.f; }
    DI void put_extra(int, int buf, float ex) const { if (tid < 64) ((LAS float*)bias)[buf * 64 + tid] = (cb - ex) * INV_SCALE; }
    DI bool active(int t) const { return (a0 + t) * 64 <= qlo + 31; }
    DI void mask(f32x16& p0, f32x16& p1, int t, int buf) const {
        const LAS float* b = bias + buf * 64 + 4 * hi;
#pragma unroll
        for (int g = 0; g < 4; ++g) { const f32x4 b0 = *(const LAS f32x4*)(b + 8 * g), b1 = *(const LAS f32x4*)(b + 32 + 8 * g);
#pragma unroll
            for (int e = 0; e < 4; ++e) { p0[4 * g + e] += b0[e]; p1[4 * g + e] += b1[e]; } }
        const int kb = (a0 + t) * 64; if (kb + 63 > qlo) mask_tile(p0, p1, qpos + (BREAK == 8 ? 1 : 0) - 4 * hi - kb, 0x7fffffffu);
    }
    DI void post(f32x16&, f32x16&, int, bool) const {}
};
DI void fox_unit(LAS unsigned char* lds_, const bf16* QKV, const float* CUM, const float* FOXN, bf16* O, int h, int qb) {
    const Cx c = make_cx(lds_);
    const int P0 = qb * 256, token = P0 + c.wid * 32 + c.r32;
    bf16x8 qr[8]; load_q(qr, QKV, NO, token, O_QC + h * 128, c.hi);
    FoxProb pr; pr.QKV = QKV; pr.cum = CUM + (size_t)h * S; pr.cb = pr.cum[P0]; pr.h = h; pr.qb = qb; pr.qlo = P0 + c.wid * 32; pr.qpos = token; pr.hi = c.hi; pr.tid = c.tid;
    pr.bias = (const LAS float*)(c.lds + L_BIAS);
    {
        LAS int* a0w = (LAS int*)(c.lds + L_MISC);
        float dl = 0.f;
#pragma unroll
        for (int d0 = 0; d0 < 8; ++d0) { const v4u kw = *(const GAS v4u*)(QKV + (size_t)token * NO + O_KC + h * 128 + d0 * 16 + c.hi * 8); const v4u qw = __builtin_bit_cast(v4u, qr[d0]);
            dl += bf2f(qw.x & 0xffffu) * bf2f(kw.x & 0xffffu) + bf2f(qw.x >> 16) * bf2f(kw.x >> 16) + bf2f(qw.y & 0xffffu) * bf2f(kw.y & 0xffffu) + bf2f(qw.y >> 16) * bf2f(kw.y >> 16);
            dl += bf2f(qw.z & 0xffffu) * bf2f(kw.z & 0xffffu) + bf2f(qw.z >> 16) * bf2f(kw.z >> 16) + bf2f(qw.w & 0xffffu) * bf2f(kw.w & 0xffffu) + bf2f(qw.w >> 16) * bf2f(kw.w >> 16); }
        dl = (dl + __shfl_xor(dl, 32)) * SCALE;
#pragma unroll
        for (int ofs = 1; ofs < 32; ofs <<= 1) dl = fminf(dl, __shfl_xor(dl, ofs));
        LAS float* dmin = (LAS float*)(c.lds + L_MISC) + 16;
        if (c.lane == 0) dmin[c.wid] = dl;
        if (c.tid == 0) *a0w = 4 * qb;
        __syncthreads();
        float dlmin = dmin[0];
#pragma unroll
        for (int w = 1; w < NWAVES; ++w) dlmin = fminf(dlmin, dmin[w]);
        const float Bqk = FOXN[h * 2] * FOXN[h * 2 + 1] * SCALE * 1.01f + 1.f;
        const float thr = 110.f + Bqk - fmaxf(fminf(dlmin, Bqk), -Bqk) + 1.f;
        if (c.tid < 4 * qb && pr.cb - pr.cum[c.tid * 64 + 63] >= -thr) __hip_atomic_fetch_min(a0w, c.tid, __ATOMIC_RELAXED, __HIP_MEMORY_SCOPE_WORKGROUP);
        __syncthreads();
        pr.a0 = FOX_SKIP ? *a0w : 0;
        __syncthreads();
    }
    float m_reg = -1e30f, l_reg = 0.f; f32x16 o[4];
#pragma unroll
    for (int d = 0; d < 4; ++d)
#pragma unroll
        for (int r = 0; r < 16; ++r) o[d][r] = 0.f;
    run<0>(c, pr, qr, m_reg, l_reg, o);
    float rc[16]; row_coefs(c, l_reg > 0.f ? 1.f / l_reg : 0.f, rc);
    store_o<false>(c, o, rc, O, P0 + c.wid * 32, h * 128);
}

struct CmpProb {
    const bf16* KC; const bf16* VC; int kvh, nt, nmax  , wnmax  , hi, r32, wid; LAS float* imp; float carry;
    DI int ntiles() const { return nt; }
    DI void src(int t, const bf16*& k, const bf16*& v, int& kp, int& vp) const { k = KC + (size_t)t * 64 * 256 + kvh * 128; v = VC + (size_t)t * 64 * 256 + kvh * 128; kp = 256; vp = 256; }
    DI float extra(int) const { return 0.f; }
    DI void put_extra(int, int, float) const {}
    DI bool active(int t) const { return t * 64 <= wnmax; }
    DI void mask(f32x16& p0, f32x16& p1, int t, int) const { mask_tile(p0, p1, nmax - 4 * hi - t * 64, 0x7fffffffu); }
    DI void post(f32x16& p0, f32x16& p1, int t, bool act) {
        if (!act) { carry = 0.f; return; }
        float G[8], L[8];
#pragma unroll
        for (int q = 0; q < 4; ++q) { G[q] = (p0[4 * q] + p0[4 * q + 1]) + (p0[4 * q + 2] + p0[4 * q + 3]); L[q] = p0[4 * q + 3];
                                      G[4 + q] = (p1[4 * q] + p1[4 * q + 1]) + (p1[4 * q + 2] + p1[4 * q + 3]); L[4 + q] = p1[4 * q + 3]; }
        float PL[8];
#pragma unroll
        for (int q = 0; q < 8; ++q) PL[q] = __shfl_xor(L[q], 32);
        float v[8];
        if (hi) {
#pragma unroll
            for (int q = 0; q < 8; ++q) v[q] = G[q] + PL[q];
        } else {
            v[0] = G[0] + carry;
#pragma unroll
            for (int q = 1; q < 8; ++q) v[q] = G[q] + PL[q - 1];
            carry = PL[7];
        }
#pragma unroll
        for (int q = 0; q < 8; ++q) { float s = v[q]; s += __shfl_xor(s, 1); s += __shfl_xor(s, 2);
            if ((r32 & 3) == 0) imp[(wid * 8 + (r32 >> 2)) * IMP_STRIDE + 16 * t + 2 * q + hi] = s; }
    }
};
struct SlcProb {
    const bf16* QKV; int kvh, ch, qlo, qpos, hi; const LAS unsigned* sw;
    DI int ntiles() const { return ch + 1; }
    DI void src(int t, const bf16*& k, const bf16*& v, int& kp, int& vp) const { const size_t key0 = (size_t)t * 64; k = QKV + key0 * NO + O_KSLC + kvh * 128; v = QKV + key0 * NO + O_VSLC + kvh * 128; kp = NO; vp = NO; }
    DI float extra(int) const { return 0.f; }
    DI void put_extra(int, int, float) const {}
    DI bool sel(int t) const { return (sw[t >> 5] >> (t & 31)) & 1u; }
    DI bool active(int t) const { return __any(sel(t)); }
    DI void mask(f32x16& p0, f32x16& p1, int t, int) const { if (!sel(t)) kill_tile(p0, p1); else if (t == ch) mask_tile(p0, p1, qpos - 4 * hi - t * 64, 0x7fffffffu); }
    DI void post(f32x16&, f32x16&, int, bool) const {}
};
DI float sigmoid_f(float v) { return 1.f / (1.f + expf(-v)); }
#define ZERO_O(o) do { _Pragma("unroll") for (int d_ = 0; d_ < 4; ++d_) _Pragma("unroll") for (int r_ = 0; r_ < 16; ++r_) o[d_][r_] = 0.f; } while (0)
DI void nsa_unit(LAS unsigned char* lds_, const bf16* QKV, const bf16* KC, const bf16* VC, const float* FG, bf16* O, float* scr  , int kvh, int ch) {
    const int T0 = ch * 64;
    LAS float* imp = (LAS float*)((LAS char*)lds_ + L_IMP);
    LAS unsigned short* sel16 = (LAS unsigned short*)((LAS char*)lds_ + L_SEL);
    { const int t0_ = tid_fresh(); for (int e = t0_; e < 64 * IMP_STRIDE; e += NWAVES * 64) imp[e] = 0.f; }
    for (int rep_ = 0; rep_ < ((NSA_DUP & 1) ? 2 : 1); ++rep_) {
        const Cx c = make_cx(lds_); const int tl = c.wid * 8 + (c.r32 >> 2), hq = kvh * 4 + (c.r32 & 3);
        int token = T0 + tl;
        bf16x8 qr[8]; load_q(qr, QKV, NO, token, O_QD + hq * 128, c.hi);
        f32x16 o[4]; float rc[16];
        CmpProb pr; pr.KC = KC; pr.VC = VC; pr.kvh = kvh; pr.hi = c.hi; pr.r32 = c.r32; pr.wid = c.wid; pr.imp = imp; pr.carry = 0.f;
        const int nmax_chunk = (T0 + 63 - 31) >> 4;
        pr.nt = nmax_chunk / 64 + 1; pr.nmax = (token - 31) >> 4; pr.wnmax = (T0 + c.wid * 8 + 7 - 31) >> 4;
        float m_reg = -1e30f, l_reg = 0.f; ZERO_O(o);
        run<0>(c, pr, qr, m_reg, l_reg, o);
        const float g_cmp = sigmoid_f(FG[(size_t)(8 + hq * 3 + 0) * S + token]);
        row_coefs(c, l_reg > 0.f ? g_cmp / l_reg : 0.f, rc);
        { GAS f32x4* sp = (GAS f32x4*)(scr + (size_t)c.tid * 64);
#pragma unroll
        for (int d = 0; d < 4; ++d)
#pragma unroll
            for (int q = 0; q < 4; ++q) sp[d * 4 + q] = (f32x4){o[d][4 * q] * rc[4 * q], o[d][4 * q + 1] * rc[4 * q + 1], o[d][4 * q + 2] * rc[4 * q + 2], o[d][4 * q + 3] * rc[4 * q + 3]}; }
        pr.carry = 0.f;
        run<1>(c, pr, qr, m_reg, l_reg, o);
    }
    for (int rep_ = 0; rep_ < ((NSA_DUP & 2) ? 2 : 1); ++rep_) {
        const int tf_ = tid_fresh(); const int tk = tf_ >> 3, q = tf_ & 7;
        const LAS float* row = imp + tk * IMP_STRIDE;
        float v[16]; int rank[16];
#pragma unroll
        for (int e = 0; e < 16; ++e) { const int j = 16 * q + e; float x = row[j]; if (j == 0 || j == ch || j == ch - 1) x = __builtin_inff(); if (j > ch) x = -__builtin_inff(); v[e] = x; rank[e] = 0; }
        for (int i0 = 0; i0 <= ch; i0 += 4) { const f32x4 xr = *(const LAS f32x4*)(row + i0);
#pragma unroll
            for (int u = 0; u < 4; ++u) { const int i = i0 + u; float x = xr[u]; if (i == 0 || i == ch || i == ch - 1) x = __builtin_inff(); if (i > ch) x = -__builtin_inff();
#pragma unroll
                for (int e = 0; e < 16; ++e) { const int j = 16 * q + e; rank[e] += (x > v[e] || (x == v[e] && i < j)) ? 1 : 0; } } }
        unsigned m = 0u;
#pragma unroll
        for (int e = 0; e < 16; ++e) { const int j = 16 * q + e; if (j <= ch && rank[e] < (BREAK == 9 ? 15 : 16)) m |= 1u << e; }
        sel16[tk * 8 + q] = (unsigned short)m;
    }
    __syncthreads();
    for (int rep_ = 0; rep_ < ((NSA_DUP & 4) ? 2 : 1); ++rep_) {
        const Cx c = make_cx(lds_); const int tl = c.wid * 8 + (c.r32 >> 2), hq = kvh * 4 + (c.r32 & 3);
        int token = T0 + tl;
        bf16x8 qr[8]; load_q(qr, QKV, NO, token, O_QD + hq * 128, c.hi);
        f32x16 o[4]; float rc[16];
        SlcProb pr; pr.QKV = QKV; pr.kvh = kvh; pr.ch = ch; pr.qlo = T0 + c.wid * 8; pr.qpos = token; pr.hi = c.hi;
        pr.sw = (const LAS unsigned*)(c.lds + L_SEL) + tl * 4;
        float m_reg = -1e30f, l_reg = 0.f; ZERO_O(o);
        run<0>(c, pr, qr, m_reg, l_reg, o);
        const float g_slc = sigmoid_f(FG[(size_t)(8 + hq * 3 + 1) * S + token]);
        row_coefs(c, l_reg > 0.f ? g_slc / l_reg : 0.f, rc);
        { GAS f32x4* sp = (GAS f32x4*)(scr + 32768 + (size_t)c.tid * 64);
#pragma unroll
        for (int d = 0; d < 4; ++d)
#pragma unroll
            for (int q = 0; q < 4; ++q) sp[d * 4 + q] = (f32x4){o[d][4 * q] * rc[4 * q], o[d][4 * q + 1] * rc[4 * q + 1], o[d][4 * q + 2] * rc[4 * q + 2], o[d][4 * q + 3] * rc[4 * q + 3]}; }
    }
    for (int rep_ = 0; rep_ < ((NSA_DUP & 8) ? 2 : 1); ++rep_) {
        const Cx c = make_cx(lds_); const int tl = c.wid * 8 + (c.r32 >> 2), hq = kvh * 4 + (c.r32 & 3);
        int token = T0 + tl;
        bf16x8 qr[8]; load_q(qr, QKV, NO, token, O_QD + hq * 128, c.hi);
        f32x16 o[4]; float rc[16];
        WinProb pr; pr.QKV = QKV; pr.pitch = NO; pr.kcol = O_KWIN + kvh * 128; pr.vcol = O_VWIN + kvh * 128; pr.t0 = ch >= 8 ? ch - 8 : 0; pr.nt = ch + 1 - pr.t0;
        pr.qlo = T0 + c.wid * 8; pr.qpos = token; pr.hi = c.hi; pr.W = 512u;
        float m_reg = -1e30f, l_reg = 0.f; ZERO_O(o);
        run<0>(c, pr, qr, m_reg, l_reg, o);
        const float g_win = sigmoid_f(FG[(size_t)(8 + hq * 3 + 2) * S + token]);
        row_coefs(c, l_reg > 0.f ? g_win / l_reg : 0.f, rc);
        { const GAS f32x4* s0 = (const GAS f32x4*)(scr + (size_t)c.tid * 64); const GAS f32x4* s1 = (const GAS f32x4*)(scr + 32768 + (size_t)c.tid * 64);
#pragma unroll
        for (int d = 0; d < 4; ++d) {
#pragma unroll
            for (int q = 0; q < 4; ++q) { const f32x4 x = s0[d * 4 + q] + s1[d * 4 + q];
#pragma unroll
                for (int e = 0; e < 4; ++e) o[d][4 * q + e] = o[d][4 * q + e] * rc[4 * q + e] + x[e]; }
            asm volatile("" ::: "memory"); } }
#pragma unroll
        for (int r = 0; r < 16; ++r) rc[r] = 1.f;
        store_o<true>(c, o, rc, O, T0 + c.wid * 8, 1024 + kvh * 512);
    }
}
}

#if defined(CHECK) && CHECK
namespace chk {
constexpr int CW_CHK = 12288;
DI float wmax(float v) {
#pragma unroll
    for (int o = 1; o < 64; o <<= 1) v = fmaxf(v, __shfl_xor(v, o));
    return v; }
DI float wsum(float v) {
#pragma unroll
    for (int o = 1; o < 64; o <<= 1) v += __shfl_xor(v, o);
    return v; }
DI float ldbf(const bf16* p) { return bf2f((unsigned)*p); }
DI int sample_token(int i) {
    const int fixed[40] = {0, 1, 2, 15, 16, 30, 31, 32, 46, 47, 48, 63, 64, 65, 95, 126, 127, 128, 129, 191, 255, 256, 257, 300, 511, 512, 513, 767, 1023, 1024, 1025, 2047, 2048, 4095, 4096, 4097, 6000, 8000, 8190, 8191};
    if (i < 40) return fixed[i];
    return (int)(((unsigned)i * 2654435761u) >> 19) & 8191; }
DI void report(gu32* ctl, int id, bool bad, int lane) { if (bad && lane == 0) __hip_atomic_fetch_add(ctl + CW_CHK + id, 1u, RLX_AGENT); }

DI float dot128(const unsigned* qp, const bf16* krow) {
    float acc = 0.f;
#pragma unroll
    for (int i = 0; i < 16; ++i) { const v4u w = *(const GAS v4u*)(krow + 8 * i);
        acc += bf2f(qp[4 * i] & 0xffffu) * bf2f(w.x & 0xffffu) + bf2f(qp[4 * i] >> 16) * bf2f(w.x >> 16);
        acc += bf2f(qp[4 * i + 1] & 0xffffu) * bf2f(w.y & 0xffffu) + bf2f(qp[4 * i + 1] >> 16) * bf2f(w.y >> 16);
        acc += bf2f(qp[4 * i + 2] & 0xffffu) * bf2f(w.z & 0xffffu) + bf2f(qp[4 * i + 2] >> 16) * bf2f(w.z >> 16);
        acc += bf2f(qp[4 * i + 3] & 0xffffu) * bf2f(w.w & 0xffffu) + bf2f(qp[4 * i + 3] >> 16) * bf2f(w.w >> 16); }
    return acc; }
template <class Vis>
DI void naive_attn(const unsigned* qp, const bf16* K, int kpitch, const bf16* V, int vpitch, int s_lo, int s_hi, Vis vis, float sink, int lane, float& o0, float& o1) {
    const float NEG = -__builtin_inff();
    float m = sink;
    for (int s0 = s_lo; s0 <= s_hi; s0 += 64) { const int s = s0 + lane; float lg = NEG;
        if (s <= s_hi) { const float b = vis(s); if (b > NEG) lg = dot128(qp, K + (size_t)s * kpitch) * att::SCALE + b; }
        m = fmaxf(m, wmax(lg)); }
    float l = 0.f, a0 = 0.f, a1 = 0.f;
    if (m > NEG) {
        if (sink > NEG) l = expf(sink - m);
        for (int s0 = s_lo; s0 <= s_hi; s0 += 64) { const int s = s0 + lane; float p = 0.f;
            if (s <= s_hi) { const float b = vis(s); if (b > NEG) p = expf(dot128(qp, K + (size_t)s * kpitch) * att::SCALE + b - m); }
            l += wsum(p);
            const int nk = (s_hi - s0 + 1) < 64 ? (s_hi - s0 + 1) : 64;
            for (int k = 0; k < nk; ++k) { const float pk = __shfl(p, k); if (pk != 0.f) { const unsigned w = *(const GAS unsigned*)(V + (size_t)(s0 + k) * vpitch + 2 * lane); a0 += pk * bf2f(w & 0xffffu); a1 += pk * bf2f(w >> 16); } } }
    }
    const float inv = l > 0.f ? 1.f / l : 0.f; o0 = a0 * inv; o1 = a1 * inv; }
DI void load_qp(unsigned* qp, const bf16* qrow) {
#pragma unroll
    for (int i = 0; i < 16; ++i) { const v4u w = *(const GAS v4u*)(qrow + 8 * i); qp[4 * i] = w.x; qp[4 * i + 1] = w.y; qp[4 * i + 2] = w.z; qp[4 * i + 3] = w.w; } }
DI bool cmp_out(float o0, float o1, const bf16* orow, int lane) {
    const unsigned w = *(const GAS unsigned*)(orow + 2 * lane); const float f0 = bf2f(w & 0xffffu), f1 = bf2f(w >> 16);
    const float d = wmax(fmaxf(fabsf(f0 - o0), fabsf(f1 - o1))), sc = wmax(fmaxf(fabsf(o0), fabsf(o1)));
    return !(d <= 0.012f * sc + 2e-5f); }

__global__ void __launch_bounds__(256) chk_inproj(Args a, int l) {
    const int lane = threadIdx.x & 63, gw = (blockIdx.x * 256 + threadIdx.x) >> 6, nw = gridDim.x * 4; const bool odd = l & 1; const int j = l >> 1;
    gu32* ctl = (gu32*)(a.ws + WS_CTL); const bf16* QKV = (const bf16*)(a.ws + WS_QKV); const float* FG = (const float*)(a.ws + WS_FG);
    const int N = odd ? NO : NE, NS = odd ? NO_SRC : NE; const float* W = odd ? a.odd_w_in + (size_t)j * DM * NO_SRC : a.even_w_in + (size_t)j * DM * NE;
    for (int smp = gw; smp < 6000; smp += nw) {
        const int t = sample_token(smp % 97), nd = (int)(((unsigned)smp * 2246822519u) >> 8) % (odd ? 5664 : NE);
        const int sec_rope = odd ? ((nd >= O_QD && nd < O_VCMP) || (nd >= O_KSLC && nd < O_VSLC) || (nd >= O_KWIN && nd < O_VWIN)) : (nd < E_VA || (nd >= E_QB && nd < E_VB));
        const int d = nd & 127, ndp = sec_rope ? (d < 64 ? nd + 64 : nd - 64) : nd;
        const int sc0 = odd ? odd_src_col(nd) : nd, sc1 = odd ? odd_src_col(ndp) : ndp;
        const float* xr = ((l == 0) ? a.x : a.out) + (size_t)t * DM; const float* mods = (const float*)(a.ws + WS_MODS) + (size_t)l * 6 * DM;
        float sq = 0.f; for (int k = lane; k < DM; k += 64) sq += xr[k] * xr[k];
        const float rstd = 1.f / sqrtf(wsum(sq) * (1.f / DM) + NORM_EPS);
        float s0 = 0.f, s1 = 0.f;
        for (int k = lane; k < DM; k += 64) { const float h = xr[k] * rstd * mods[DM + k] + mods[k]; s0 += h * W[(size_t)k * NS + sc0]; s1 += h * W[(size_t)k * NS + sc1]; }
        s0 = wsum(s0); s1 = wsum(s1);
        float ref = s0;
        if (sec_rope) { const int dd = d & 63; const float inv = 1.0f / powf(10000.0f, (float)dd / 64.0f); const float ang = (float)t * inv; const float cv = cosf(ang), sv = sinf(ang);
            ref = (d < 64) ? s0 * cv - s1 * sv : s1 * sv + s0 * cv; }
        float got;
        if (odd && nd >= O_FG) got = FG[(size_t)(nd - O_FG) * S + t]; else got = ldbf(QKV + (size_t)t * N + nd);
        report(ctl, 1 + (odd ? 1 : 0), !(fabsf(got - ref) <= 0.03f * (fabsf(ref) + 0.3f)), lane);
    }
}
__global__ void __launch_bounds__(256) chk_prep(Args a, int l) {
    const int lane = threadIdx.x & 63, gw = (blockIdx.x * 256 + threadIdx.x) >> 6, nw = gridDim.x * 4; const bool odd = l & 1; const int j = l >> 1;
    gu32* ctl = (gu32*)(a.ws + WS_CTL); const bf16* QKV = (const bf16*)(a.ws + WS_QKV);
    if (!odd) {
        const bf16* KMH = (const bf16*)(a.ws + WS_KMH); const bf16* KML = (const bf16*)(a.ws + WS_KML);
        for (int u = gw; u < 256; u += nw) { const int h = u >> 5, blk = u & 31; float s0 = 0.f, s1 = 0.f;
            for (int k = 0; k < 256; ++k) { const unsigned w = *(const GAS unsigned*)(QKV + (size_t)(blk * 256 + k) * NE + E_KA + h * 128 + 2 * lane); s0 += bf2f(w & 0xffffu); s1 += bf2f(w >> 16); }
            s0 *= (1.f / 256.f); s1 *= (1.f / 256.f);
            const float g0 = ldbf(KMH + (size_t)u * 128 + 2 * lane) + ldbf(KML + (size_t)u * 128 + 2 * lane), g1 = ldbf(KMH + (size_t)u * 128 + 2 * lane + 1) + ldbf(KML + (size_t)u * 128 + 2 * lane + 1);
            const float dd = wmax(fmaxf(fabsf(g0 - s0), fabsf(g1 - s1)));
            report(ctl, 3, !(dd <= 3e-5f), lane); }
    } else {
        const float* FG = (const float*)(a.ws + WS_FG); const float* CUM = (const float*)(a.ws + WS_CUM);
        if (gw < 8) { const int h = gw;
            bool bad = false;
            if (lane == 0) { double run = 0.0; const float fb = a.fox_forget_b[j * 8 + h];
                for (int t = 0; t < S; ++t) { const double x = (double)FG[(size_t)h * S + t] + (double)fb; run += (x < 0 ? x - log1p(exp(x)) : -log1p(exp(-x)));
                    if (!(fabs((double)CUM[(size_t)h * S + t] - run) <= 2e-3 + 1e-5 * fabs(run))) bad = true; } }
            report(ctl, 4, __any(bad), lane); }
        for (int smp = gw; smp < 8 + 600; smp += nw) { if (smp < 8) continue;
            const int q = smp - 8, kind = q & 1, hd = (q >> 1) & 1, n = (q < 40) ? (q < 20 ? (q >> 2) : 510 - ((q - 20) >> 2)) : (int)(((unsigned)q * 2654435761u) >> 20) % NCMP;
            const int srccol = (kind ? O_VCMP : O_KCMP) + hd * 128;
            const float* pos = (kind ? a.nsa_v_pos : a.nsa_k_pos) + (size_t)j * 32 * 128; const float* w1 = (kind ? a.nsa_v_w1 : a.nsa_k_w1) + (size_t)j * 4096 * 128; const float* w2 = (kind ? a.nsa_v_w2 : a.nsa_k_w2) + (size_t)j * 128 * 128;
            float h0 = 0.f, h1 = 0.f;
            for (int k = 0; k < 4096; ++k) { const int ll = k >> 7, d = k & 127; const float x = ldbf(QKV + (size_t)(16 * n + ll) * NO + srccol + d) + pos[ll * 128 + d]; h0 += x * w1[(size_t)k * 128 + lane]; h1 += x * w1[(size_t)k * 128 + lane + 64]; }
            h0 = gelu_tanh_f(h0); h1 = gelu_tanh_f(h1);
            float o0 = 0.f, o1 = 0.f;
            for (int c = 0; c < 128; ++c) { const float hv = __shfl(c < 64 ? h0 : h1, c & 63); o0 += hv * w2[c * 128 + lane]; o1 += hv * w2[c * 128 + lane + 64]; }
            const bf16* dst = (const bf16*)(a.ws + (kind ? WS_VC : WS_KC)) + (size_t)n * 256 + hd * 128;
            const float f0 = ldbf(dst + lane), f1 = ldbf(dst + lane + 64);
            const float dd = wmax(fmaxf(fabsf(f0 - o0), fabsf(f1 - o1))), sc = wmax(fmaxf(fabsf(o0), fabsf(o1)));
            report(ctl, 5, !(dd <= 0.03f * sc + 1e-3f), lane); }
    }
}
__global__ void __launch_bounds__(256) chk_attn(Args a, int l) {
    __shared__ float imp_s[4][128]; __shared__ unsigned sel_s[4][4];
    const int lane = threadIdx.x & 63, wv = threadIdx.x >> 6, gw = (blockIdx.x * 256 + threadIdx.x) >> 6, nw = gridDim.x * 4; const bool odd = l & 1; const int j = l >> 1;
    gu32* ctl = (gu32*)(a.ws + WS_CTL); const bf16* QKV = (const bf16*)(a.ws + WS_QKV); const bf16* OB = (const bf16*)(a.ws + WS_O);
    const float NEG = -__builtin_inff();
    unsigned qp[64];
    if (!odd) {
        const bf16* KMH = (const bf16*)(a.ws + WS_KMH); const bf16* KML = (const bf16*)(a.ws + WS_KML);
        for (int smp = gw; smp < 1600; smp += nw) {
            const int t = sample_token(smp >> 3), h = smp & 7;
            {
                load_qp(qp, QKV + (size_t)t * NE + E_QA + h * 128);
                const int own = t >> 8;
                float g = NEG;
                if (lane < own) g = dot128(qp, KMH + ((size_t)h * 32 + lane) * 128) + dot128(qp, KML + ((size_t)h * 32 + lane) * 128);
                int rank = 0;
                for (int i = 0; i < 32; ++i) { const float gi = __shfl(g, i); rank += (gi > g || (gi == g && i < lane)) ? 1 : 0; }
                const unsigned long long bal = __ballot(lane < own && rank < 3);
                const unsigned selm = (unsigned)bal;
                float o0, o1;
                naive_attn(qp, QKV + E_KA + h * 128, NE, QKV + E_VA + h * 128, NE, 0, t, [&](int s) { const int b = s >> 8; return (b == own || ((selm >> b) & 1u)) ? 0.f : NEG; }, NEG, lane, o0, o1);
                report(ctl, 6, cmp_out(o0, o1, OB + (size_t)t * DM + h * 128, lane), lane);
            }
            {
                load_qp(qp, QKV + (size_t)t * NE + E_QB + h * 128);
                float o0, o1; const int lo = t - 127 > 0 ? t - 127 : 0;
                naive_attn(qp, QKV + E_KB + (h >> 2) * 128, NE, QKV + E_VB + (h >> 2) * 128, NE, lo, t, [&](int) { return 0.f; }, a.even_sinks[j * 8 + h], lane, o0, o1);
                report(ctl, 7, cmp_out(o0, o1, OB + (size_t)t * DM + 1024 + h * 128, lane), lane);
            }
        }
    } else {
        const float* CUM = (const float*)(a.ws + WS_CUM); const float* FG = (const float*)(a.ws + WS_FG);
        const bf16* KC = (const bf16*)(a.ws + WS_KC); const bf16* VC = (const bf16*)(a.ws + WS_VC);
        for (int smp = gw; smp < 1600; smp += nw) {
            const int t = sample_token(smp >> 3), h = smp & 7;
            {
                load_qp(qp, QKV + (size_t)t * NO + O_QC + h * 128);
                const float* ch = CUM + (size_t)h * S; const float ct = ch[t];
                float o0, o1;
                naive_attn(qp, QKV + O_KC + h * 128, NO, QKV + O_VC + h * 128, NO, 0, t, [&](int s) { return ct - ch[s]; }, NEG, lane, o0, o1);
                report(ctl, 8, cmp_out(o0, o1, OB + (size_t)t * DM + h * 128, lane), lane);
            }
            {
                const int kvh = h >> 2, cur = t >> 6, nmax = (t - 31) >> 4;
                for (int i = lane; i < 128; i += 64) imp_s[wv][i] = 0.f;
                __builtin_amdgcn_wave_barrier();
                for (int g = 0; g < 4; ++g) {
                    load_qp(qp, QKV + (size_t)t * NO + O_QD + (kvh * 4 + g) * 128);
                    float lg[8]; float m = NEG;
#pragma unroll
                    for (int i = 0; i < 8; ++i) { const int n = lane + 64 * i; lg[i] = (n <= nmax) ? dot128(qp, KC + (size_t)n * 256 + kvh * 128) * att::SCALE : NEG; m = fmaxf(m, lg[i]); }
                    m = wmax(m);
                    if (m > NEG) { float ls = 0.f;
#pragma unroll
                        for (int i = 0; i < 8; ++i) { lg[i] = (lg[i] > NEG) ? expf(lg[i] - m) : 0.f; ls += lg[i]; }
                        ls = wsum(ls);
#pragma unroll
                        for (int i = 0; i < 8; ++i) { const int n = lane + 64 * i; const float p = lg[i] / ls;
                            if (p != 0.f) { atomicAdd(&imp_s[wv][n >> 2], p); if ((n & 3) == 3 && (n >> 2) + 1 < 128) atomicAdd(&imp_s[wv][(n >> 2) + 1], p); } } }
                }
                __builtin_amdgcn_wave_barrier();
                asm volatile("s_waitcnt lgkmcnt(0)" ::: "memory");
                float v0, v1; { const int j0 = lane, j1 = lane + 64; v0 = imp_s[wv][j0]; v1 = imp_s[wv][j1];
                    if (j0 == 0 || j0 == cur || j0 == cur - 1) v0 = __builtin_inff(); if (j0 > cur) v0 = NEG;
                    if (j1 == 0 || j1 == cur || j1 == cur - 1) v1 = __builtin_inff(); if (j1 > cur) v1 = NEG; }
                int r0 = 0, r1 = 0;
                for (int i = 0; i < 128; ++i) { const float x = __shfl(i < 64 ? v0 : v1, i & 63); r0 += (x > v0 || (x == v0 && i < lane)) ? 1 : 0; r1 += (x > v1 || (x == v1 && i < lane + 64)) ? 1 : 0; }
                const unsigned long long b0 = __ballot(r0 < 16 && lane <= cur), b1 = __ballot(r1 < 16 && lane + 64 <= cur);
                if (lane == 0) { sel_s[wv][0] = (unsigned)b0; sel_s[wv][1] = (unsigned)(b0 >> 32); sel_s[wv][2] = (unsigned)b1; sel_s[wv][3] = (unsigned)(b1 >> 32); }
                __builtin_amdgcn_wave_barrier();
                asm volatile("s_waitcnt lgkmcnt(0)" ::: "memory");
                const unsigned m0 = sel_s[wv][0], m1 = sel_s[wv][1], m2 = sel_s[wv][2], m3 = sel_s[wv][3];
                load_qp(qp, QKV + (size_t)t * NO + O_QD + h * 128);
                float c0, c1, s0, s1, w0, w1;
                naive_attn(qp, KC + kvh * 128, 256, VC + kvh * 128, 256, 0, nmax, [&](int) { return 0.f; }, NEG, lane, c0, c1);
                naive_attn(qp, QKV + O_KSLC + kvh * 128, NO, QKV + O_VSLC + kvh * 128, NO, 0, t, [&](int s) { const int b = s >> 6; const unsigned mm = (b < 32) ? m0 : (b < 64 ? m1 : (b < 96 ? m2 : m3)); return ((mm >> (b & 31)) & 1u) ? 0.f : NEG; }, NEG, lane, s0, s1);
                const int lo = t - 511 > 0 ? t - 511 : 0;
                naive_attn(qp, QKV + O_KWIN + kvh * 128, NO, QKV + O_VWIN + kvh * 128, NO, lo, t, [&](int) { return 0.f; }, NEG, lane, w0, w1);
                const float* gp = FG + (size_t)(8 + h * 3) * S + t; const float g0 = att::sigmoid_f(gp[0]), g1 = att::sigmoid_f(gp[S]), g2 = att::sigmoid_f(gp[2 * S]);
                report(ctl, 9, cmp_out(g0 * c0 + g1 * s0 + g2 * w0, g0 * c1 + g1 * s1 + g2 * w1, OB + (size_t)t * DM + 1024 + h * 128, lane), lane);
            }
        }
    }
}
__global__ void chk_poison(Args a) {
    if (threadIdx.x != 0 || blockIdx.x != 0) return;
    gu32* ctl = (gu32*)(a.ws + WS_CTL);
    const unsigned allow[10] = {0, 0, 0, 0, 0, 0, 3, 0, 0, 3};
    for (int k = 1; k <= 9; ++k) if (__hip_atomic_load(ctl + CW_CHK + k, RLX_AGENT) > allow[k]) { a.out[0] = 16.f * (float)k; return; }
}
}
#endif

#ifndef MK_PER_PHASE
#define MK_PER_PHASE 0
#endif
constexpr int PH_PER_LAYER = 10, N_PHASES = 2 + 4 * PH_PER_LAYER;
#ifndef DUP_MASK
#define DUP_MASK 0
#endif
#define DUP(b) ((DUP_MASK >> (b)) & 1)
#ifndef ODD_NSPLIT
#define ODD_NSPLIT 64
#endif
#ifndef EVEN_SPLIT
#define EVEN_SPLIT 1
#endif

__global__ void __launch_bounds__(NWAVES * 64, 2) fwd(Args a_unused) {
    extern __shared__ __attribute__((aligned(16))) unsigned char lds_raw[];
    LAS unsigned char* const lds = (LAS unsigned char*)lds_raw;
    volatile LAS unsigned* MISC = (volatile LAS unsigned*)(lds + MISC_OFF);
    { const int t0 = tid_fresh(); for (int u = t0; u < (LDS_BYTES - LDSCTL_OFF) / 4; u += NWAVES * 64) ((LAS unsigned*)(lds + LDSCTL_OFF))[u] = 0u; }
    __syncthreads();
    int lo, hi; { KA a = kargs(); lo = a->ph_lo; hi = a->ph_hi; }
    XcdBarrier bar; { KA a = kargs(); bar.bar = (unsigned*)((gu32*)(a->ws + WS_CTL) + CW_BAR); bar.x = 0; bar.st = nullptr;
        if (hi - lo > 1) bar = xcd_barrier_post(bar.bar, MISC + 8); }
#define IN(k) (lo <= (k) && (k) < hi)
#define SEAM(k) do { if (IN(k) && IN((k) + 1)) { xcd_barrier(bar); if (DUP(12)) xcd_barrier(bar); } } while (0)
#define DEQUEUE(idx, qhead, qslot) do { if (tid_fresh() == 0) *(qslot) = (int)__hip_atomic_fetch_add((qhead), 1u, RLX_AGENT); __syncthreads(); idx = *(qslot); __syncthreads(); } while (0)

    if (IN(0)) { if (DUP(0)) { { const Ctx C = make_ctx(lds); p0_prologue(kargs(), C); } xcd_barrier(bar); }
        { const Ctx C = make_ctx(lds); p0_prologue(kargs(), C); } SEAM(0); }

    for (int l = 0; l < DEPTH; ++l) {
        const int pb = 1 + PH_PER_LAYER * l, j = l >> 1; const bool odd = l & 1;
        if (IN(pb + 0) && l == 0) { KA a = kargs(); unsigned char* ws = a->ws; const Ctx C = make_ctx(lds); const float* mods = (const float*)(ws + WS_MODS);
            if (DUP(1)) { norm_phase(C, a->x, mods + 1 * DM, (bf16*)(ws + WS_H), (float*)(ws + WS_SS)); for (int it = blockIdx.x; it < bias_in_items(0); it += gridDim.x) bias_item(ws, 0, 0, it); xcd_barrier(bar); }
            norm_phase(C, a->x, mods + 1 * DM, (bf16*)(ws + WS_H), (float*)(ws + WS_SS)); for (int it = blockIdx.x; it < bias_in_items(0); it += gridDim.x) bias_item(ws, 0, 0, it); SEAM(pb + 0); }
        if (IN(pb + 1)) {
            KA a = kargs(); unsigned char* ws = a->ws;
            const int N = odd ? NO : NE;
            pg8::Gemm g{(const bf16*)(ws + WS_H), (const bf16*)(ws + WS_W + (size_t)l * W_LAYER + W_IN), S, N, DM}; pg8::StaticOrder So; So.init(S, N, (int)gridDim.x, (int)blockIdx.x);
            LAS float* etab = (LAS float*)(lds + EPITAB_OFF);
            const float* ssp = (const float*)(ws + WS_SS); const float* bip = (const float*)(ws + WS_BIAS) + (size_t)l * (NO + DFF);
            pg8::EpiIn E{(bf16*)(ws + WS_QKV), N, (float*)(ws + WS_FG), odd ? 1 : 0, etab};
            if ((DUP(2) && !odd) || (DUP(3) && odd)) { pg8::epi_preload(So, ssp, bip, etab); pg8::gemm_phase<pg8::EpiIn, pg8::StaticOrder, true, true>(lds + RING_OFF, g, So, E); xcd_barrier(bar); }
            if (odd || !EVEN_SPLIT) { pg8::epi_preload(So, ssp, bip, etab); pg8::gemm_phase<pg8::EpiIn, pg8::StaticOrder, true, true>(lds + RING_OFF, g, So, E); }
            else {
                pg8::MapOrder Mo; Mo.init(S, 16, (int)gridDim.x, (int)blockIdx.x, 10, 2);
                pg8::epi_preload(Mo, ssp, bip, etab);
                pg8::gemm_phase<pg8::EpiIn, pg8::MapOrder, true, true>(lds + RING_OFF, g, Mo, E); }
            SEAM(pb + 1);
        }
        if (IN(pb + 2)) {
            KA a = kargs(); unsigned char* ws = a->ws; const Ctx C = make_ctx(lds);
            if (DUP(4) || (DUP(13) && !odd) || (DUP(14) && odd)) { if (!odd) kmean_phase(C, (const bf16*)(ws + WS_QKV), (bf16*)(ws + WS_KMH), (bf16*)(ws + WS_KML)); else oddprep_phase(a, C, j); xcd_barrier(bar); }
            if (!odd) kmean_phase(C, (const bf16*)(ws + WS_QKV), (bf16*)(ws + WS_KMH), (bf16*)(ws + WS_KML));
            else oddprep_phase(a, C, j);
            SEAM(pb + 2);
        }
        const int nrep = ((DUP(5) && !odd) || (DUP(6) && odd)) ? 2 : 1;
        for (int rep = 0; rep < nrep; ++rep) {
        if (IN(pb + 3)) {
            KA a = kargs(); unsigned char* ws = a->ws;
            const bf16* QKV = (const bf16*)(ws + WS_QKV); bf16* OB = (bf16*)(ws + WS_O);
            LAS unsigned char* const alds = lds + RING_OFF;
            LAS int* qslot = (LAS int*)(lds + RING_OFF + 133120 + 1536);
            gu32* qhead = (gu32*)(ws + WS_CTL) + CW_Q + 64 * (l * 4 + rep);
            const int nhost = (int)gridDim.x < 64 ? (int)gridDim.x : 64;
            if (!odd && EVEN_SPLIT && (int)blockIdx.x < nhost) {
                pg8::Gemm g{(const bf16*)(ws + WS_H), (const bf16*)(ws + WS_W + (size_t)l * W_LAYER + W_IN), S, NE, DM};
                LAS float* etab = (LAS float*)(lds + EPITAB_OFF);
                pg8::EpiIn E{(bf16*)(ws + WS_QKV), NE, (float*)(ws + WS_FG), 0, etab};
                pg8::MapOrder Mo; Mo.init(S, 2, nhost, (int)blockIdx.x, 0, 10);
                pg8::epi_preload(Mo, (const float*)(ws + WS_SS), (const float*)(ws + WS_BIAS) + (size_t)l * (NO + DFF), etab);
                pg8::gemm_phase<pg8::EpiIn, pg8::MapOrder, true, true>(lds + RING_OFF, g, Mo, E);
                __syncthreads(); }
            gu32* fhead = (gu32*)(ws + WS_CTL) + CW_Q + 64 * (16 + l * 4 + rep);
            const int fwhich = odd ? 2 : 0; bool fmore = true;
            for (int it = 0;; ++it) {
                int idx;
                DEQUEUE(idx, qhead, qslot);
                if (idx >= 512) break;
                if (!odd) {
                    if (idx < 256) att::moba_gate_unit(alds, QKV, (const bf16*)(ws + WS_KMH), (const bf16*)(ws + WS_KML), (gu32*)(ws + WS_CTL) + CW_MCNT + 256 * (l + 4 * rep), (unsigned*)(ws + WS_MLIST), idx & 7, 31 - (idx >> 3));
                    else { const int i = idx - 256; att::swa_unit(alds, QKV, a->even_sinks + j * 8, OB, i & 1, i >> 1); }
                } else {
                    constexpr int NSPLIT = ODD_NSPLIT, NA = 2 * (128 - NSPLIT);
                    const bool is_nsa = idx < NA || idx >= NA + 256; const int i = idx < NA ? idx : idx - NA - 256, kvh = i & 1, ch = (idx < NA ? 127 : NSPLIT - 1) - (i >> 1);
                    const int fi = idx - NA, fh = fi & 7, fqb = 31 - (fi >> 3);
                    if (is_nsa) { if (DUP(11)) att::nsa_unit(alds, QKV, (const bf16*)(ws + WS_KC), (const bf16*)(ws + WS_VC), (const float*)(ws + WS_FG), OB, (float*)(ws + WS_NSASCR) + (size_t)blockIdx.x * 65536, kvh, ch);
                        att::nsa_unit(alds, QKV, (const bf16*)(ws + WS_KC), (const bf16*)(ws + WS_VC), (const float*)(ws + WS_FG), OB, (float*)(ws + WS_NSASCR) + (size_t)blockIdx.x * 65536, kvh, ch); }
                    else { if (DUP(10)) att::fox_unit(alds, QKV, (const float*)(ws + WS_CUM), (const float*)((const gu32*)(ws + WS_CTL) + CW_FOXN + 16 * j), OB, fh, fqb);
                        att::fox_unit(alds, QKV, (const float*)(ws + WS_CUM), (const float*)((const gu32*)(ws + WS_CTL) + CW_FOXN + 16 * j), OB, fh, fqb); }
                }
            }
            while (fmore) { int fi; DEQUEUE(fi, fhead, qslot); fmore = tail_item(a, ws, lds, l, fwhich, fi); __syncthreads(); }
            if (!odd) SEAM(pb + 3);
        }
        if (IN(pb + 4) && !odd) {
            KA a = kargs(); unsigned char* ws = a->ws;
            const bf16* QKV = (const bf16*)(ws + WS_QKV);
            LAS unsigned char* const alds = lds + RING_OFF;
            LAS int* qslot = (LAS int*)(lds + RING_OFF + 133120 + 1536);
            LAS int* pre = (LAS int*)(lds + RING_OFF + 133120);
            const gu32* cnt = (const gu32*)(ws + WS_CTL) + CW_MCNT + 256 * (l + 4 * rep);
            { const int tid = tid_fresh(), lane = tid & 63, wv = tid >> 6;
                const int nt = tid < 256 ? (int)((cnt[tid] + 255u) >> 8) : 0; int sc = nt;
#pragma unroll
                for (int o = 1; o < 64; o <<= 1) { const int n = __shfl_up(sc, o); if (lane >= o) sc += n; }
                if (tid < 256 && lane == 63) pre[260 + wv] = sc;
                __syncthreads();
                int base = 0; for (int w = 0; w < wv && w < 4; ++w) base += pre[260 + w];
                if (tid < 256) pre[tid + 1] = base + sc;
                if (tid == 0) pre[0] = 0;
                __syncthreads(); }
            const int total = 256 + pre[256];
            gu32* qhead = (gu32*)(ws + WS_CTL) + CW_Q + 64 * (l * 4 + 2 + rep);
            gu32* fhead = (gu32*)(ws + WS_CTL) + CW_Q + 64 * (16 + l * 4 + 2 + rep); bool fmore = true;
            for (int it = 0;; ++it) {
                int idx; DEQUEUE(idx, qhead, qslot);
                if (idx >= total) break;
                int h, jb, r;
                if (idx < 256) { h = idx & 7; jb = idx >> 3; r = -1; }
                else { const int g = idx - 256; int b0 = 0, b1 = 256; while (b1 - b0 > 1) { const int mid = (b0 + b1) >> 1; if (pre[mid] <= g) b0 = mid; else b1 = mid; } h = b0 >> 5; jb = b0 & 31; r = g - pre[b0]; }
                att::moba_blk_unit(alds, QKV, cnt, (const unsigned*)(ws + WS_MLIST), (bf16*)(ws + WS_MPO), (float*)(ws + WS_MML), h, jb, r);
            }
            while (fmore) { int fi; DEQUEUE(fi, fhead, qslot); fmore = tail_item(a, ws, lds, l, 1, fi); __syncthreads(); }
            SEAM(pb + 4);
        }
        if (IN(pb + 5) && !odd) { KA a = kargs(); unsigned char* ws = a->ws; const Ctx C = make_ctx(lds);
            moba_combine_phase(C, (const bf16*)(ws + WS_MPO), (const float*)(ws + WS_MML), (bf16*)(ws + WS_O)); }
        if (rep + 1 < nrep) xcd_barrier(bar);
        }
        if (IN(pb + 5) && IN(pb + 6)) xcd_barrier(bar);
        if (IN(pb + 6)) {
            KA a = kargs(); unsigned char* ws = a->ws; const float* mods = (const float*)(ws + WS_MODS) + (size_t)l * 6 * DM;
            pg8::Gemm g{(const bf16*)(ws + WS_O), (const bf16*)(ws + WS_W + (size_t)l * W_LAYER + W_OUT), S, DM, DM}; pg8::StaticOrder So; So.init(S, DM, (int)gridDim.x, (int)blockIdx.x);
            pg8::EpiRes E{(l == 0) ? a->x : a->out, a->out, DM, mods + 2 * DM, (bf16*)(ws + WS_H), mods + 4 * DM, (float*)(ws + WS_SS)};
            if (DUP(7)) { pg8::EpiRes E2{(l == 0) ? a->x : a->out, (float*)(ws + WS_U), DM, mods + 2 * DM, nullptr, nullptr, nullptr}; pg8::gemm_phase<pg8::EpiRes, pg8::StaticOrder, true, true>(lds + RING_OFF, g, So, E2); xcd_barrier(bar); }
            pg8::gemm_phase<pg8::EpiRes, pg8::StaticOrder, true, true>(lds + RING_OFF, g, So, E);
            SEAM(pb + 6);
        }
        if (IN(pb + 8)) {
            KA a = kargs(); unsigned char* ws = a->ws;
            pg8::Gemm g{(const bf16*)(ws + WS_H), (const bf16*)(ws + WS_W + (size_t)l * W_LAYER + W_UP), S, DFF, DM}; pg8::StaticOrder So; So.init(S, DFF, (int)gridDim.x, (int)blockIdx.x);
            LAS float* etab = (LAS float*)(lds + EPITAB_OFF);
            pg8::EpiRelu2 E{(bf16*)(ws + WS_U), DFF, etab};
            pg8::epi_preload(So, (const float*)(ws + WS_SS), (const float*)(ws + WS_BIAS) + (size_t)l * (NO + DFF) + NO, etab);
            if (DUP(8)) { pg8::gemm_phase<pg8::EpiRelu2, pg8::StaticOrder, true, true>(lds + RING_OFF, g, So, E); xcd_barrier(bar); }
            pg8::gemm_phase<pg8::EpiRelu2, pg8::StaticOrder, true, true>(lds + RING_OFF, g, So, E);
            SEAM(pb + 8);
        }
        if (IN(pb + 9)) {
            KA a = kargs(); unsigned char* ws = a->ws; const float* mods = (const float*)(ws + WS_MODS) + (size_t)l * 6 * DM;
            pg8::Gemm g{(const bf16*)(ws + WS_U), (const bf16*)(ws + WS_W + (size_t)l * W_LAYER + W_DOWN), S, DM, DFF}; pg8::StaticOrder So; So.init(S, DM, (int)gridDim.x, (int)blockIdx.x);
            const float* modsn = (const float*)(ws + WS_MODS) + (size_t)(l + 1) * 6 * DM;
            pg8::EpiRes E{a->out, a->out, DM, mods + 5 * DM, (l + 1 < DEPTH) ? (bf16*)(ws + WS_H) : nullptr, modsn + 1 * DM, (float*)(ws + WS_SS)};
            if (DUP(9)) { pg8::EpiRes E2{a->out, (float*)(ws + WS_QKV), DM, mods + 5 * DM, nullptr, nullptr, nullptr}; pg8::gemm_phase<pg8::EpiRes, pg8::StaticOrder, true, true>(lds + RING_OFF, g, So, E2); xcd_barrier(bar); }
            pg8::gemm_phase<pg8::EpiRes, pg8::StaticOrder, true, true>(lds + RING_OFF, g, So, E);
            SEAM(pb + 9);
        }
    }
    if (IN(N_PHASES - 1)) { KA a = kargs(); const Ctx C = make_ctx(lds); final_norm_phase(C, a->out, a->final_norm_g); }
#undef IN
#undef SEAM
#undef DEQUEUE
}

extern "C" void kernel_launch(void* const* d_in, const int* in_sizes, int n_in, void* d_out, int out_size, void* d_ws, size_t ws_size, hipStream_t stream) {
    static int grid = 0;
    if (grid == 0) {
        if (n_in != 21 || in_sizes[0] != S * DM || out_size != S * DM || ws_size < WS_END) {
            fprintf(stderr, "kernel_launch: unexpected shapes (n_in %d, in0 %d, out %d, ws %zu < %zu); nothing launched\n", n_in, n_in > 0 ? in_sizes[0] : -1, out_size, ws_size, (size_t)WS_END); grid = -1; return; }
        int dev = 0, cus = 0, per_cu = 0;
        if (hipGetDevice(&dev) != hipSuccess || hipDeviceGetAttribute(&cus, hipDeviceAttributeMultiprocessorCount, dev) != hipSuccess) { fprintf(stderr, "kernel_launch: device query failed\n"); grid = -1; return; }
        if (hipFuncSetAttribute((const void*)fwd, hipFuncAttributeMaxDynamicSharedMemorySize, LDS_BYTES) != hipSuccess) { fprintf(stderr, "kernel_launch: hipFuncSetAttribute failed\n"); grid = -1; return; }
        if (hipOccupancyMaxActiveBlocksPerMultiprocessor(&per_cu, (const void*)fwd, NWAVES * 64, LDS_BYTES) != hipSuccess || per_cu < 1)
            fprintf(stderr, "kernel_launch: note: occupancy query reports %d workgroups per CU\n", per_cu);
        (void)hipGetLastError();
        grid = cus;
    }
    if (grid < 0) return;
    if (hipMemsetAsync((char*)d_ws + WS_CTL, 0, CTL_ZERO_BYTES, stream) != hipSuccess) { fprintf(stderr, "kernel_launch: memset failed\n"); return; }
    Args a{};
    const float** ap = (const float**)&a;
    for (int i = 0; i < 21; ++i) ap[i] = (const float*)d_in[i];
    a.out = (float*)d_out; a.ws = (unsigned char*)d_ws;
#if defined(CHECK) && CHECK
    for (int p = 0; p < N_PHASES; ++p) { a.ph_lo = p; a.ph_hi = p + 1; hipLaunchKernelGGL(fwd, dim3(grid), dim3(NWAVES * 64), LDS_BYTES, stream, a);
        if (p >= 1 && p < N_PHASES - 1) { const int l = (p - 1) / PH_PER_LAYER, q = (p - 1) % PH_PER_LAYER; Args b = a; b.ph_lo = 0; b.ph_hi = 0;
            if (q == 3) hipLaunchKernelGGL(chk::chk_inproj, dim3(512), dim3(256), 0, stream, b, l);
            if (q == 2) hipLaunchKernelGGL(chk::chk_prep, dim3(512), dim3(256), 0, stream, b, l);
            if (q == 5) hipLaunchKernelGGL(chk::chk_attn, dim3(512), dim3(256), 0, stream, b, l); } }
    { Args b = a; b.ph_lo = 0; b.ph_hi = 0; hipLaunchKernelGGL(chk::chk_poison, dim3(1), dim3(64), 0, stream, b); }
#elif MK_PER_PHASE
    for (int p = 0; p < N_PHASES; ++p) { a.ph_lo = p; a.ph_hi = p + 1; hipLaunchKernelGGL(fwd, dim3(grid), dim3(NWAVES * 64), LDS_BYTES, stream, a); }
#else
    a.ph_lo = 0; a.ph_hi = N_PHASES;
    hipLaunchKernelGGL(fwd, dim3(grid), dim3(NWAVES * 64), LDS_BYTES, stream, a);
#endif
    const hipError_t le = hipPeekAtLastError();
    if (le != hipSuccess) fprintf(stderr, "kernel_launch: launch failed: %s\n", hipGetErrorName(le));
}
```

```cpp
#include <hip/hip_runtime.h>
#include <hip/hip_bf16.h>
#include <cstdio>
#include <cstdint>
#include <cmath>
__device__ __forceinline__ int tid_fresh() { int t = threadIdx.x; asm volatile("" : "+v"(t)); return t; }
#ifndef CHECK
#define CHECK 0
#endif
#ifndef BREAK
#define BREAK 0
#endif
namespace pg8 {
#define PG8_LAS __attribute__((address_space(3)))
typedef unsigned short bf16_t;
typedef short bf16x8 __attribute__((ext_vector_type(8)));
typedef float f32x4 __attribute__((ext_vector_type(4)));
typedef unsigned u32x4 __attribute__((ext_vector_type(4)));
constexpr int BM = 256, BK = 64, HALF = 128, HTB = HALF * BK * 2  , STAGE_BYTES = 8 * HTB, NXCD = 8, WGM = 4;

__host__ __device__ __forceinline__ int lds_byte(int r, int c) { const int st = (r >> 4) * 2 + (c >> 5), rr = r & 15, cc = c & 31, ob = rr * 64 + cc * 2; return st * 1024 + (ob ^ (((ob >> 9) & 1) << 5)); }
__host__ __device__ __forceinline__ void stage_rc(int b, int& R, int& C) { const int st = b / 1024, sb = b % 1024, swz = sb ^ (((sb >> 9) & 1) << 5); R = (st >> 1) * 16 + swz / 64; C = (st & 1) * 32 + (swz % 64) / 2; }
__host__ __device__ __forceinline__ int perm32(int rho) { const int n = rho >> 4, i = rho & 15; return 8 * (i >> 2) + 4 * n + (i & 3); }

struct Unit { int pm, pn; };
struct Gemm { const bf16_t* A; const bf16_t* Bt; int M, N, K; };

struct StaticOrder {
    int nM, nN, nwg, G, c;
    __host__ __device__ void init(int M, int N, int G_, int c_) { nM = M / BM; nN = N / BM; nwg = nM * nN; G = G_; c = c_; }
    __host__ __device__ bool next(int i, Unit& u) const {
        const long L = (long)i * G + c; if (L >= nwg) return false;
        int wgid = (int)L; { const int q = nwg / NXCD, r = nwg % NXCD, xcd = wgid % NXCD, off = wgid / NXCD; wgid = (xcd < r ? xcd * (q + 1) : r * (q + 1) + (xcd - r) * q) + off; }
        const int nig = WGM * nN, gid = wgid / nig, fm = gid * WGM, gsz = (nM - fm) < WGM ? (nM - fm) : WGM;
        u.pm = fm + ((wgid % nig) % gsz); u.pn = (wgid % nig) / gsz; return true;
    }
    __device__ __forceinline__ void a_ready(const Unit&) const {}
    __device__ __forceinline__ void done(const Unit&) const {}
};

__device__ __forceinline__ unsigned cvt_pk_bf16(float lo, float hi) { unsigned r; asm volatile("v_cvt_pk_bf16_f32 %0, %1, %2" : "=v"(r) : "v"(lo), "v"(hi)); return r; }
typedef float f32x2 __attribute__((ext_vector_type(2)));


struct EpiIn {
    static constexpr bool PERM = true, AFTER_DRAIN = false;
    bf16_t* O; int ldc; float* FG; int odd; const PG8_LAS float* tab;
    __device__ __forceinline__ void operator()(const f32x4 (&acc)[2][2][4][2], const Unit& u, int ui, int wr, int wc, int fr, int fq) const {
        asm volatile("" : "+v"(fr), "+v"(fq));
        const int pn = u.pn;
        int mode;
        if (!odd) mode = (pn < 8 || (pn >= 12 && pn <= 16)) ? 1 : 0;
        else mode = (pn == 22) ? 2 : (((pn >= 12 && pn <= 16) || pn == 18 || pn == 20) ? 1 : 0);
        const int row0 = u.pm * BM + wr * 64 + fr;
        const int hh = wc >> 1, dd = (wc & 1) * 32 + 8 * fq;
        const int cl0 = hh * 128 + dd, col0 = pn * BM + cl0;
        const PG8_LAS float* tb = tab + ui * 512;
        if (mode == 2) {
            if (wc == 0) { const f32x4 bb0 = *(const PG8_LAS f32x4*)(tb + 256 + cl0), bb1 = *(const PG8_LAS f32x4*)(tb + 256 + cl0 + 4);
#pragma unroll
                for (int ai = 0; ai < 2; ++ai)
#pragma unroll
                    for (int m = 0; m < 4; ++m) { const int row = row0 + ai * HALF + m * 16; const float rs = tb[wr * 64 + fr + ai * HALF + m * 16]; float* p = FG + (size_t)(8 * fq) * 8192 + row;
                        const f32x4 v0 = acc[ai][0][m][0] * rs + bb0, v1 = acc[ai][0][m][1] * rs + bb1;
#pragma unroll
                        for (int e = 0; e < 4; ++e) { p[(size_t)e * 8192] = v0[e]; p[(size_t)(4 + e) * 8192] = v1[e]; } }
            }
            return;
        }
        const f32x4 ir0 = *(const PG8_LAS f32x4*)(tab + 2048 + dd), ir1 = *(const PG8_LAS f32x4*)(tab + 2048 + dd + 4);
        const f32x4 ba0 = *(const PG8_LAS f32x4*)(tb + 256 + cl0), ba1 = *(const PG8_LAS f32x4*)(tb + 256 + cl0 + 4), bb0 = *(const PG8_LAS f32x4*)(tb + 256 + cl0 + 64), bb1 = *(const PG8_LAS f32x4*)(tb + 256 + cl0 + 68);
#pragma unroll
        for (int ai = 0; ai < 2; ++ai)
#pragma unroll
            for (int m = 0; m < 4; ++m) { const int row = row0 + ai * HALF + m * 16; const float rs = tb[wr * 64 + fr + ai * HALF + m * 16];
                f32x4 a0 = acc[ai][0][m][0] * rs + ba0, a1 = acc[ai][0][m][1] * rs + ba1, b0 = acc[ai][1][m][0] * rs + bb0, b1 = acc[ai][1][m][1] * rs + bb1;
                if (mode == 1) {
                    const float tf = (float)row; f32x4 c0, c1, s0, s1;
#pragma unroll
                    for (int e = 0; e < 4; ++e) { float r0 = tf * ir0[e], r1 = tf * ir1[e]; r0 = __builtin_amdgcn_fractf(r0); r1 = __builtin_amdgcn_fractf(r1);
                        c0[e] = __builtin_amdgcn_cosf(r0); s0[e] = __builtin_amdgcn_sinf(r0); c1[e] = __builtin_amdgcn_cosf(r1); s1[e] = __builtin_amdgcn_sinf(r1); }
                    const f32x4 x0 = a0 * c0 - b0 * s0, x1 = a1 * c1 - b1 * s1, y0 = a0 * s0 + b0 * c0, y1 = a1 * s1 + b1 * c1;
                    a0 = x0; a1 = x1; b0 = y0; b1 = y1; }
                bf16_t* rowp = O + (size_t)row * ldc + col0;
                u32x4 w; w.x = cvt_pk_bf16(a0[0], a0[1]); w.y = cvt_pk_bf16(a0[2], a0[3]); w.z = cvt_pk_bf16(a1[0], a1[1]); w.w = cvt_pk_bf16(a1[2], a1[3]);
                *(u32x4*)rowp = w;
                u32x4 v; v.x = cvt_pk_bf16(b0[0], b0[1]); v.y = cvt_pk_bf16(b0[2], b0[3]); v.z = cvt_pk_bf16(b1[0], b1[1]); v.w = cvt_pk_bf16(b1[2], b1[3]);
                *(u32x4*)(rowp + 64) = v; }
    }
};
struct EpiRes {
    static constexpr bool PERM = true, AFTER_DRAIN = false;
    bf16_t* R; float* XF; int ldc; const float* gate; float* ss;
    __device__ __forceinline__ void operator()(const f32x4 (&acc)[2][2][4][2], const Unit& u, int ui, int wr, int wc, int fr, int fq) const {
        asm volatile("" : "+v"(fr), "+v"(fq));
        const int row0 = u.pm * BM + wr * 64 + fr, col0 = u.pn * BM + wc * 32 + 8 * fq;
        f32x4 gv[2][2];
#pragma unroll
        for (int bj = 0; bj < 2; ++bj)
#pragma unroll
            for (int n = 0; n < 2; ++n) gv[bj][n] = *(const f32x4*)(gate + col0 + bj * HALF + 4 * n);
#pragma unroll
        for (int ai = 0; ai < 2; ++ai)
#pragma unroll
            for (int m = 0; m < 4; ++m) { const int row = row0 + ai * HALF + m * 16; const size_t off = (size_t)row * ldc + col0; float sq = 0.f;
#pragma unroll
                for (int bj = 0; bj < 2; ++bj) { const u32x4 rb = *(const u32x4*)(R + off + bj * HALF);
                    const f32x4 r0 = {__builtin_bit_cast(float, rb.x << 16), __builtin_bit_cast(float, rb.x & 0xffff0000u), __builtin_bit_cast(float, rb.y << 16), __builtin_bit_cast(float, rb.y & 0xffff0000u)};
                    const f32x4 r1 = {__builtin_bit_cast(float, rb.z << 16), __builtin_bit_cast(float, rb.z & 0xffff0000u), __builtin_bit_cast(float, rb.w << 16), __builtin_bit_cast(float, rb.w & 0xffff0000u)};
                    const f32x4 x0 = r0 + gv[bj][0] * acc[ai][bj][m][0], x1 = r1 + gv[bj][1] * acc[ai][bj][m][1];
                    if (XF) { *(f32x4*)(XF + off + bj * HALF) = x0; *(f32x4*)(XF + off + bj * HALF + 4) = x1; }
                    sq += ((x0[0] * x0[0] + x0[1] * x0[1]) + (x0[2] * x0[2] + x0[3] * x0[3])) + ((x1[0] * x1[0] + x1[1] * x1[1]) + (x1[2] * x1[2] + x1[3] * x1[3]));
                    u32x4 w; w.x = cvt_pk_bf16(x0[0], x0[1]); w.y = cvt_pk_bf16(x0[2], x0[3]); w.z = cvt_pk_bf16(x1[0], x1[1]); w.w = cvt_pk_bf16(x1[2], x1[3]);
                    *(u32x4*)(R + off + bj * HALF) = w; }
                if (ss) { sq += __shfl_xor(sq, 16); sq += __shfl_xor(sq, 32); if (fq == 0) ss[(size_t)row * 32 + u.pn * 4 + wc] = sq; } }
    }
};
struct EpiRelu2 {
    static constexpr bool PERM = true, AFTER_DRAIN = false;
    bf16_t* O; int ldc; const PG8_LAS float* tab;
    __device__ __forceinline__ void operator()(const f32x4 (&acc)[2][2][4][2], const Unit& u, int ui, int wr, int wc, int fr, int fq) const {
        asm volatile("" : "+v"(fr), "+v"(fq));
        const int row0 = u.pm * BM + wr * 64 + fr, col0 = u.pn * BM + wc * 32 + 8 * fq;
        const PG8_LAS float* tb = tab + ui * 512; const int cl0 = wc * 32 + 8 * fq;
        f32x4 bv[2][2];
#pragma unroll
        for (int bj = 0; bj < 2; ++bj)
#pragma unroll
            for (int n = 0; n < 2; ++n) bv[bj][n] = *(const PG8_LAS f32x4*)(tb + 256 + cl0 + bj * HALF + 4 * n);
#pragma unroll
        for (int ai = 0; ai < 2; ++ai)
#pragma unroll
            for (int m = 0; m < 4; ++m) { const int row = row0 + ai * HALF + m * 16; const float rs = tb[wr * 64 + fr + ai * HALF + m * 16]; bf16_t* rowp = O + (size_t)row * ldc + col0;
#pragma unroll
                for (int bj = 0; bj < 2; ++bj) { f32x4 v0 = acc[ai][bj][m][0] * rs + bv[bj][0], v1 = acc[ai][bj][m][1] * rs + bv[bj][1];
#pragma unroll
                    for (int e = 0; e < 4; ++e) { const float a = fmaxf(v0[e], 0.f), b = fmaxf(v1[e], 0.f); v0[e] = a * a; v1[e] = b * b; }
                    u32x4 w; w.x = cvt_pk_bf16(v0[0], v0[1]); w.y = cvt_pk_bf16(v0[2], v0[3]); w.z = cvt_pk_bf16(v1[0], v1[1]); w.w = cvt_pk_bf16(v1[2], v1[3]);
                    *(u32x4*)(rowp + bj * HALF) = w; } }
    }
};

struct MapOrder {
    StaticOrder b; int cut, shift;
    __device__ void init(int M, int nTiles, int G_, int c_, int cut_, int shift_) { b.init(M, nTiles * BM, G_, c_); cut = cut_; shift = shift_; }
    __device__ bool next(int i, Unit& u) const { if (!b.next(i, u)) return false; u.pn += (u.pn >= cut) ? shift : 0; return true; }
    __device__ __forceinline__ void a_ready(const Unit&) const {}
    __device__ __forceinline__ void done(const Unit&) const {}
};

template <class Sched>
__device__ __forceinline__ void epi_preload(const Sched& S, const float* ss, const float* bp, PG8_LAS float* tab) {
    const int tid = tid_fresh();
    if (tid < 64) tab[2048 + tid] = 0.15915494309189535f / powf(10000.f, (float)tid * (1.f / 64.f));
    Unit u;
    if (tid < 256) {
        int pmp = -1; float rs = 0.f;
        for (int i = 0; i < 4 && S.next(i, u); ++i) {
            if (u.pm != pmp) { const float* sp = ss + (size_t)(u.pm * BM + tid) * 32; float t = 0.f; pmp = u.pm;
#pragma unroll
                for (int q = 0; q < 8; ++q) { const f32x4 a = *(const f32x4*)(sp + 4 * q); t += (a[0] + a[1]) + (a[2] + a[3]); }
                rs = 1.f / sqrtf(t * (1.f / 2048.f) + 1e-6f); }
            tab[i * 512 + tid] = rs; }
    } else {
        const int w = (tid - 256) >> 6, ln = tid & 63;
        if (S.next(w, u)) { const float* b = bp + u.pn * BM + 4 * ln; f32x4 t0 = {0.f, 0.f, 0.f, 0.f}, t1 = t0;
#pragma unroll
            for (int kb = 0; kb < 32; kb += 2) { t0 += *(const f32x4*)(b + (size_t)kb * 8192); t1 += *(const f32x4*)(b + (size_t)(kb + 1) * 8192); }
            *(PG8_LAS f32x4*)(tab + w * 512 + 256 + 4 * ln) = t0 + t1; }
    }
    __syncthreads();
}
template <class Epi, class Sched, bool ALIGN_EPI = false, bool SP2 = false>
__device__ __forceinline__ void gemm_phase(PG8_LAS unsigned char* lds, const Gemm g, const Sched& S, const Epi& E) {
    const int tid = tid_fresh(), wid = __builtin_amdgcn_readfirstlane(tid >> 6), lane = tid & 63, wr = wid >> 2, wc = wid & 3, fr = lane & 15, fq = lane >> 4;
    const int K = g.K, nt = K / BK;
    unsigned voffA[2], voffB[2];
#pragma unroll
    for (int i = 0; i < 2; ++i) { int R, C; stage_rc(tid * 16 + i * 8192, R, C); const int Rb = Epi::PERM ? ((R & ~31) + perm32(R & 31)) : R;
        voffA[i] = (unsigned)(R * K + C) * 2u; voffB[i] = (unsigned)(Rb * K + C) * 2u; }
    const size_t kstep = (size_t)(BK * 2);
    const size_t hstep = (size_t)HALF * K * 2;
    const size_t tstep = 2 * hstep;
    const unsigned ldsw = (unsigned)wid * 1024u;
    const int aoff = lds_byte(wr * 64 + fr, fq * 8), boff = lds_byte(wc * 32 + fr, fq * 8);
#define PG8_SA(b, h) (((b) * 2 + (h)) * HTB)
#define PG8_SB(b, h) ((4 + (b) * 2 + (h)) * HTB)
#define PG8_STAGE(bufoff, gbase, voff) do { _Pragma("unroll") for (int _i = 0; _i < 2; ++_i) \
        __builtin_amdgcn_global_load_lds((const unsigned*)((const char*)(gbase) + (voff)[_i]), (PG8_LAS unsigned*)(lds + (bufoff) + ldsw + _i * 8192), 16, 0, 0); } while (0)
#define PG8_LDA(dst, b, h) do { _Pragma("unroll") for (int m = 0; m < 4; ++m) _Pragma("unroll") for (int k = 0; k < 2; ++k) dst[m][k] = *(const PG8_LAS bf16x8*)(lds + PG8_SA(b, h) + aoff + m * 2048 + k * 1024); } while (0)
#define PG8_LDB(dst, b, h) do { _Pragma("unroll") for (int n = 0; n < 2; ++n) _Pragma("unroll") for (int k = 0; k < 2; ++k) dst[n][k] = *(const PG8_LAS bf16x8*)(lds + PG8_SB(b, h) + boff + n * 2048 + k * 1024); } while (0)
#define PG8_MMA(ai, bj, At, Bt) do { __builtin_amdgcn_s_setprio(1); _Pragma("unroll") for (int m = 0; m < 4; ++m) _Pragma("unroll") for (int n = 0; n < 2; ++n) _Pragma("unroll") for (int k = 0; k < 2; ++k) \
        acc[ai][bj][m][n] = __builtin_amdgcn_mfma_f32_16x16x32_bf16(Bt[n][k], At[m][k], acc[ai][bj][m][n], 0, 0, 0); __builtin_amdgcn_s_setprio(0); } while (0)
#define PG8_WAIT_V(n) asm volatile("s_waitcnt vmcnt(" #n ")" ::: "memory")
#define PG8_WAIT_L(n) asm volatile("s_waitcnt lgkmcnt(" #n ")" ::: "memory")
#define PG8_BAR __builtin_amdgcn_s_barrier()
#define PG8_SCHED __builtin_amdgcn_sched_barrier(0)
    Unit cur, nxt; int ui = 0;
    if (!S.next(0, cur)) return;
    f32x4 acc[2][2][4][2];
#pragma unroll
    for (int a = 0; a < 2; ++a)
#pragma unroll
        for (int b = 0; b < 2; ++b)
#pragma unroll
            for (int m = 0; m < 4; ++m)
#pragma unroll
                for (int n = 0; n < 2; ++n) acc[a][b][m][n] = (f32x4){0.f, 0.f, 0.f, 0.f};
    bf16x8 At[4][2], B0[2][2], B1[2][2];
    const char* cA = (const char*)g.A + (size_t)cur.pm * tstep; const char* cB = (const char*)g.Bt + (size_t)cur.pn * tstep;
    S.a_ready(cur);
    if constexpr (SP2) {
        PG8_STAGE(PG8_SB(0, 0), cB, voffB); PG8_STAGE(PG8_SB(0, 1), cB + hstep, voffB); PG8_STAGE(PG8_SA(0, 0), cA, voffA); PG8_STAGE(PG8_SA(0, 1), cA + hstep, voffA);
        if (wr == 1) PG8_BAR;
        PG8_WAIT_V(2); PG8_BAR;
        PG8_STAGE(PG8_SB(1, 0), cB + kstep, voffB); PG8_STAGE(PG8_SA(1, 0), cA + kstep, voffA); PG8_STAGE(PG8_SB(1, 1), cB + hstep + kstep, voffB);
        PG8_WAIT_V(6); PG8_BAR;
    } else {
        PG8_STAGE(PG8_SB(0, 0), cB, voffB); PG8_STAGE(PG8_SA(0, 0), cA, voffA); PG8_STAGE(PG8_SB(0, 1), cB + hstep, voffB); PG8_STAGE(PG8_SA(0, 1), cA + hstep, voffA);
        if (wr == 1) PG8_BAR;
        PG8_WAIT_V(4); PG8_BAR;
        PG8_STAGE(PG8_SB(1, 0), cB + kstep, voffB); PG8_STAGE(PG8_SA(1, 0), cA + kstep, voffA); PG8_STAGE(PG8_SB(1, 1), cB + hstep + kstep, voffB);
        PG8_WAIT_V(6); PG8_BAR;
    }
    for (;;) {
        const bool has_next = S.next(ui + 1, nxt);
        const char* nA = has_next ? (const char*)g.A + (size_t)nxt.pm * tstep : cA; const char* nB = has_next ? (const char*)g.Bt + (size_t)nxt.pn * tstep : cB;
        for (int t = 0; t < nt; t += 2) {
            const bool last = (t == nt - 2);
            const char* a1 = cA + (size_t)(t + 1) * kstep;
            const char* a2 = last ? nA : cA + (size_t)(t + 2) * kstep; const char* b2 = last ? nB : cB + (size_t)(t + 2) * kstep;
            const char* a3 = a2 + kstep; const char* b3 = b2 + kstep;
            if (last && has_next) S.a_ready(nxt);
            if constexpr (SP2) {
            PG8_LDB(B0, 0, 0); PG8_LDB(B1, 0, 1); PG8_SCHED; PG8_LDA(At, 0, 0); PG8_STAGE(PG8_SA(1, 1), a1 + hstep, voffA);
            PG8_WAIT_V(8); PG8_WAIT_L(0); PG8_BAR; PG8_MMA(0, 0, At, B0); PG8_MMA(0, 1, At, B1); PG8_BAR; PG8_SCHED;
            PG8_LDA(At, 0, 1); PG8_STAGE(PG8_SB(0, 0), b2, voffB); PG8_STAGE(PG8_SB(0, 1), b2 + hstep, voffB); PG8_STAGE(PG8_SA(0, 0), a2, voffA);
            PG8_WAIT_V(8); PG8_WAIT_L(0); PG8_BAR; PG8_MMA(1, 0, At, B0); PG8_MMA(1, 1, At, B1); PG8_BAR; PG8_SCHED;
            PG8_LDB(B0, 1, 0); PG8_LDB(B1, 1, 1); PG8_SCHED; PG8_LDA(At, 1, 0); PG8_STAGE(PG8_SA(0, 1), a2 + hstep, voffA);
            PG8_WAIT_V(8); PG8_WAIT_L(0); PG8_BAR; PG8_MMA(0, 0, At, B0); PG8_MMA(0, 1, At, B1); PG8_BAR; PG8_SCHED;
            PG8_LDA(At, 1, 1); PG8_STAGE(PG8_SB(1, 0), b3, voffB); PG8_STAGE(PG8_SB(1, 1), b3 + hstep, voffB); PG8_STAGE(PG8_SA(1, 0), a3, voffA);
            PG8_WAIT_V(8); PG8_WAIT_L(0); PG8_BAR; PG8_MMA(1, 0, At, B0); PG8_MMA(1, 1, At, B1); PG8_BAR; PG8_SCHED;
            } else {
            PG8_LDB(B0, 0, 0); PG8_SCHED; PG8_LDA(At, 0, 0); PG8_STAGE(PG8_SA(1, 1), a1 + hstep, voffA);
            PG8_WAIT_L(8); PG8_BAR; PG8_WAIT_L(0); PG8_MMA(0, 0, At, B0); PG8_BAR; PG8_SCHED;
            PG8_LDB(B1, 0, 1); PG8_STAGE(PG8_SB(0, 0), b2, voffB);
            PG8_BAR; PG8_WAIT_L(0); PG8_MMA(0, 1, At, B1); PG8_BAR;
            PG8_LDA(At, 0, 1); PG8_STAGE(PG8_SA(0, 0), a2, voffA);
            PG8_BAR; PG8_WAIT_L(0); PG8_MMA(1, 0, At, B0); PG8_BAR; PG8_SCHED;
            PG8_STAGE(PG8_SB(0, 1), b2 + hstep, voffB);
            PG8_WAIT_V(6); PG8_BAR; PG8_MMA(1, 1, At, B1); PG8_BAR;
            PG8_LDB(B0, 1, 0); PG8_SCHED; PG8_LDA(At, 1, 0); PG8_STAGE(PG8_SA(0, 1), a2 + hstep, voffA);
            PG8_WAIT_L(8); PG8_BAR; PG8_WAIT_L(0); PG8_MMA(0, 0, At, B0); PG8_BAR; PG8_SCHED;
            PG8_LDB(B1, 1, 1); PG8_STAGE(PG8_SB(1, 0), b3, voffB);
            PG8_BAR; PG8_WAIT_L(0); PG8_MMA(0, 1, At, B1); PG8_BAR;
            PG8_LDA(At, 1, 1); PG8_STAGE(PG8_SA(1, 0), a3, voffA);
            PG8_BAR; PG8_WAIT_L(0); PG8_MMA(1, 0, At, B0); PG8_BAR; PG8_SCHED;
            PG8_STAGE(PG8_SB(1, 1), b3 + hstep, voffB);
            PG8_WAIT_V(6); PG8_BAR; PG8_MMA(1, 1, At, B1); PG8_BAR;
            }
        }
        if constexpr (ALIGN_EPI) { if (wr == 0) PG8_BAR; }
        if constexpr (!Epi::AFTER_DRAIN) { E(acc, cur, ui, wr, wc, fr, fq); S.done(cur); }
        if (!has_next) break;
#pragma unroll
        for (int a = 0; a < 2; ++a)
#pragma unroll
            for (int b = 0; b < 2; ++b)
#pragma unroll
                for (int m = 0; m < 4; ++m)
#pragma unroll
                    for (int n = 0; n < 2; ++n) acc[a][b][m][n] = (f32x4){0.f, 0.f, 0.f, 0.f};
        cur = nxt; cA = nA; cB = nB; ++ui;
        if constexpr (ALIGN_EPI) { if (wr == 1) PG8_BAR; }
    }
    PG8_WAIT_V(0);
    if constexpr (!ALIGN_EPI) { if (wr == 0) PG8_BAR; }
    PG8_BAR;
    if constexpr (Epi::AFTER_DRAIN) { E.fused(acc, cur, wr, wc, fr, fq, lds, wid, lane); S.done(cur); }
#undef PG8_SA
#undef PG8_SB
#undef PG8_STAGE
#undef PG8_LDA
#undef PG8_LDB
#undef PG8_MMA
#undef PG8_WAIT_V
#undef PG8_WAIT_L
#undef PG8_BAR
#undef PG8_SCHED
}
}

constexpr int S = 8192, DM = 2048, HD = 128, DFF = 8192, DEPTH = 4;
constexpr int NE = 4608, NO = 5888, NO_SRC = 5664;
constexpr float NORM_EPS = 1e-6f;
constexpr int NWAVES = 8;
constexpr int E_QA = 0, E_KA = 1024, E_VA = 2048, E_QB = 3072, E_KB = 4096, E_VB = 4352;
constexpr int O_QC = 0, O_KC = 1024, O_VC = 2048, O_QD = 3072, O_KCMP = 4096, O_VCMP = 4352, O_KSLC = 4608, O_VSLC = 4864, O_KWIN = 5120, O_VWIN = 5376, O_FG = 5632;
constexpr int NCMP = 511;

constexpr size_t MiB = 1u << 20;
constexpr size_t WS_CTL = 0, CTL_ZERO_BYTES = 1 * MiB;
constexpr size_t WS_MODS = 1 * MiB;
constexpr size_t WS_KMH = 6 * MiB, WS_KML = 6 * MiB + 128 * 1024;
constexpr size_t WS_CUM = 7 * MiB;
constexpr size_t WS_FOXN = 7 * MiB + 512 * 1024;
constexpr size_t WS_FG = 8 * MiB;
constexpr size_t WS_KC = 9 * MiB, WS_VC = 9 * MiB + 512 * 1024;
constexpr size_t WS_W1T = 10 * MiB;
constexpr size_t WS_W2T = 14 * MiB;
constexpr size_t WS_W = 16 * MiB, W_LAYER = 96 * MiB, W_IN = 0, W_OUT = 24 * MiB, W_UP = 32 * MiB, W_DOWN = 64 * MiB;
constexpr size_t WS_H = 400 * MiB;
constexpr size_t WS_QKV = 432 * MiB;
constexpr size_t WS_O = 528 * MiB;
constexpr size_t WS_U = 560 * MiB;
constexpr size_t WS_NSASCR = 688 * MiB;
constexpr size_t WS_MPO = WS_NSASCR;
constexpr size_t WS_MML = 752 * MiB;
constexpr size_t WS_MLIST = 754 * MiB;
constexpr size_t WS_SS = 762 * MiB;
constexpr size_t WS_BPART = 764 * MiB;
constexpr size_t WS_END = 772 * MiB;
constexpr int CW_BAR = 4096;
constexpr int CW_Q = 8192;
constexpr int CW_FOXN = 13312;
constexpr int CW_MCNT = 10240;

constexpr int RING_OFF = 0, RING_BYTES = 135168;
constexpr int LDSCTL_OFF = RING_BYTES, MISC_OFF = LDSCTL_OFF + 320;
constexpr int LDS_BYTES = 147456;
constexpr int EPITAB_OFF = MISC_OFF + 128;
static_assert(EPITAB_OFF + (4 * 512 + 64) * 4 <= LDS_BYTES, "LDS map");

#define GAS __attribute__((address_space(1)))
#define LAS __attribute__((address_space(3)))
#define DI __device__ __forceinline__
typedef unsigned short bf16;
typedef unsigned v4u __attribute__((ext_vector_type(4)));
typedef float f32x4 __attribute__((ext_vector_type(4)));
typedef float f32x16 __attribute__((ext_vector_type(16)));
typedef short bf16x8 __attribute__((ext_vector_type(8)));
typedef short s16x4 __attribute__((ext_vector_type(4)));
typedef GAS unsigned gu32;
#define RLX_AGENT __ATOMIC_RELAXED, __HIP_MEMORY_SCOPE_AGENT
#define LDS_WAIT() asm volatile("s_waitcnt lgkmcnt(0)" ::: "memory")
DI unsigned f2bf(float f) { unsigned u = __builtin_bit_cast(unsigned, f); return (u + 0x7fffu + ((u >> 16) & 1u)) >> 16; }
DI float bf2f(unsigned b) { return __builtin_bit_cast(float, b << 16); }
DI unsigned pk2(float lo, float hi) { return f2bf(lo) | (f2bf(hi) << 16); }
DI float wave_sum(float v) {
#pragma unroll
    for (int o = 1; o < 64; o <<= 1) v += __shfl_xor(v, o);
    return v;
}
#define XB_TMO      128
#define XB_XCNT(j)  (256  + 64 * (j))
#define XB_XSUB(j)  (1280 + 64 * (j))
#define XB_XGEN(j)  (2304 + 64 * (j))
#define XB_TOP      3328
#define XB_TOPGEN   3392
#define XCD_BAR_WORDS 3456
#define XB_SPIN_CAP (1u << 18)

__device__ __forceinline__ unsigned xb_ld(unsigned* p)              { return __hip_atomic_load(p, __ATOMIC_RELAXED, __HIP_MEMORY_SCOPE_AGENT); }
__device__ __forceinline__ unsigned xb_add(unsigned* p, unsigned v) { return __hip_atomic_fetch_add(p, v, __ATOMIC_RELAXED, __HIP_MEMORY_SCOPE_AGENT); }
__device__ __forceinline__ unsigned xb_xcc_id() { return (unsigned)__builtin_amdgcn_s_getreg((3 << 11) | 20) & 0xFu; }
#define XB_SPIN(cond, bar) do { unsigned _sp = 0; while (cond) { __builtin_amdgcn_s_sleep(1); \
    if ((++_sp & 255u) == 0u) { if (xb_ld(&(bar)[XB_TMO])) break; if (_sp > XB_SPIN_CAP) { atomicAdd(&(bar)[XB_TMO], 1u); break; } } } } while (0)

struct XcdBarrier {
    unsigned* bar; unsigned x;
    volatile LAS unsigned* st;
};

__device__ __forceinline__ XcdBarrier xcd_barrier_post(unsigned* bar, volatile LAS unsigned* st) {
    XcdBarrier b; b.bar = bar; b.x = xb_xcc_id(); b.st = st;
    if (threadIdx.x == 0) (void)xb_add(&bar[XB_XCNT(b.x)], 1u);
    return b;
}
__device__ __forceinline__ void xcd_barrier_complete(unsigned* bar, unsigned x, unsigned& nloc, unsigned& nx) {
    const unsigned G = gridDim.x * gridDim.y * gridDim.z;
    unsigned sum, cnt, mine, sp = 0u;
    for (;;) {
        sum = 0u; cnt = 0u; mine = 0u;
#pragma unroll
        for (unsigned j = 0; j < 16; ++j) { const unsigned c = xb_ld(&bar[XB_XCNT(j)]); sum += c; cnt += (c > 0u) ? 1u : 0u; mine = (j == x) ? c : mine; }
        if (sum == G) break;
        __builtin_amdgcn_s_sleep(1);
        if ((++sp & 255u) == 0u) { if (xb_ld(&bar[XB_TMO])) break; if (sp > XB_SPIN_CAP) { atomicAdd(&bar[XB_TMO], 1u); break; } }
    }
    nloc = mine > 0u ? mine : 1u; nx = cnt > 0u ? cnt : 1u;
}

__device__ __forceinline__ void xcd_barrier(const XcdBarrier& b) {
    asm volatile("s_waitcnt vmcnt(0)" ::: "memory");
    __syncthreads();
    if (threadIdx.x == 0) {
        unsigned* bar = b.bar;
        __builtin_amdgcn_s_waitcnt(0);
        unsigned nloc = b.st[0], nx = b.st[1];
        if (nloc == 0u) { xcd_barrier_complete(bar, b.x, nloc, nx); b.st[0] = nloc; b.st[1] = nx; }
        const unsigned old = xb_add(&bar[XB_XSUB(b.x)], 1u);
        const unsigned gen = old / nloc;
        if (old + 1u == (gen + 1u) * nloc) {
            __builtin_amdgcn_fence(__ATOMIC_RELEASE, "agent");
            asm volatile("s_waitcnt vmcnt(0)" ::: "memory");
            const unsigned og = xb_add(&bar[XB_TOP], 1u);
            const unsigned tg = og / nx;
            if (og + 1u == (tg + 1u) * nx) xb_add(&bar[XB_TOPGEN], 1u);
            else XB_SPIN(xb_ld(&bar[XB_TOPGEN]) == tg, bar);
            __builtin_amdgcn_fence(__ATOMIC_ACQUIRE, "agent");
            xb_add(&bar[XB_XGEN(b.x)], 1u);
            asm volatile("s_waitcnt vmcnt(0)" ::: "memory");
        } else {
            XB_SPIN(xb_ld(&bar[XB_XGEN(b.x)]) == gen, bar);
            __builtin_amdgcn_fence(__ATOMIC_ACQUIRE, "agent");
            asm volatile("s_waitcnt vmcnt(0)" ::: "memory");
        }
    }
    __syncthreads();
}

struct Args {
    const float* x; const float* c; const float* norm_mix_g; const float* norm_mlp_g; const float* ada_w; const float* ada_b;
    const float* mlp_up; const float* mlp_down; const float* even_w_in; const float* even_sinks; const float* even_w_out;
    const float* odd_w_in; const float* fox_forget_b; const float* nsa_k_pos; const float* nsa_k_w1; const float* nsa_k_w2;
    const float* nsa_v_pos; const float* nsa_v_w1; const float* nsa_v_w2; const float* odd_w_out; const float* final_norm_g;
    float* out; unsigned char* ws; int ph_lo, ph_hi;
};
typedef const __attribute__((address_space(4))) Args* KA;
DI KA kargs() { KA p = (KA)__builtin_amdgcn_kernarg_segment_ptr(); asm volatile("" : "+s"(p)); return p; }
struct Ctx {
    LAS unsigned char* lds; int tid, lane, wave, G, gw, NGW;
};
DI Ctx make_ctx(LAS unsigned char* lds) { Ctx C; C.lds = lds; C.tid = tid_fresh(); C.lane = C.tid & 63; C.wave = __builtin_amdgcn_readfirstlane(C.tid >> 6);
    C.G = gridDim.x; C.gw = blockIdx.x * NWAVES + C.wave; C.NGW = C.G * NWAVES; return C; }

DI int tile_perm_row(int nd) { const int q = nd & 255, hh = q >> 7, d = q & 127; return (nd & ~255) + (d < 64 ? hh * 64 + d : 128 + hh * 64 + (d - 64)); }
DI int odd_src_col(int nd) { return nd < 3072 ? nd : (nd < 5632 ? nd + 8 : (nd < 5640 ? 3072 + (nd - 5632) : (nd < 5664 ? nd : -1))); }
struct TJob { const float* W; int K, Nsrc, Ndst; bf16* WT; int mode; const float* Ak  ; const float* Sk  ; float* bp  ; };
DI float* bpart_of(unsigned char* ws, int l, int kind) { return (float*)(ws + WS_BPART) + (size_t)(l * 2 + kind) * 32 * 8192; }
DI void tr_load(const TJob& J, int item, int lane, float (&v)[64], int& sc) {
    const int nblk = J.Ndst / 64, kb = item / nblk, nb = item % nblk, k0 = 64 * kb, n0 = 64 * nb;
    const int ndl = n0 + lane;
    sc = (J.mode == 2) ? odd_src_col(ndl) : ndl;
    const int scl = sc >= 0 ? sc : 0;
#pragma unroll
    for (int i = 0; i < 64; ++i) { const float* rowp = J.W + (size_t)(k0 + i) * J.Nsrc; v[i] = __builtin_nontemporal_load(rowp + scl); }
    if (J.Ak) {
        const unsigned a_l = __builtin_bit_cast(unsigned, J.Ak[k0 + lane]), s_l = __builtin_bit_cast(unsigned, J.Sk[k0 + lane]);
        float part = 0.f;
#pragma unroll
        for (int i = 0; i < 64; ++i) { const float w = (sc >= 0) ? v[i] : 0.f;
            part = fmaf(__builtin_bit_cast(float, __builtin_amdgcn_readlane(s_l, i)), w, part); v[i] = w * __builtin_bit_cast(float, __builtin_amdgcn_readlane(a_l, i)); }
        J.bp[(size_t)kb * 8192 + ndl] = part; }
}
DI void tr_store(const TJob& J, int item, int lane, const float (&v)[64], int sc, LAS float* scr) {
    const int nblk = J.Ndst / 64, kb = item / nblk, nb = item % nblk, k0 = 64 * kb, n0 = 64 * nb;
#pragma unroll
    for (int i = 0; i < 64; ++i) scr[i * 65 + lane] = (sc >= 0) ? v[i] : 0.f;
    LDS_WAIT(); asm volatile("" ::: "memory");
    const int c = lane & 7;
#pragma unroll
    for (int j = 0; j < 8; ++j) { const int n = (lane >> 3) + 8 * j; const LAS float* s = scr + (8 * c) * 65 + n;
        v4u o; o.x = pk2(s[0 * 65], s[1 * 65]); o.y = pk2(s[2 * 65], s[3 * 65]); o.z = pk2(s[4 * 65], s[5 * 65]); o.w = pk2(s[6 * 65], s[7 * 65]);
        const int drow = (J.mode == 0) ? (n0 + n) : tile_perm_row(n0 + n);
        *(GAS v4u*)(J.WT + (size_t)drow * J.K + k0 + 8 * c) = o; }
    LDS_WAIT(); asm volatile("" ::: "memory");
}
DI void p0_transpose_item(const float* W, int K, int Nsrc, int Ndst, bf16* WT, LAS float* scr, int item, int lane, int mode) {
    const TJob J{W, K, Nsrc, Ndst, WT, mode, nullptr, nullptr, nullptr}; float v[64]; int sc; tr_load(J, item, lane, v, sc); tr_store(J, item, lane, v, sc, scr);
}
DI void transpose_job_item(const TJob& J, LAS float* scr, int item, int lane) { float v[64]; int sc; tr_load(J, item, lane, v, sc); tr_store(J, item, lane, v, sc, scr); }
DI float silu_f(float v) { return v / (1.f + expf(-v)); }

DI int conv_items(int l, int x) { return x == 0 ? (DM / 64) * (((l & 1) ? NO : NE) / 64) : (x == 1 ? (DM / 64) * (DM / 64) : (DM / 64) * (DFF / 64)); }
DI TJob conv_job(KA a, unsigned char* ws, int l, int x) {
    const int j = l >> 1; const bool odd = l & 1;
    unsigned char* wl = ws + WS_W + (size_t)l * W_LAYER; const float* mods = (const float*)(ws + WS_MODS) + (size_t)l * 6 * DM;
    if (x == 0) { if (!odd) return TJob{a->even_w_in + (size_t)j * DM * NE, DM, NE, NE, (bf16*)(wl + W_IN), 1, mods + 1 * DM, mods, bpart_of(ws, l, 0)};
                  return TJob{a->odd_w_in + (size_t)j * DM * NO_SRC, DM, NO_SRC, NO, (bf16*)(wl + W_IN), 2, mods + 1 * DM, mods, bpart_of(ws, l, 0)}; }
    if (x == 1) return TJob{(odd ? a->odd_w_out : a->even_w_out) + (size_t)j * DM * DM, DM, DM, DM, (bf16*)(wl + W_OUT), 0, nullptr, nullptr, nullptr};
    if (x == 2) return TJob{a->mlp_up + (size_t)l * DM * DFF, DM, DFF, DFF, (bf16*)(wl + W_UP), 0, mods + 4 * DM, mods + 3 * DM, bpart_of(ws, l, 1)};
    return TJob{a->mlp_down + (size_t)l * DFF * DM, DFF, DM, DM, (bf16*)(wl + W_DOWN), 0, nullptr, nullptr, nullptr};
}
DI void conv_item(KA a, unsigned char* ws, int l, int x, int item, LAS float* scr, int lane) { const TJob J = conv_job(a, ws, l, x); transpose_job_item(J, scr, item, lane); }
DI void p0_ada(KA a, const Ctx& C) {
    unsigned char* ws = a->ws;
    {
        LAS float* red = (LAS float*)(C.lds + RING_OFF);
        for (int u = blockIdx.x; u < 4 * 48; u += C.G) {
            const int l = u / 48, cg = u % 48;
            const float* Wb = a->ada_w + (size_t)l * DM * (6 * DM) + cg * 256 + 4 * C.lane;
            f32x4 acc = {0.f, 0.f, 0.f, 0.f};
            const int kbeg = C.wave * 256;
#pragma unroll 8
            for (int k = 0; k < 256; ++k) { const float sc = silu_f(a->c[kbeg + k]); const f32x4 w = *(const f32x4*)(Wb + (size_t)(kbeg + k) * (6 * DM)); acc += w * sc; }
            __syncthreads();
            *(LAS f32x4*)(red + C.wave * 256 + 4 * C.lane) = acc;
            __syncthreads();
            if (C.tid < 256) { float v = 0.f;
#pragma unroll
                for (int w = 0; w < 8; ++w) v += red[w * 256 + C.tid];
                const int j = cg * 256 + C.tid, sec = j / DM, col = j % DM;
                v += a->ada_b[(size_t)l * 6 * DM + j];
                if (sec == 1) v = a->norm_mix_g[l * DM + col] * (1.f + v);
                if (sec == 4) v = a->norm_mlp_g[l * DM + col] * (1.f + v);
                ((float*)(ws + WS_MODS))[(size_t)l * 6 * DM + j] = v; }
        }
        __syncthreads();
    }
}
DI void p0_convert(KA a, const Ctx& C) {
    unsigned char* ws = a->ws;
    {
        LAS float* scr = (LAS float*)(C.lds + RING_OFF + C.wave * 16640);
        constexpr int I_W1 = (4096 / 64) * (128 / 64), I_W2 = (128 / 64) * (128 / 64);
        const int n0 = conv_items(0, 0) + conv_items(0, 1) + conv_items(0, 2) + conv_items(0, 3), n1 = conv_items(1, 0);
        const int total = n0 + n1 + 4 * (I_W1 + I_W2);
        for (int it = C.gw; it < total; it += C.NGW) {
            if (it < n0) { int r = it, x = 0; while (r >= conv_items(0, x)) { r -= conv_items(0, x); ++x; } conv_item(a, ws, 0, x, r, scr, C.lane); }
            else if (it < n0 + n1) conv_item(a, ws, 1, 0, it - n0, scr, C.lane);
            else { int r = it - n0 - n1; const int q = r / (I_W1 + I_W2); r %= (I_W1 + I_W2); const int j = q >> 1, kind = q & 1;
                if (r < I_W1) p0_transpose_item((kind ? a->nsa_v_w1 : a->nsa_k_w1) + (size_t)j * 4096 * 128, 4096, 128, 128, (bf16*)(ws + WS_W1T) + (size_t)q * 128 * 4096, scr, r, C.lane, 0);
                else p0_transpose_item((kind ? a->nsa_v_w2 : a->nsa_k_w2) + (size_t)j * 128 * 128, 128, 128, 128, (bf16*)(ws + WS_W2T) + (size_t)q * 128 * 128, scr, r - I_W1, C.lane, 0); }
        }
    }
}

DI void resid_init_phase(const Ctx& C, const float* X, bf16* R, float* ss) {
    for (int m = C.gw; m < S; m += C.NGW) {
        const GAS f32x4* xr = (const GAS f32x4*)(X + (size_t)m * DM) + C.lane;
        f32x4 v[8]; float s = 0.f;
#pragma unroll
        for (int j = 0; j < 8; ++j) { v[j] = xr[64 * j]; s += (v[j].x * v[j].x + v[j].y * v[j].y) + (v[j].z * v[j].z + v[j].w * v[j].w); }
        const float tot = wave_sum(s);
        if (C.lane < 32) ss[(size_t)m * 32 + C.lane] = C.lane == 0 ? tot : 0.f;
        GAS unsigned long long* o8 = (GAS unsigned long long*)(R + (size_t)m * DM) + C.lane;
#pragma unroll
        for (int j = 0; j < 8; ++j) o8[64 * j] = (unsigned long long)pk2(v[j].x, v[j].y) | ((unsigned long long)pk2(v[j].z, v[j].w) << 32);
    }
}
DI bool tail_item(KA a, unsigned char* ws, LAS unsigned char* lds, int l, int which, int ti) {
    const bool n1 = l + 1 < DEPTH, n2 = l + 2 < DEPTH;
    int jl[4], jx[4], nj = 0;
    if (which == 0) { if (n1) { jl[nj] = l + 1; jx[nj++] = 1; jl[nj] = l + 1; jx[nj++] = 2; jl[nj] = l + 1; jx[nj++] = 3; } }
    else if (which == 1) { if (n2) { jl[nj] = l + 2; jx[nj++] = 0; } }
    else { if (n1) { jl[nj] = l + 1; jx[nj++] = 1; jl[nj] = l + 1; jx[nj++] = 2; jl[nj] = l + 1; jx[nj++] = 3; } if (n2) { jl[nj] = l + 2; jx[nj++] = 0; } }
    const int tid = tid_fresh(), lane = tid & 63, wave = __builtin_amdgcn_readfirstlane(tid >> 6);
    LAS float* scr = (LAS float*)(lds + RING_OFF + wave * 16640);
#pragma unroll
    for (int q = 0; q < 4; ++q) { if (q < nj) { const int cnt = conv_items(jl[q], jx[q]) >> 3; if (ti < cnt) { conv_item(a, ws, jl[q], jx[q], ti * 8 + wave, scr, lane); return true; } ti -= cnt; } }
    return false;
}
DI void final_norm_phase(const Ctx& C, const bf16* R, const float* ss, const float* g, float* OUT) {
    for (int m = C.gw; m < S; m += C.NGW) {
        float s = C.lane < 32 ? ss[(size_t)m * 32 + C.lane] : 0.f;
        const float rstd = 1.f / sqrtf(wave_sum(s) * (1.f / DM) + NORM_EPS);
        const GAS v4u* rr = (const GAS v4u*)(R + (size_t)m * DM) + C.lane;
        GAS f32x4* orow = (GAS f32x4*)(OUT + (size_t)m * DM);
        v4u w[4];
#pragma unroll
        for (int j = 0; j < 4; ++j) w[j] = rr[64 * j];
#pragma unroll
        for (int j = 0; j < 4; ++j) { const int c4 = 128 * j + 2 * C.lane;
            const f32x4 g0 = *((const f32x4*)g + c4), g1 = *((const f32x4*)g + c4 + 1);
            const f32x4 x0 = {bf2f(w[j].x & 0xffffu), bf2f(w[j].x >> 16), bf2f(w[j].y & 0xffffu), bf2f(w[j].y >> 16)}, x1 = {bf2f(w[j].z & 0xffffu), bf2f(w[j].z >> 16), bf2f(w[j].w & 0xffffu), bf2f(w[j].w >> 16)};
            orow[c4] = x0 * rstd * g0; orow[c4 + 1] = x1 * rstd * g1; }
    }
}


DI void kmean_phase(const Ctx& C, const bf16* QKV, bf16* KMH, bf16* KML) {
    LAS float* part = (LAS float*)(C.lds + RING_OFF);
    for (int u = blockIdx.x; u < 256; u += C.G) {
        const int h = u >> 5, blk = u & 31;
        const int dch = C.tid & 15, kg = C.tid >> 4;
        float s[8];
#pragma unroll
        for (int e = 0; e < 8; ++e) s[e] = 0.f;
#pragma unroll
        for (int i = 0; i < 8; ++i) { const v4u w = *(const GAS v4u*)(QKV + (size_t)(blk * 256 + kg * 8 + i) * NE + E_KA + h * 128 + dch * 8);
            s[0] += bf2f(w.x & 0xffffu); s[1] += bf2f(w.x >> 16); s[2] += bf2f(w.y & 0xffffu); s[3] += bf2f(w.y >> 16);
            s[4] += bf2f(w.z & 0xffffu); s[5] += bf2f(w.z >> 16); s[6] += bf2f(w.w & 0xffffu); s[7] += bf2f(w.w >> 16); }
        __syncthreads();
#pragma unroll
        for (int e = 0; e < 8; ++e) part[kg * 128 + dch * 8 + e] = s[e];
        __syncthreads();
        if (C.tid < 128) { float v = 0.f;
#pragma unroll
            for (int g = 0; g < 32; ++g) v += part[g * 128 + C.tid];
            v *= (1.f / 256.f);
            const unsigned hb = f2bf(v); const float lo = v - bf2f(hb);
            KMH[(size_t)u * 128 + C.tid] = (bf16)hb; KML[(size_t)u * 128 + C.tid] = (bf16)f2bf(lo); }
    }
    __syncthreads();
}

DI float log_sigmoid_f(float x) { const float t = __builtin_amdgcn_exp2f(-fabsf(x) * 1.4426950408889634f); return fminf(x, 0.f) - 0.6931471805599453f * __builtin_amdgcn_logf(1.f + t); }
DI float gelu_tanh_f(float x) { return 0.5f * x * (1.f + tanhf(0.7978845608028654f * (x + 0.044715f * x * x * x))); }
DI f32x4 mfma16(bf16x8 a, bf16x8 b, f32x4 c) { return __builtin_amdgcn_mfma_f32_16x16x32_bf16(a, b, c, 0, 0, 0); }

#ifndef OP_DUP
#define OP_DUP 0
#endif
DI void oddprep_phase(KA a, const Ctx& C, int j  ) {
    unsigned char* ws = a->ws;
    const float* FG = (const float*)(ws + WS_FG); float* CUM = (float*)(ws + WS_CUM);
    const bf16* QKV = (const bf16*)(ws + WS_QKV);
    for (int u = blockIdx.x; u < 8 + 128 + 64; u += C.G) {
      for (int oprep_ = 0; oprep_ < ((u >= 136 ? (OP_DUP & 4) : (u < 8 ? (OP_DUP & 1) : (OP_DUP & 2))) ? 2 : 1); ++oprep_) {
        if (u >= 8 + 128) {
            const int hw = (u - 136) >> 2, part = (u - 136) & 3, h = hw >> 1, which = hw & 1; const int col = (which ? O_KC : O_QC) + h * 128;
            LAS float* wm = (LAS float*)(C.lds + RING_OFF);
            float mx = 0.f;
#pragma unroll 2
            for (int r = part * 2048 + C.tid; r < part * 2048 + 2048; r += NWAVES * 64) { float ss = 0.f;
#pragma unroll
                for (int i = 0; i < 16; ++i) { const v4u w = *(const GAS v4u*)(QKV + (size_t)r * NO + col + 8 * i);
                    const float a0 = bf2f(w.x & 0xffffu), a1 = bf2f(w.x >> 16), a2 = bf2f(w.y & 0xffffu), a3 = bf2f(w.y >> 16), a4 = bf2f(w.z & 0xffffu), a5 = bf2f(w.z >> 16), a6 = bf2f(w.w & 0xffffu), a7 = bf2f(w.w >> 16);
                    ss += (a0 * a0 + a1 * a1) + (a2 * a2 + a3 * a3) + (a4 * a4 + a5 * a5) + (a6 * a6 + a7 * a7); }
                mx = fmaxf(mx, ss); }
#pragma unroll
            for (int o = 1; o < 64; o <<= 1) mx = fmaxf(mx, __shfl_xor(mx, o));
            __syncthreads();
            if (C.lane == 0) wm[C.wave] = mx;
            __syncthreads();
            if (C.tid == 0) { float m = 0.f; for (int w = 0; w < NWAVES; ++w) m = fmaxf(m, wm[w]);
                __hip_atomic_fetch_max((gu32*)(ws + WS_CTL) + CW_FOXN + 16 * j + h * 2 + which, __builtin_bit_cast(unsigned, sqrtf(m)), RLX_AGENT); }
            __syncthreads();
        } else if (u < 8) {
            const int h = u; const float fb = a->fox_forget_b[j * 8 + h];
            LAS float* wtot = (LAS float*)(C.lds + RING_OFF);
            float v[16]; float run = 0.f;
#pragma unroll
            for (int i = 0; i < 16; ++i) { run += log_sigmoid_f(FG[(size_t)h * S + C.tid * 16 + i] + fb); v[i] = run; }
            float sc = run;
#pragma unroll
            for (int o = 1; o < 64; o <<= 1) { const float n = __shfl_up(sc, o); if (C.lane >= o) sc += n; }
            __syncthreads();
            if (C.lane == 63) wtot[C.wave] = sc;
            __syncthreads();
            float base = sc - run;
            for (int w = 0; w < C.wave; ++w) base += wtot[w];
#pragma unroll
            for (int i = 0; i < 16; ++i) CUM[(size_t)h * S + C.tid * 16 + i] = base + v[i];
            __syncthreads();
        } else {
            const int cu = u - 8, kind = cu >> 6, hd = (cu >> 5) & 1, n0 = (cu & 31) * 16;
            const int srccol = (kind ? O_VCMP : O_KCMP) + hd * 128;
            const float* pos = (kind ? a->nsa_v_pos : a->nsa_k_pos) + (size_t)j * 32 * 128;
            const bf16* w1t = (const bf16*)(ws + WS_W1T) + (size_t)(j * 2 + kind) * 128 * 4096;
            const bf16* w2t = (const bf16*)(ws + WS_W2T) + (size_t)(j * 2 + kind) * 128 * 128;
            bf16* dst = (bf16*)(ws + (kind ? WS_VC : WS_KC));
            LAS float* red = (LAS float*)(C.lds + RING_OFF);
            LAS bf16* h1b = (LAS bf16*)(C.lds + RING_OFF + 65536);
            const int row = C.lane & 15, kg = C.lane >> 4;
            f32x4 acc[8];
#pragma unroll
            for (int cb = 0; cb < 8; ++cb) acc[cb] = (f32x4){0.f, 0.f, 0.f, 0.f};
#define CMP_LOAD(step_, w_, q0_, q1_, b_) do { const int l_ = C.wave * 4 + ((step_) >> 2), d_ = 32 * ((step_) & 3) + 8 * kg; int tok_ = 16 * (n0 + row) + l_; if (tok_ > S - 1) tok_ = S - 1; \
                w_ = *(const GAS v4u*)(QKV + (size_t)tok_ * NO + srccol + d_); q0_ = *(const f32x4*)(pos + l_ * 128 + d_); q1_ = *(const f32x4*)(pos + l_ * 128 + d_ + 4);          \
                _Pragma("unroll") for (int cb = 0; cb < 8; ++cb) b_[cb] = *(const GAS bf16x8*)(w1t + (size_t)(cb * 16 + row) * 4096 + l_ * 128 + d_); } while (0)
#define CMP_MMA(w_, q0_, q1_, b_) do { v4u aw; aw.x = pk2(bf2f(w_.x & 0xffffu) + q0_.x, bf2f(w_.x >> 16) + q0_.y); aw.y = pk2(bf2f(w_.y & 0xffffu) + q0_.z, bf2f(w_.y >> 16) + q0_.w);                 \
                aw.z = pk2(bf2f(w_.z & 0xffffu) + q1_.x, bf2f(w_.z >> 16) + q1_.y); aw.w = pk2(bf2f(w_.w & 0xffffu) + q1_.z, bf2f(w_.w >> 16) + q1_.w);                                            \
                const bf16x8 af = __builtin_bit_cast(bf16x8, aw); _Pragma("unroll") for (int cb = 0; cb < 8; ++cb) acc[cb] = mfma16(af, b_[cb], acc[cb]); } while (0)
            { v4u wa, wb; f32x4 pa0, pa1, pb0, pb1; bf16x8 ba[8], bb[8];
              CMP_LOAD(0, wa, pa0, pa1, ba);
#pragma unroll 1
              for (int st = 0; st < 16; st += 2) { CMP_LOAD(st + 1, wb, pb0, pb1, bb); CMP_MMA(wa, pa0, pa1, ba); if (st + 2 < 16) CMP_LOAD(st + 2, wa, pa0, pa1, ba); CMP_MMA(wb, pb0, pb1, bb); } }
#undef CMP_LOAD
#undef CMP_MMA
            __syncthreads();
#pragma unroll
            for (int cb = 0; cb < 8; ++cb)
#pragma unroll
                for (int e = 0; e < 4; ++e) red[(C.wave * 16 + 4 * kg + e) * 128 + cb * 16 + row] = acc[cb][e];
            __syncthreads();
            for (int e = C.tid; e < 16 * 128; e += NWAVES * 64) { float v = 0.f;
#pragma unroll
                for (int w = 0; w < 8; ++w) v += red[w * 2048 + e];
                h1b[(e >> 7) * 136 + (e & 127)] = (bf16)f2bf(gelu_tanh_f(v)); }
            __syncthreads();
            {
                f32x4 o = {0.f, 0.f, 0.f, 0.f};
#pragma unroll
                for (int ks = 0; ks < 4; ++ks) { const bf16x8 af = *(const LAS bf16x8*)(h1b + row * 136 + 32 * ks + 8 * kg);
                    const bf16x8 bfr = *(const GAS bf16x8*)(w2t + (size_t)(C.wave * 16 + row) * 128 + 32 * ks + 8 * kg);
                    o = mfma16(af, bfr, o); }
#pragma unroll
                for (int e = 0; e < 4; ++e) { const int n = n0 + 4 * kg + e; dst[(size_t)n * 256 + hd * 128 + C.wave * 16 + row] = (n < NCMP) ? (bf16)f2bf(o[e]) : (bf16)0; }
            }
            __syncthreads();
        }
      }
    }
}

DI void moba_combine_phase(const Ctx& C, const bf16* PO, const float* PML, bf16* O) {
    constexpr float C2 = 0.08838834764831845f * 1.4426950408889634f;
    for (int item = C.gw; item < 8 * S; item += C.NGW) {
        const int token = item >> 3, h = item & 7; const int nsel = (token >> 8) < 3 ? (token >> 8) : 3;
        const size_t pb = ((size_t)h * S + token) * 4;
        const f32x4 ml01 = *(const f32x4*)(PML + pb * 2), ml23 = *(const f32x4*)(PML + pb * 2 + 4);
        const float m0 = ml01.x, l0 = ml01.y, m1 = ml01.z, l1 = ml01.w, m2 = ml23.x, l2 = ml23.y, m3 = ml23.z, l3 = ml23.w;
        float M = m3; if (nsel > 0) M = fmaxf(M, m0); if (nsel > 1) M = fmaxf(M, m1); if (nsel > 2) M = fmaxf(M, m2);
        const float w3 = l3 * __builtin_amdgcn_exp2f((m3 - M) * C2);
        const float w0 = nsel > 0 ? l0 * __builtin_amdgcn_exp2f((m0 - M) * C2) : 0.f, w1 = nsel > 1 ? l1 * __builtin_amdgcn_exp2f((m1 - M) * C2) : 0.f, w2 = nsel > 2 ? l2 * __builtin_amdgcn_exp2f((m2 - M) * C2) : 0.f;
        const GAS unsigned* po = (const GAS unsigned*)(PO + pb * 128) + C.lane;
        const unsigned u3 = po[3 * 64]; float a0 = w3 * bf2f(u3 & 0xffffu), a1 = w3 * bf2f(u3 >> 16);
        if (nsel > 0) { const unsigned u = po[0]; a0 += w0 * bf2f(u & 0xffffu); a1 += w0 * bf2f(u >> 16); }
        if (nsel > 1) { const unsigned u = po[64]; a0 += w1 * bf2f(u & 0xffffu); a1 += w1 * bf2f(u >> 16); }
        if (nsel > 2) { const unsigned u = po[128]; a0 += w2 * bf2f(u & 0xffffu); a1 += w2 * bf2f(u >> 16); }
        const float inv = 1.f / (w0 + w1 + w2 + w3);
        *((GAS unsigned*)(O + (size_t)token * DM + h * 128) + C.lane) = pk2(a0 * inv, a1 * inv);
    }
}

namespace att {
#ifndef FOX_SKIP
#define FOX_SKIP 1
#endif
#ifndef NSA_DUP
#define NSA_DUP 0
#endif
constexpr float SCALE = 0.08838834764831845f, LOG2E = 1.4426950408889634f, C2 = SCALE * LOG2E, INV_SCALE = 11.313708498984761f;
constexpr float THR = 8.f;
constexpr int KVBLK = 64, SHM_K = 16384, SHM_V = 16384;
constexpr int L_V = 0, L_K = 2 * SHM_V, L_WS = 65536, L_BIAS = L_WS + 2048, L_MISC = L_BIAS + 512, L_IMP = L_MISC + 1536, IMP_STRIDE = 132, L_SEL = L_IMP + 64 * IMP_STRIDE * 4, L_END = L_SEL + 1024;
static_assert(L_END <= RING_BYTES, "attention LDS map");
#define KSWZ(row, colB) ((row) * 256 + ((colB) ^ (((row) & 15) << 4)))
#define SBAR() __builtin_amdgcn_sched_barrier(0)
DI int v_st(int k, int c) { const int kk = (k & ~0xC) | ((k & 4) << 1) | ((k & 8) >> 1); return ((kk >> 3) * 4 + (c >> 5)) * 512 + ((kk & 7) * 32 + (c & 31)) * 2; }
DI int v_rd_base(int lane) { return ((lane & 3) << 3) | (((lane >> 2) & 3) << 6) | (((lane >> 4) & 1) << 5) | (((lane >> 5) & 1) << 8); }
constexpr int v_rd_off(int d0, int ks, int half) { return d0 * 512 + ks * 4096 + half * 2048; }
DI int crow(int r, int hi) { return (r & 3) + 8 * (r >> 2) + 4 * hi; }
DI unsigned cvtpk(float lo, float hi) { unsigned r; asm volatile("v_cvt_pk_bf16_f32 %0, %1, %2" : "=v"(r) : "v"(lo), "v"(hi)); return r; }

struct Cx {
    LAS char* lds; int tid, wid, lane, r32, hi, sr, sc, kws, vst0, vst1, vb0; LAS float* li_l; LAS float* al_l;
};
DI Cx make_cx(LAS unsigned char* lds_) {
    Cx c; c.lds = (LAS char*)lds_; c.tid = tid_fresh(); c.wid = __builtin_amdgcn_readfirstlane(c.tid >> 6); c.lane = c.tid & 63; c.r32 = c.lane & 31; c.hi = c.lane >> 5;
    c.sr = c.tid >> 4; c.sc = (c.tid & 15) * 8; c.kws = KSWZ(c.sr, c.sc * 2); c.vst0 = v_st(c.sr, c.sc); c.vst1 = v_st(32 + c.sr, c.sc);
    c.vb0 = (int)(unsigned)(uintptr_t)(c.lds + L_V) + v_rd_base(c.lane);
    c.li_l = (LAS float*)(c.lds + L_WS) + c.wid * 64; c.al_l = c.li_l + 32;
    return c;
}
struct Stage { bf16x8 k0, k1, v0, v1; float ex; };

DI void qkt(f32x16& p0, f32x16& p1, const LAS char* Kb, int r32, int hi, const bf16x8* qr) {
#pragma unroll
    for (int r = 0; r < 16; ++r) { p0[r] = 0.f; p1[r] = 0.f; }
    const LAS char* kbase = Kb + r32 * 256; const int xs = ((r32 & 15) ^ hi) << 4;
#pragma unroll
    for (int d0 = 0; d0 < 8; ++d0) { const LAS char* a = kbase + ((d0 * 32) ^ xs);
        const bf16x8 b0 = *(const LAS bf16x8*)a, b1 = *(const LAS bf16x8*)(a + 32 * 256);
        p0 = __builtin_amdgcn_mfma_f32_32x32x16_bf16(b0, qr[d0], p0, 0, 0, 0);
        p1 = __builtin_amdgcn_mfma_f32_32x32x16_bf16(b1, qr[d0], p1, 0, 0, 0); }
}
DI void partialSM(f32x16& p0, f32x16& p1, float& m_reg, float& mn, float& alpha) {
    float pmax = p0[0];
#pragma unroll
    for (int r = 1; r < 16; ++r) pmax = fmaxf(pmax, p0[r]);
#pragma unroll
    for (int r = 0; r < 16; ++r) pmax = fmaxf(pmax, p1[r]);
    { auto rr = __builtin_amdgcn_permlane32_swap(__float_as_uint(pmax), __float_as_uint(pmax), false, false);
      pmax = fmaxf(__uint_as_float(rr[0]), __uint_as_float(rr[1])); }
    if (__builtin_expect(__all((pmax - m_reg) * SCALE <= THR), 1)) { mn = m_reg; alpha = 1.f; }
    else { mn = fmaxf(m_reg, pmax); alpha = __builtin_amdgcn_exp2f((m_reg - mn) * C2); m_reg = mn; }
    const float mnL = -mn * C2;
#pragma unroll
    for (int r = 0; r < 16; ++r) p0[r] = fmaf(p0[r], C2, mnL);
#pragma unroll
    for (int r = 0; r < 16; ++r) p1[r] = fmaf(p1[r], C2, mnL);
#pragma unroll
    for (int r = 0; r < 16; ++r) p0[r] = __builtin_amdgcn_exp2f(p0[r]);
}
DI void pack_p(const f32x16& p0, const f32x16& p1, bf16x8& pa0, bf16x8& pa1, bf16x8& pa2, bf16x8& pa3) {
#define PK4(P, B_, OUT) do { unsigned a0 = cvtpk(P[B_+0], P[B_+1]), a1 = cvtpk(P[B_+2], P[B_+3]);                          \
        unsigned b0 = cvtpk(P[B_+4], P[B_+5]), b1 = cvtpk(P[B_+6], P[B_+7]);                                             \
        auto r0 = __builtin_amdgcn_permlane32_swap(a0, b0, false, false); auto r1 = __builtin_amdgcn_permlane32_swap(a1, b1, false, false); \
        v4u w = {r0[0], r1[0], r0[1], r1[1]}; OUT = __builtin_bit_cast(bf16x8, w); } while (0)
    PK4(p0, 0, pa0); PK4(p0, 8, pa1); PK4(p1, 0, pa2); PK4(p1, 8, pa3);
#undef PK4
}
DI void finishSM(f32x16& p0, f32x16& p1, float alpha, float& l_reg, bf16x8& pa0, bf16x8& pa1, bf16x8& pa2, bf16x8& pa3) {
#pragma unroll
    for (int r = 0; r < 16; ++r) p1[r] = __builtin_amdgcn_exp2f(p1[r]);
    float ps = 0;
#pragma unroll
    for (int r = 0; r < 16; ++r) ps += p0[r];
#pragma unroll
    for (int r = 0; r < 16; ++r) ps += p1[r];
    { auto rr = __builtin_amdgcn_permlane32_swap(__float_as_uint(ps), __float_as_uint(ps), false, false);
      ps = __uint_as_float(rr[0]) + __uint_as_float(rr[1]); }
    l_reg = l_reg * alpha + ps;
    pack_p(p0, p1, pa0, pa1, pa2, pa3);
}
DI void pv_tile(f32x16* o, int vb0, bf16x8 pa0, bf16x8 pa1, bf16x8 pa2, bf16x8 pa3) {
#define TRRD(dst, off) asm volatile("ds_read_b64_tr_b16 %0, %1 offset:%2" : "=&v"(dst) : "v"(vb0), "i"(off) : "memory")
#define PV_D0(d0) do { s16x4 l0, l1, l2, l3, h0, h1, h2, h3; constexpr int b_ = v_rd_off(d0, 0, 0); \
        TRRD(l0, b_); TRRD(h0, b_ + 2048); TRRD(l1, b_ + 4096); TRRD(h1, b_ + 6144); TRRD(l2, b_ + 8192); TRRD(h2, b_ + 10240); TRRD(l3, b_ + 12288); TRRD(h3, b_ + 14336); \
        asm volatile("s_waitcnt lgkmcnt(0)" ::: "memory"); SBAR();   \
        o[d0] = __builtin_amdgcn_mfma_f32_32x32x16_bf16(pa0, (bf16x8){l0[0], l0[1], l0[2], l0[3], h0[0], h0[1], h0[2], h0[3]}, o[d0], 0, 0, 0);   \
        o[d0] = __builtin_amdgcn_mfma_f32_32x32x16_bf16(pa1, (bf16x8){l1[0], l1[1], l1[2], l1[3], h1[0], h1[1], h1[2], h1[3]}, o[d0], 0, 0, 0);   \
        o[d0] = __builtin_amdgcn_mfma_f32_32x32x16_bf16(pa2, (bf16x8){l2[0], l2[1], l2[2], l2[3], h2[0], h2[1], h2[2], h2[3]}, o[d0], 0, 0, 0);   \
        o[d0] = __builtin_amdgcn_mfma_f32_32x32x16_bf16(pa3, (bf16x8){l3[0], l3[1], l3[2], l3[3], h3[0], h3[1], h3[2], h3[3]}, o[d0], 0, 0, 0); } while (0)
    PV_D0(0); PV_D0(1); PV_D0(2); PV_D0(3);
#undef PV_D0
#undef TRRD
}
DI void rescale_o(const Cx& c, f32x16* o, float alpha) {
    if (__any(alpha < 1.f)) { if (c.hi == 0) c.al_l[c.r32] = alpha; asm volatile("s_waitcnt lgkmcnt(0)" ::: "memory");
#pragma unroll
        for (int d = 0; d < 4; ++d)
#pragma unroll
            for (int r = 0; r < 16; ++r) o[d][r] *= c.al_l[crow(r, c.hi)];
    }
}
DI void mask_tile(f32x16& p0, f32x16& p1, int dq, unsigned W) {
    const float NEG = -__builtin_inff();
#pragma unroll
    for (int r = 0; r < 16; ++r) { const int cc = (r & 3) + 8 * (r >> 2);
        if ((unsigned)(dq - cc) >= W) p0[r] = NEG;
        if ((unsigned)(dq - cc - 32) >= W) p1[r] = NEG; }
}
DI void kill_tile(f32x16& p0, f32x16& p1) { const float NEG = -__builtin_inff();
#pragma unroll
    for (int r = 0; r < 16; ++r) { p0[r] = NEG; p1[r] = NEG; } }

template <int MODE, class P>
DI void run(const Cx& c, P& prob, const bf16x8* qr, float& m_reg, float& l_reg, f32x16* o) {
    const int nt = prob.ntiles();
    if (nt <= 0) return;
    Stage st;
    { const bf16 *kp, *vp; int kpitch, vpitch; prob.src(0, kp, vp, kpitch, vpitch);
      st.k0 = *(const GAS bf16x8*)(kp + (size_t)c.sr * kpitch + c.sc); st.k1 = *(const GAS bf16x8*)(kp + (size_t)(32 + c.sr) * kpitch + c.sc);
      if (MODE == 0) { st.v0 = *(const GAS bf16x8*)(vp + (size_t)c.sr * vpitch + c.sc); st.v1 = *(const GAS bf16x8*)(vp + (size_t)(32 + c.sr) * vpitch + c.sc); }
      st.ex = prob.extra(0); }
    const float inv_l = (MODE == 1) ? (l_reg > 0.f ? 1.f / l_reg : 0.f) : 0.f;
    for (int t = 0; t < nt; ++t) {
        const int buf = t & 1;
        *(LAS bf16x8*)(c.lds + L_K + buf * SHM_K + c.kws) = st.k0; *(LAS bf16x8*)(c.lds + L_K + buf * SHM_K + c.kws + 32 * 256) = st.k1;
        if (MODE == 0) { *(LAS bf16x8*)(c.lds + L_V + buf * SHM_V + c.vst0) = st.v0; *(LAS bf16x8*)(c.lds + L_V + buf * SHM_V + c.vst1) = st.v1; }
        prob.put_extra(t, buf, st.ex);
        __syncthreads();
        if (t + 1 < nt) { const bf16 *kp, *vp; int kpitch, vpitch; prob.src(t + 1, kp, vp, kpitch, vpitch);
            st.k0 = *(const GAS bf16x8*)(kp + (size_t)c.sr * kpitch + c.sc); st.k1 = *(const GAS bf16x8*)(kp + (size_t)(32 + c.sr) * kpitch + c.sc);
            if (MODE == 0) { st.v0 = *(const GAS bf16x8*)(vp + (size_t)c.sr * vpitch + c.sc); st.v1 = *(const GAS bf16x8*)(vp + (size_t)(32 + c.sr) * vpitch + c.sc); }
            st.ex = prob.extra(t + 1); }
        if (prob.active(t)) {
            f32x16 p0, p1;
            qkt(p0, p1, c.lds + L_K + buf * SHM_K, c.r32, c.hi, qr);
            prob.mask(p0, p1, t, buf);
            if (MODE == 0) {
                float mn, alpha; partialSM(p0, p1, m_reg, mn, alpha);
                rescale_o(c, o, alpha);
                bf16x8 pa0, pa1, pa2, pa3; finishSM(p0, p1, alpha, l_reg, pa0, pa1, pa2, pa3);
                pv_tile(o, c.vb0 + buf * SHM_V, pa0, pa1, pa2, pa3);
            } else {
                const float mnL = -m_reg * C2;
#pragma unroll
                for (int r = 0; r < 16; ++r) { p0[r] = __builtin_amdgcn_exp2f(fmaf(p0[r], C2, mnL)) * inv_l; p1[r] = __builtin_amdgcn_exp2f(fmaf(p1[r], C2, mnL)) * inv_l; }
                prob.post(p0, p1, t, true);
            }
        } else if (MODE == 1) { f32x16 z0, z1; prob.post(z0, z1, t, false); }
    }
    __syncthreads();
}

DI void load_q(bf16x8* qr, const bf16* Q, int pitch, int token, int col, int hi) {
#pragma unroll
    for (int d0 = 0; d0 < 8; ++d0) qr[d0] = *(const GAS bf16x8*)(Q + (size_t)token * pitch + col + d0 * 16 + hi * 8);
}
DI void row_coefs(const Cx& c, float coef, float* rc) {
    if (c.hi == 0) c.li_l[c.r32] = coef; asm volatile("s_waitcnt lgkmcnt(0)" ::: "memory");
#pragma unroll
    for (int r = 0; r < 16; ++r) rc[r] = c.li_l[crow(r, c.hi)];
    asm volatile("s_waitcnt lgkmcnt(0)" ::: "memory");
}
template <bool GQA>
DI void store_o(const Cx& c, const f32x16* o, const float* rc, bf16* O, int tok0  , int col0  ) {
#pragma unroll
    for (int r = 0; r < 16; ++r) { const int rr = crow(r, c.hi);
        const int token = GQA ? tok0 + (rr >> 2) : tok0 + rr; const int col = GQA ? col0 + (rr & 3) * 128 : col0;
#pragma unroll
        for (int d0 = 0; d0 < 4; ++d0) { const float v = o[d0][r] * rc[r]; const float vn = __shfl_xor(v, 1);
            if ((c.r32 & 1) == 0) *(GAS unsigned*)(O + (size_t)token * DM + col + d0 * 32 + c.r32) = cvtpk(v, vn); } }
}

DI void moba_gate_unit(LAS unsigned char* lds_, const bf16* QKV, const bf16* KMH, const bf16* KML, gu32* cnt  , unsigned* list  , int h, int qb) {
    if (qb == 0) return;
    const Cx c = make_cx(lds_);
    const int P0 = qb * 256, token = P0 + c.wid * 32 + c.r32;
    bf16x8 qr[8]; load_q(qr, QKV, NE, token, E_QA + h * 128, c.hi);
    unsigned taken = 0u;
    {
        f32x16 g;
#pragma unroll
        for (int r = 0; r < 16; ++r) g[r] = 0.f;
#pragma unroll
        for (int d0 = 0; d0 < 8; ++d0) { const size_t off = ((size_t)h * 32 + c.r32) * 128 + d0 * 16 + c.hi * 8;
            const bf16x8 kh = *(const GAS bf16x8*)(KMH + off), kl = *(const GAS bf16x8*)(KML + off);
            g = __builtin_amdgcn_mfma_f32_32x32x16_bf16(kh, qr[d0], g, 0, 0, 0); g = __builtin_amdgcn_mfma_f32_32x32x16_bf16(kl, qr[d0], g, 0, 0, 0); }
        const float NEG = -__builtin_inff();
#pragma unroll
        for (int it = 0; it < (BREAK == 6 ? 2 : 3); ++it) { float best = NEG; int bi = 99;
#pragma unroll
            for (int r = 0; r < 16; ++r) { const int b = crow(r, c.hi); const float v = (b < qb && !((taken >> b) & 1u)) ? g[r] : NEG; if (v > best) { best = v; bi = b; } }
            const float ob = __shfl_xor(best, 32); const int obi = __shfl_xor(bi, 32);
            if (ob > best || (ob == best && obi < bi)) { best = ob; bi = obi; }
            if (best > NEG) taken |= 1u << bi; }
    }
    const unsigned lt = (1u << c.r32) - 1u;
    unsigned my_n = 0u;
    for (int j = 0; j < qb; ++j) { const unsigned long long b = __ballot(c.hi == 0 && ((taken >> j) & 1u)); if (c.lane == j) my_n = (unsigned)__popcll(b); }
    unsigned base = 0u;
    if (c.lane < qb && my_n) base = __hip_atomic_fetch_add(cnt + h * 32 + c.lane, my_n, RLX_AGENT);
    for (int j = 0; j < qb; ++j) { const bool sl = c.hi == 0 && ((taken >> j) & 1u); const unsigned m = (unsigned)__ballot(sl); const unsigned bj = __shfl(base, j);
        if (sl) list[((size_t)h * 32 + j) * 8192 + bj + __popc(m & lt)] = (unsigned)token | ((unsigned)__popc(taken & ((1u << j) - 1u)) << 16); }
}
struct BlkProb {
    const bf16* QKV; int h, key0, causal, qlo, qpos, hi; bool wact  ;
    DI int ntiles() const { return 4; }
    DI void src(int t, const bf16*& k, const bf16*& v, int& kp, int& vp) const { const size_t kk = (size_t)(key0 + t * 64); k = QKV + kk * NE + E_KA + h * 128; v = QKV + kk * NE + E_VA + h * 128; kp = NE; vp = NE; }
    DI float extra(int) const { return 0.f; }
    DI void put_extra(int, int, float) const {}
    DI bool active(int t) const { return causal ? (key0 + t * 64 <= qlo + 31) : wact; }
    DI void mask(f32x16& p0, f32x16& p1, int t, int) const { if (causal) { const int kb = key0 + t * 64; if (kb + 63 > qlo) mask_tile(p0, p1, qpos - 4 * hi - kb, 0x7fffffffu); } }
    DI void post(f32x16&, f32x16&, int, bool) const {}
};
DI void moba_blk_unit(LAS unsigned char* lds_, const bf16* QKV, const gu32* cnt, const unsigned* list, bf16* PO, float* PML, int h, int j, int r) {
    const Cx c = make_cx(lds_);
    int token, slot; bool valid = true;
    if (r < 0) { token = j * 256 + c.wid * 32 + c.r32; slot = 3; }
    else { const int n = (int)cnt[h * 32 + j], row = r * 256 + c.wid * 32 + c.r32; valid = row < n;
        const unsigned e = list[((size_t)h * 32 + j) * 8192 + (valid ? row : 0)]; token = (int)(e & 0xffffu); slot = (int)(e >> 16); }
    bf16x8 qr[8]; load_q(qr, QKV, NE, token, E_QA + h * 128, c.hi);
    BlkProb pr; pr.QKV = QKV; pr.h = h; pr.key0 = j * 256; pr.causal = r < 0 ? 1 : 0; pr.qlo = j * 256 + c.wid * 32; pr.qpos = token; pr.hi = c.hi; pr.wact = __any(valid);
    float m_reg = -1e30f, l_reg = 0.f; f32x16 o[4];
#pragma unroll
    for (int d = 0; d < 4; ++d)
#pragma unroll
        for (int q = 0; q < 16; ++q) o[d][q] = 0.f;
    run<0>(c, pr, qr, m_reg, l_reg, o);
    const int dest = valid ? (((h * 8192 + token) << 2) + slot) : -1;
    if (valid && c.hi == 0) { GAS float* ml = (GAS float*)PML + (size_t)dest * 2; ml[0] = m_reg; ml[1] = l_reg; }
    float rc[16]; row_coefs(c, l_reg > 0.f ? 1.f / l_reg : 0.f, rc);
    int dst[16];
    { LAS int* il = (LAS int*)c.li_l; if (c.hi == 0) il[c.r32] = dest; asm volatile("s_waitcnt lgkmcnt(0)" ::: "memory");
#pragma unroll
      for (int q = 0; q < 16; ++q) dst[q] = il[crow(q, c.hi)];
      asm volatile("s_waitcnt lgkmcnt(0)" ::: "memory"); }
#pragma unroll
    for (int q = 0; q < 16; ++q) {
#pragma unroll
        for (int d0 = 0; d0 < 4; ++d0) { const float v = o[d0][q] * rc[q]; const float vn = __shfl_xor(v, 1);
            if ((c.r32 & 1) == 0 && dst[q] >= 0) *(GAS unsigned*)(PO + (size_t)dst[q] * 128 + d0 * 32 + c.r32) = cvtpk(v, vn); } }
}

struct WinProb {
    const bf16* QKV; int pitch, kcol, vcol, t0  , nt, qlo  , qpos, hi; unsigned W;
    DI int ntiles() const { return nt; }
    DI void src(int t, const bf16*& k, const bf16*& v, int& kp, int& vp) const { const size_t key0 = (size_t)(t0 + t) * 64; k = QKV + key0 * pitch + kcol; v = QKV + key0 * pitch + vcol; kp = pitch; vp = pitch; }
    DI float extra(int) const { return 0.f; }
    DI void put_extra(int, int, float) const {}
    DI bool active(int t) const { const int kb = (t0 + t) * 64; return kb <= qlo + 7 && kb + 63 >= qlo - (int)W + 1; }
    DI void mask(f32x16& p0, f32x16& p1, int t, int) const { const int kb = (t0 + t) * 64; if (kb + 63 > qlo || kb <= qlo + 7 - (int)W) mask_tile(p0, p1, qpos - 4 * hi - kb, W); }
    DI void post(f32x16&, f32x16&, int, bool) const {}
};
DI void swa_unit(LAS unsigned char* lds_, const bf16* QKV, const float* sinks, bf16* O, int kvh, int ch) {
    const Cx c = make_cx(lds_);
    const int T0 = ch * 64, token = T0 + c.wid * 8 + (c.r32 >> 2), hq = kvh * 4 + (c.r32 & 3);
    bf16x8 qr[8]; load_q(qr, QKV, NE, token, E_QB + hq * 128, c.hi);
    WinProb pr; pr.QKV = QKV; pr.pitch = NE; pr.kcol = E_KB + kvh * 128; pr.vcol = E_VB + kvh * 128; pr.t0 = ch >= 2 ? ch - 2 : 0; pr.nt = ch + 1 - pr.t0;
    pr.qlo = T0 + c.wid * 8; pr.qpos = token; pr.hi = c.hi; pr.W = 128u;
    float m_reg = sinks[hq] * INV_SCALE, l_reg = 1.f; f32x16 o[4];
#pragma unroll
    for (int d = 0; d < 4; ++d)
#pragma unroll
        for (int r = 0; r < 16; ++r) o[d][r] = 0.f;
    run<0>(c, pr, qr, m_reg, l_reg, o);
    float rc[16]; row_coefs(c, 1.f / l_reg, rc);
    store_o<true>(c, o, rc, O, T0 + c.wid * 8, 1024 + kvh * 512);
}

struct FoxProb {
    const bf16* QKV; const float* cum  ; float cb; int h, qb, qlo, qpos, hi, tid, a0  ; const LAS float* bias;
    DI int ntiles() const { return 4 * (qb + 1) - a0; }
    DI void src(int t, const bf16*& k, const bf16*& v, int& kp, int& vp) const { const size_t key0 = (size_t)(a0 + t) * 64; k = QKV + key0 * NO + O_KC + h * 128; v = QKV + key0 * NO + O_VC + h * 128; kp = NO; vp = NO; }
    DI float extra(int t) const { return tid < 64 ? cum[(a0 + t) * 64 + tid] : 0.f; }
    DI void put_extra(int, int buf, float ex) const { if (tid < 64) ((LAS float*)bias)[buf * 64 + tid] = (cb - ex) * INV_SCALE; }
    DI bool active(int t) const { return (a0 + t) * 64 <= qlo + 31; }
    DI void mask(f32x16& p0, f32x16& p1, int t, int buf) const {
        const LAS float* b = bias + buf * 64 + 4 * hi;
#pragma unroll
        for (int g = 0; g < 4; ++g) { const f32x4 b0 = *(const LAS f32x4*)(b + 8 * g), b1 = *(const LAS f32x4*)(b + 32 + 8 * g);
#pragma unroll
            for (int e = 0; e < 4; ++e) { p0[4 * g + e] += b0[e]; p1[4 * g + e] += b1[e]; } }
        const int kb = (a0 + t) * 64; if (kb + 63 > qlo) mask_tile(p0, p1, qpos + (BREAK == 8 ? 1 : 0) - 4 * hi - kb, 0x7fffffffu);
    }
    DI void post(f32x16&, f32x16&, int, bool) const {}
};
DI void fox_unit(LAS unsigned char* lds_, const bf16* QKV, const float* CUM, const float* FOXN, bf16* O, int h, int qb) {
    const Cx c = make_cx(lds_);
    const int P0 = qb * 256, token = P0 + c.wid * 32 + c.r32;
    bf16x8 qr[8]; load_q(qr, QKV, NO, token, O_QC + h * 128, c.hi);
    FoxProb pr; pr.QKV = QKV; pr.cum = CUM + (size_t)h * S; pr.cb = pr.cum[P0]; pr.h = h; pr.qb = qb; pr.qlo = P0 + c.wid * 32; pr.qpos = token; pr.hi = c.hi; pr.tid = c.tid;
    pr.bias = (const LAS float*)(c.lds + L_BIAS);
    {
        LAS int* a0w = (LAS int*)(c.lds + L_MISC);
        float dl = 0.f;
#pragma unroll
        for (int d0 = 0; d0 < 8; ++d0) { const v4u kw = *(const GAS v4u*)(QKV + (size_t)token * NO + O_KC + h * 128 + d0 * 16 + c.hi * 8); const v4u qw = __builtin_bit_cast(v4u, qr[d0]);
            dl += bf2f(qw.x & 0xffffu) * bf2f(kw.x & 0xffffu) + bf2f(qw.x >> 16) * bf2f(kw.x >> 16) + bf2f(qw.y & 0xffffu) * bf2f(kw.y & 0xffffu) + bf2f(qw.y >> 16) * bf2f(kw.y >> 16);
            dl += bf2f(qw.z & 0xffffu) * bf2f(kw.z & 0xffffu) + bf2f(qw.z >> 16) * bf2f(kw.z >> 16) + bf2f(qw.w & 0xffffu) * bf2f(kw.w & 0xffffu) + bf2f(qw.w >> 16) * bf2f(kw.w >> 16); }
        dl = (dl + __shfl_xor(dl, 32)) * SCALE;
#pragma unroll
        for (int ofs = 1; ofs < 32; ofs <<= 1) dl = fminf(dl, __shfl_xor(dl, ofs));
        LAS float* dmin = (LAS float*)(c.lds + L_MISC) + 16;
        if (c.lane == 0) dmin[c.wid] = dl;
        if (c.tid == 0) *a0w = 4 * qb;
        __syncthreads();
        float dlmin = dmin[0];
#pragma unroll
        for (int w = 1; w < NWAVES; ++w) dlmin = fminf(dlmin, dmin[w]);
        const float Bqk = FOXN[h * 2] * FOXN[h * 2 + 1] * SCALE * 1.01f + 1.f;
        const float thr = 110.f + Bqk - fmaxf(fminf(dlmin, Bqk), -Bqk) + 1.f;
        if (c.tid < 4 * qb && pr.cb - pr.cum[c.tid * 64 + 63] >= -thr) __hip_atomic_fetch_min(a0w, c.tid, __ATOMIC_RELAXED, __HIP_MEMORY_SCOPE_WORKGROUP);
        __syncthreads();
        pr.a0 = FOX_SKIP ? *a0w : 0;
        __syncthreads();
    }
    float m_reg = -1e30f, l_reg = 0.f; f32x16 o[4];
#pragma unroll
    for (int d = 0; d < 4; ++d)
#pragma unroll
        for (int r = 0; r < 16; ++r) o[d][r] = 0.f;
    run<0>(c, pr, qr, m_reg, l_reg, o);
    float rc[16]; row_coefs(c, l_reg > 0.f ? 1.f / l_reg : 0.f, rc);
    store_o<false>(c, o, rc, O, P0 + c.wid * 32, h * 128);
}

struct CmpProb {
    const bf16* KC; const bf16* VC; int kvh, nt, nmax  , wnmax  , hi, r32, wid; LAS float* imp; float carry;
    DI int ntiles() const { return nt; }
    DI void src(int t, const bf16*& k, const bf16*& v, int& kp, int& vp) const { k = KC + (size_t)t * 64 * 256 + kvh * 128; v = VC + (size_t)t * 64 * 256 + kvh * 128; kp = 256; vp = 256; }
    DI float extra(int) const { return 0.f; }
    DI void put_extra(int, int, float) const {}
    DI bool active(int t) const { return t * 64 <= wnmax; }
    DI void mask(f32x16& p0, f32x16& p1, int t, int) const { mask_tile(p0, p1, nmax - 4 * hi - t * 64, 0x7fffffffu); }
    DI void post(f32x16& p0, f32x16& p1, int t, bool act) {
        if (!act) { carry = 0.f; return; }
        float G[8], L[8];
#pragma unroll
        for (int q = 0; q < 4; ++q) { G[q] = (p0[4 * q] + p0[4 * q + 1]) + (p0[4 * q + 2] + p0[4 * q + 3]); L[q] = p0[4 * q + 3];
                                      G[4 + q] = (p1[4 * q] + p1[4 * q + 1]) + (p1[4 * q + 2] + p1[4 * q + 3]); L[4 + q] = p1[4 * q + 3]; }
        float PL[8];
#pragma unroll
        for (int q = 0; q < 8; ++q) PL[q] = __shfl_xor(L[q], 32);
        float v[8];
        if (hi) {
#pragma unroll
            for (int q = 0; q < 8; ++q) v[q] = G[q] + PL[q];
        } else {
            v[0] = G[0] + carry;
#pragma unroll
            for (int q = 1; q < 8; ++q) v[q] = G[q] + PL[q - 1];
            carry = PL[7];
        }
#pragma unroll
        for (int q = 0; q < 8; ++q) { float s = v[q]; s += __shfl_xor(s, 1); s += __shfl_xor(s, 2);
            if ((r32 & 3) == 0) imp[(wid * 8 + (r32 >> 2)) * IMP_STRIDE + 16 * t + 2 * q + hi] = s; }
    }
};
struct SlcProb {
    const bf16* QKV; int kvh, ch, qlo, qpos, hi; const LAS unsigned* sw;
    DI int ntiles() const { return ch + 1; }
    DI void src(int t, const bf16*& k, const bf16*& v, int& kp, int& vp) const { const size_t key0 = (size_t)t * 64; k = QKV + key0 * NO + O_KSLC + kvh * 128; v = QKV + key0 * NO + O_VSLC + kvh * 128; kp = NO; vp = NO; }
    DI float extra(int) const { return 0.f; }
    DI void put_extra(int, int, float) const {}
    DI bool sel(int t) const { return (sw[t >> 5] >> (t & 31)) & 1u; }
    DI bool active(int t) const { return __any(sel(t)); }
    DI void mask(f32x16& p0, f32x16& p1, int t, int) const { if (!sel(t)) kill_tile(p0, p1); else if (t == ch) mask_tile(p0, p1, qpos - 4 * hi - t * 64, 0x7fffffffu); }
    DI void post(f32x16&, f32x16&, int, bool) const {}
};
DI float sigmoid_f(float v) { return 1.f / (1.f + expf(-v)); }
#define ZERO_O(o) do { _Pragma("unroll") for (int d_ = 0; d_ < 4; ++d_) _Pragma("unroll") for (int r_ = 0; r_ < 16; ++r_) o[d_][r_] = 0.f; } while (0)
DI void nsa_unit(LAS unsigned char* lds_, const bf16* QKV, const bf16* KC, const bf16* VC, const float* FG, bf16* O, float* scr  , int kvh, int ch) {
    const int T0 = ch * 64;
    LAS float* imp = (LAS float*)((LAS char*)lds_ + L_IMP);
    LAS unsigned short* sel16 = (LAS unsigned short*)((LAS char*)lds_ + L_SEL);
    { const int t0_ = tid_fresh(); for (int e = t0_; e < 64 * IMP_STRIDE; e += NWAVES * 64) imp[e] = 0.f; }
    for (int rep_ = 0; rep_ < ((NSA_DUP & 1) ? 2 : 1); ++rep_) {
        const Cx c = make_cx(lds_); const int tl = c.wid * 8 + (c.r32 >> 2), hq = kvh * 4 + (c.r32 & 3);
        int token = T0 + tl;
        bf16x8 qr[8]; load_q(qr, QKV, NO, token, O_QD + hq * 128, c.hi);
        f32x16 o[4]; float rc[16];
        CmpProb pr; pr.KC = KC; pr.VC = VC; pr.kvh = kvh; pr.hi = c.hi; pr.r32 = c.r32; pr.wid = c.wid; pr.imp = imp; pr.carry = 0.f;
        const int nmax_chunk = (T0 + 63 - 31) >> 4;
        pr.nt = nmax_chunk / 64 + 1; pr.nmax = (token - 31) >> 4; pr.wnmax = (T0 + c.wid * 8 + 7 - 31) >> 4;
        float m_reg = -1e30f, l_reg = 0.f; ZERO_O(o);
        run<0>(c, pr, qr, m_reg, l_reg, o);
        const float g_cmp = sigmoid_f(FG[(size_t)(8 + hq * 3 + 0) * S + token]);
        row_coefs(c, l_reg > 0.f ? g_cmp / l_reg : 0.f, rc);
        { GAS f32x4* sp = (GAS f32x4*)(scr + (size_t)c.tid * 64);
#pragma unroll
        for (int d = 0; d < 4; ++d)
#pragma unroll
            for (int q = 0; q < 4; ++q) sp[d * 4 + q] = (f32x4){o[d][4 * q] * rc[4 * q], o[d][4 * q + 1] * rc[4 * q + 1], o[d][4 * q + 2] * rc[4 * q + 2], o[d][4 * q + 3] * rc[4 * q + 3]}; }
        pr.carry = 0.f;
        run<1>(c, pr, qr, m_reg, l_reg, o);
    }
    for (int rep_ = 0; rep_ < ((NSA_DUP & 2) ? 2 : 1); ++rep_) {
        const int tf_ = tid_fresh(); const int tk = tf_ >> 3, q = tf_ & 7;
        const LAS float* row = imp + tk * IMP_STRIDE;
        float v[16]; int rank[16];
#pragma unroll
        for (int e = 0; e < 16; ++e) { const int j = 16 * q + e; float x = row[j]; if (j == 0 || j == ch || j == ch - 1) x = __builtin_inff(); if (j > ch) x = -__builtin_inff(); v[e] = x; rank[e] = 0; }
        for (int i0 = 0; i0 <= ch; i0 += 4) { const f32x4 xr = *(const LAS f32x4*)(row + i0);
#pragma unroll
            for (int u = 0; u < 4; ++u) { const int i = i0 + u; float x = xr[u]; if (i == 0 || i == ch || i == ch - 1) x = __builtin_inff(); if (i > ch) x = -__builtin_inff();
#pragma unroll
                for (int e = 0; e < 16; ++e) { const int j = 16 * q + e; rank[e] += (x > v[e] || (x == v[e] && i < j)) ? 1 : 0; } } }
        unsigned m = 0u;
#pragma unroll
        for (int e = 0; e < 16; ++e) { const int j = 16 * q + e; if (j <= ch && rank[e] < (BREAK == 9 ? 15 : 16)) m |= 1u << e; }
        sel16[tk * 8 + q] = (unsigned short)m;
    }
    __syncthreads();
    for (int rep_ = 0; rep_ < ((NSA_DUP & 4) ? 2 : 1); ++rep_) {
        const Cx c = make_cx(lds_); const int tl = c.wid * 8 + (c.r32 >> 2), hq = kvh * 4 + (c.r32 & 3);
        int token = T0 + tl;
        bf16x8 qr[8]; load_q(qr, QKV, NO, token, O_QD + hq * 128, c.hi);
        f32x16 o[4]; float rc[16];
        SlcProb pr; pr.QKV = QKV; pr.kvh = kvh; pr.ch = ch; pr.qlo = T0 + c.wid * 8; pr.qpos = token; pr.hi = c.hi;
        pr.sw = (const LAS unsigned*)(c.lds + L_SEL) + tl * 4;
        float m_reg = -1e30f, l_reg = 0.f; ZERO_O(o);
        run<0>(c, pr, qr, m_reg, l_reg, o);
        const float g_slc = sigmoid_f(FG[(size_t)(8 + hq * 3 + 1) * S + token]);
        row_coefs(c, l_reg > 0.f ? g_slc / l_reg : 0.f, rc);
        { GAS f32x4* sp = (GAS f32x4*)(scr + 32768 + (size_t)c.tid * 64);
#pragma unroll
        for (int d = 0; d < 4; ++d)
#pragma unroll
            for (int q = 0; q < 4; ++q) sp[d * 4 + q] = (f32x4){o[d][4 * q] * rc[4 * q], o[d][4 * q + 1] * rc[4 * q + 1], o[d][4 * q + 2] * rc[4 * q + 2], o[d][4 * q + 3] * rc[4 * q + 3]}; }
    }
    for (int rep_ = 0; rep_ < ((NSA_DUP & 8) ? 2 : 1); ++rep_) {
        const Cx c = make_cx(lds_); const int tl = c.wid * 8 + (c.r32 >> 2), hq = kvh * 4 + (c.r32 & 3);
        int token = T0 + tl;
        bf16x8 qr[8]; load_q(qr, QKV, NO, token, O_QD + hq * 128, c.hi);
        f32x16 o[4]; float rc[16];
        WinProb pr; pr.QKV = QKV; pr.pitch = NO; pr.kcol = O_KWIN + kvh * 128; pr.vcol = O_VWIN + kvh * 128; pr.t0 = ch >= 8 ? ch - 8 : 0; pr.nt = ch + 1 - pr.t0;
        pr.qlo = T0 + c.wid * 8; pr.qpos = token; pr.hi = c.hi; pr.W = 512u;
        float m_reg = -1e30f, l_reg = 0.f; ZERO_O(o);
        run<0>(c, pr, qr, m_reg, l_reg, o);
        const float g_win = sigmoid_f(FG[(size_t)(8 + hq * 3 + 2) * S + token]);
        row_coefs(c, l_reg > 0.f ? g_win / l_reg : 0.f, rc);
        { const GAS f32x4* s0 = (const GAS f32x4*)(scr + (size_t)c.tid * 64); const GAS f32x4* s1 = (const GAS f32x4*)(scr + 32768 + (size_t)c.tid * 64);
#pragma unroll
        for (int d = 0; d < 4; ++d) {
#pragma unroll
            for (int q = 0; q < 4; ++q) { const f32x4 x = s0[d * 4 + q] + s1[d * 4 + q];
#pragma unroll
                for (int e = 0; e < 4; ++e) o[d][4 * q + e] = o[d][4 * q + e] * rc[4 * q + e] + x[e]; }
            asm volatile("" ::: "memory"); } }
#pragma unroll
        for (int r = 0; r < 16; ++r) rc[r] = 1.f;
        store_o<true>(c, o, rc, O, T0 + c.wid * 8, 1024 + kvh * 512);
    }
}
}

#if defined(CHECK) && CHECK
namespace chk {
constexpr int CW_CHK = 12288;
DI float wmax(float v) {
#pragma unroll
    for (int o = 1; o < 64; o <<= 1) v = fmaxf(v, __shfl_xor(v, o));
    return v; }
DI float wsum(float v) {
#pragma unroll
    for (int o = 1; o < 64; o <<= 1) v += __shfl_xor(v, o);
    return v; }
DI float ldbf(const bf16* p) { return bf2f((unsigned)*p); }
DI int sample_token(int i) {
    const int fixed[40] = {0, 1, 2, 15, 16, 30, 31, 32, 46, 47, 48, 63, 64, 65, 95, 126, 127, 128, 129, 191, 255, 256, 257, 300, 511, 512, 513, 767, 1023, 1024, 1025, 2047, 2048, 4095, 4096, 4097, 6000, 8000, 8190, 8191};
    if (i < 40) return fixed[i];
    return (int)(((unsigned)i * 2654435761u) >> 19) & 8191; }
DI void report(gu32* ctl, int id, bool bad, int lane) { if (bad && lane == 0) __hip_atomic_fetch_add(ctl + CW_CHK + id, 1u, RLX_AGENT); }

DI float dot128(const unsigned* qp, const bf16* krow) {
    float acc = 0.f;
#pragma unroll
    for (int i = 0; i < 16; ++i) { const v4u w = *(const GAS v4u*)(krow + 8 * i);
        acc += bf2f(qp[4 * i] & 0xffffu) * bf2f(w.x & 0xffffu) + bf2f(qp[4 * i] >> 16) * bf2f(w.x >> 16);
        acc += bf2f(qp[4 * i + 1] & 0xffffu) * bf2f(w.y & 0xffffu) + bf2f(qp[4 * i + 1] >> 16) * bf2f(w.y >> 16);
        acc += bf2f(qp[4 * i + 2] & 0xffffu) * bf2f(w.z & 0xffffu) + bf2f(qp[4 * i + 2] >> 16) * bf2f(w.z >> 16);
        acc += bf2f(qp[4 * i + 3] & 0xffffu) * bf2f(w.w & 0xffffu) + bf2f(qp[4 * i + 3] >> 16) * bf2f(w.w >> 16); }
    return acc; }
template <class Vis>
DI void naive_attn(const unsigned* qp, const bf16* K, int kpitch, const bf16* V, int vpitch, int s_lo, int s_hi, Vis vis, float sink, int lane, float& o0, float& o1) {
    const float NEG = -__builtin_inff();
    float m = sink;
    for (int s0 = s_lo; s0 <= s_hi; s0 += 64) { const int s = s0 + lane; float lg = NEG;
        if (s <= s_hi) { const float b = vis(s); if (b > NEG) lg = dot128(qp, K + (size_t)s * kpitch) * att::SCALE + b; }
        m = fmaxf(m, wmax(lg)); }
    float l = 0.f, a0 = 0.f, a1 = 0.f;
    if (m > NEG) {
        if (sink > NEG) l = expf(sink - m);
        for (int s0 = s_lo; s0 <= s_hi; s0 += 64) { const int s = s0 + lane; float p = 0.f;
            if (s <= s_hi) { const float b = vis(s); if (b > NEG) p = expf(dot128(qp, K + (size_t)s * kpitch) * att::SCALE + b - m); }
            l += wsum(p);
            const int nk = (s_hi - s0 + 1) < 64 ? (s_hi - s0 + 1) : 64;
            for (int k = 0; k < nk; ++k) { const float pk = __shfl(p, k); if (pk != 0.f) { const unsigned w = *(const GAS unsigned*)(V + (size_t)(s0 + k) * vpitch + 2 * lane); a0 += pk * bf2f(w & 0xffffu); a1 += pk * bf2f(w >> 16); } } }
    }
    const float inv = l > 0.f ? 1.f / l : 0.f; o0 = a0 * inv; o1 = a1 * inv; }
DI void load_qp(unsigned* qp, const bf16* qrow) {
#pragma unroll
    for (int i = 0; i < 16; ++i) { const v4u w = *(const GAS v4u*)(qrow + 8 * i); qp[4 * i] = w.x; qp[4 * i + 1] = w.y; qp[4 * i + 2] = w.z; qp[4 * i + 3] = w.w; } }
DI bool cmp_out(float o0, float o1, const bf16* orow, int lane) {
    const unsigned w = *(const GAS unsigned*)(orow + 2 * lane); const float f0 = bf2f(w & 0xffffu), f1 = bf2f(w >> 16);
    const float d = wmax(fmaxf(fabsf(f0 - o0), fabsf(f1 - o1))), sc = wmax(fmaxf(fabsf(o0), fabsf(o1)));
    return !(d <= 0.012f * sc + 2e-5f); }

__global__ void __launch_bounds__(256) chk_inproj(Args a, int l) {
    const int lane = threadIdx.x & 63, gw = (blockIdx.x * 256 + threadIdx.x) >> 6, nw = gridDim.x * 4; const bool odd = l & 1; const int j = l >> 1;
    gu32* ctl = (gu32*)(a.ws + WS_CTL); const bf16* QKV = (const bf16*)(a.ws + WS_QKV); const float* FG = (const float*)(a.ws + WS_FG);
    const int N = odd ? NO : NE, NS = odd ? NO_SRC : NE; const float* W = odd ? a.odd_w_in + (size_t)j * DM * NO_SRC : a.even_w_in + (size_t)j * DM * NE;
    for (int smp = gw; smp < 6000; smp += nw) {
        const int t = sample_token(smp % 97), nd = (int)(((unsigned)smp * 2246822519u) >> 8) % (odd ? 5664 : NE);
        const int sec_rope = odd ? ((nd >= O_QD && nd < O_VCMP) || (nd >= O_KSLC && nd < O_VSLC) || (nd >= O_KWIN && nd < O_VWIN)) : (nd < E_VA || (nd >= E_QB && nd < E_VB));
        const int d = nd & 127, ndp = sec_rope ? (d < 64 ? nd + 64 : nd - 64) : nd;
        const int sc0 = odd ? odd_src_col(nd) : nd, sc1 = odd ? odd_src_col(ndp) : ndp;
        const bf16* xr = (const bf16*)(a.ws + WS_H) + (size_t)t * DM; const float* mods = (const float*)(a.ws + WS_MODS) + (size_t)l * 6 * DM;
        float sq = 0.f; for (int k = lane; k < DM; k += 64) sq += ldbf(xr + k) * ldbf(xr + k);
        const float rstd = 1.f / sqrtf(wsum(sq) * (1.f / DM) + NORM_EPS);
        float s0 = 0.f, s1 = 0.f;
        for (int k = lane; k < DM; k += 64) { const float h = ldbf(xr + k) * rstd * mods[DM + k] + mods[k]; s0 += h * W[(size_t)k * NS + sc0]; s1 += h * W[(size_t)k * NS + sc1]; }
        s0 = wsum(s0); s1 = wsum(s1);
        float ref = s0;
        if (sec_rope) { const int dd = d & 63; const float inv = 1.0f / powf(10000.0f, (float)dd / 64.0f); const float ang = (float)t * inv; const float cv = cosf(ang), sv = sinf(ang);
            ref = (d < 64) ? s0 * cv - s1 * sv : s1 * sv + s0 * cv; }
        float got;
        if (odd && nd >= O_FG) got = FG[(size_t)(nd - O_FG) * S + t]; else got = ldbf(QKV + (size_t)t * N + nd);
        report(ctl, 1 + (odd ? 1 : 0), !(fabsf(got - ref) <= 0.03f * (fabsf(ref) + 0.3f)), lane);
    }
}
__global__ void __launch_bounds__(256) chk_prep(Args a, int l) {
    const int lane = threadIdx.x & 63, gw = (blockIdx.x * 256 + threadIdx.x) >> 6, nw = gridDim.x * 4; const bool odd = l & 1; const int j = l >> 1;
    gu32* ctl = (gu32*)(a.ws + WS_CTL); const bf16* QKV = (const bf16*)(a.ws + WS_QKV);
    if (!odd) {
        const bf16* KMH = (const bf16*)(a.ws + WS_KMH); const bf16* KML = (const bf16*)(a.ws + WS_KML);
        for (int u = gw; u < 256; u += nw) { const int h = u >> 5, blk = u & 31; float s0 = 0.f, s1 = 0.f;
            for (int k = 0; k < 256; ++k) { const unsigned w = *(const GAS unsigned*)(QKV + (size_t)(blk * 256 + k) * NE + E_KA + h * 128 + 2 * lane); s0 += bf2f(w & 0xffffu); s1 += bf2f(w >> 16); }
            s0 *= (1.f / 256.f); s1 *= (1.f / 256.f);
            const float g0 = ldbf(KMH + (size_t)u * 128 + 2 * lane) + ldbf(KML + (size_t)u * 128 + 2 * lane), g1 = ldbf(KMH + (size_t)u * 128 + 2 * lane + 1) + ldbf(KML + (size_t)u * 128 + 2 * lane + 1);
            const float dd = wmax(fmaxf(fabsf(g0 - s0), fabsf(g1 - s1)));
            report(ctl, 3, !(dd <= 3e-5f), lane); }
    } else {
        const float* FG = (const float*)(a.ws + WS_FG); const float* CUM = (const float*)(a.ws + WS_CUM);
        if (gw < 8) { const int h = gw;
            bool bad = false;
            if (lane == 0) { double run = 0.0; const float fb = a.fox_forget_b[j * 8 + h];
                for (int t = 0; t < S; ++t) { const double x = (double)FG[(size_t)h * S + t] + (double)fb; run += (x < 0 ? x - log1p(exp(x)) : -log1p(exp(-x)));
                    if (!(fabs((double)CUM[(size_t)h * S + t] - run) <= 2e-3 + 1e-5 * fabs(run))) bad = true; } }
            report(ctl, 4, __any(bad), lane); }
        for (int smp = gw; smp < 8 + 600; smp += nw) { if (smp < 8) continue;
            const int q = smp - 8, kind = q & 1, hd = (q >> 1) & 1, n = (q < 40) ? (q < 20 ? (q >> 2) : 510 - ((q - 20) >> 2)) : (int)(((unsigned)q * 2654435761u) >> 20) % NCMP;
            const int srccol = (kind ? O_VCMP : O_KCMP) + hd * 128;
            const float* pos = (kind ? a.nsa_v_pos : a.nsa_k_pos) + (size_t)j * 32 * 128; const float* w1 = (kind ? a.nsa_v_w1 : a.nsa_k_w1) + (size_t)j * 4096 * 128; const float* w2 = (kind ? a.nsa_v_w2 : a.nsa_k_w2) + (size_t)j * 128 * 128;
            float h0 = 0.f, h1 = 0.f;
            for (int k = 0; k < 4096; ++k) { const int ll = k >> 7, d = k & 127; const float x = ldbf(QKV + (size_t)(16 * n + ll) * NO + srccol + d) + pos[ll * 128 + d]; h0 += x * w1[(size_t)k * 128 + lane]; h1 += x * w1[(size_t)k * 128 + lane + 64]; }
            h0 = gelu_tanh_f(h0); h1 = gelu_tanh_f(h1);
            float o0 = 0.f, o1 = 0.f;
            for (int c = 0; c < 128; ++c) { const float hv = __shfl(c < 64 ? h0 : h1, c & 63); o0 += hv * w2[c * 128 + lane]; o1 += hv * w2[c * 128 + lane + 64]; }
            const bf16* dst = (const bf16*)(a.ws + (kind ? WS_VC : WS_KC)) + (size_t)n * 256 + hd * 128;
            const float f0 = ldbf(dst + lane), f1 = ldbf(dst + lane + 64);
            const float dd = wmax(fmaxf(fabsf(f0 - o0), fabsf(f1 - o1))), sc = wmax(fmaxf(fabsf(o0), fabsf(o1)));
            report(ctl, 5, !(dd <= 0.03f * sc + 1e-3f), lane); }
    }
}
__global__ void __launch_bounds__(256) chk_attn(Args a, int l) {
    __shared__ float imp_s[4][128]; __shared__ unsigned sel_s[4][4];
    const int lane = threadIdx.x & 63, wv = threadIdx.x >> 6, gw = (blockIdx.x * 256 + threadIdx.x) >> 6, nw = gridDim.x * 4; const bool odd = l & 1; const int j = l >> 1;
    gu32* ctl = (gu32*)(a.ws + WS_CTL); const bf16* QKV = (const bf16*)(a.ws + WS_QKV); const bf16* OB = (const bf16*)(a.ws + WS_O);
    const float NEG = -__builtin_inff();
    unsigned qp[64];
    if (!odd) {
        const bf16* KMH = (const bf16*)(a.ws + WS_KMH); const bf16* KML = (const bf16*)(a.ws + WS_KML);
        for (int smp = gw; smp < 1600; smp += nw) {
            const int t = sample_token(smp >> 3), h = smp & 7;
            {
                load_qp(qp, QKV + (size_t)t * NE + E_QA + h * 128);
                const int own = t >> 8;
                float g = NEG;
                if (lane < own) g = dot128(qp, KMH + ((size_t)h * 32 + lane) * 128) + dot128(qp, KML + ((size_t)h * 32 + lane) * 128);
                int rank = 0;
                for (int i = 0; i < 32; ++i) { const float gi = __shfl(g, i); rank += (gi > g || (gi == g && i < lane)) ? 1 : 0; }
                const unsigned long long bal = __ballot(lane < own && rank < 3);
                const unsigned selm = (unsigned)bal;
                float o0, o1;
                naive_attn(qp, QKV + E_KA + h * 128, NE, QKV + E_VA + h * 128, NE, 0, t, [&](int s) { const int b = s >> 8; return (b == own || ((selm >> b) & 1u)) ? 0.f : NEG; }, NEG, lane, o0, o1);
                report(ctl, 6, cmp_out(o0, o1, OB + (size_t)t * DM + h * 128, lane), lane);
            }
            {
                load_qp(qp, QKV + (size_t)t * NE + E_QB + h * 128);
                float o0, o1; const int lo = t - 127 > 0 ? t - 127 : 0;
                naive_attn(qp, QKV + E_KB + (h >> 2) * 128, NE, QKV + E_VB + (h >> 2) * 128, NE, lo, t, [&](int) { return 0.f; }, a.even_sinks[j * 8 + h], lane, o0, o1);
                report(ctl, 7, cmp_out(o0, o1, OB + (size_t)t * DM + 1024 + h * 128, lane), lane);
            }
        }
    } else {
        const float* CUM = (const float*)(a.ws + WS_CUM); const float* FG = (const float*)(a.ws + WS_FG);
        const bf16* KC = (const bf16*)(a.ws + WS_KC); const bf16* VC = (const bf16*)(a.ws + WS_VC);
        for (int smp = gw; smp < 1600; smp += nw) {
            const int t = sample_token(smp >> 3), h = smp & 7;
            {
                load_qp(qp, QKV + (size_t)t * NO + O_QC + h * 128);
                const float* ch = CUM + (size_t)h * S; const float ct = ch[t];
                float o0, o1;
                naive_attn(qp, QKV + O_KC + h * 128, NO, QKV + O_VC + h * 128, NO, 0, t, [&](int s) { return ct - ch[s]; }, NEG, lane, o0, o1);
                report(ctl, 8, cmp_out(o0, o1, OB + (size_t)t * DM + h * 128, lane), lane);
            }
            {
                const int kvh = h >> 2, cur = t >> 6, nmax = (t - 31) >> 4;
                for (int i = lane; i < 128; i += 64) imp_s[wv][i] = 0.f;
                __builtin_amdgcn_wave_barrier();
                for (int g = 0; g < 4; ++g) {
                    load_qp(qp, QKV + (size_t)t * NO + O_QD + (kvh * 4 + g) * 128);
                    float lg[8]; float m = NEG;
#pragma unroll
                    for (int i = 0; i < 8; ++i) { const int n = lane + 64 * i; lg[i] = (n <= nmax) ? dot128(qp, KC + (size_t)n * 256 + kvh * 128) * att::SCALE : NEG; m = fmaxf(m, lg[i]); }
                    m = wmax(m);
                    if (m > NEG) { float ls = 0.f;
#pragma unroll
                        for (int i = 0; i < 8; ++i) { lg[i] = (lg[i] > NEG) ? expf(lg[i] - m) : 0.f; ls += lg[i]; }
                        ls = wsum(ls);
#pragma unroll
                        for (int i = 0; i < 8; ++i) { const int n = lane + 64 * i; const float p = lg[i] / ls;
                            if (p != 0.f) { atomicAdd(&imp_s[wv][n >> 2], p); if ((n & 3) == 3 && (n >> 2) + 1 < 128) atomicAdd(&imp_s[wv][(n >> 2) + 1], p); } } }
                }
                __builtin_amdgcn_wave_barrier();
                asm volatile("s_waitcnt lgkmcnt(0)" ::: "memory");
                float v0, v1; { const int j0 = lane, j1 = lane + 64; v0 = imp_s[wv][j0]; v1 = imp_s[wv][j1];
                    if (j0 == 0 || j0 == cur || j0 == cur - 1) v0 = __builtin_inff(); if (j0 > cur) v0 = NEG;
                    if (j1 == 0 || j1 == cur || j1 == cur - 1) v1 = __builtin_inff(); if (j1 > cur) v1 = NEG; }
                int r0 = 0, r1 = 0;
                for (int i = 0; i < 128; ++i) { const float x = __shfl(i < 64 ? v0 : v1, i & 63); r0 += (x > v0 || (x == v0 && i < lane)) ? 1 : 0; r1 += (x > v1 || (x == v1 && i < lane + 64)) ? 1 : 0; }
                const unsigned long long b0 = __ballot(r0 < 16 && lane <= cur), b1 = __ballot(r1 < 16 && lane + 64 <= cur);
                if (lane == 0) { sel_s[wv][0] = (unsigned)b0; sel_s[wv][1] = (unsigned)(b0 >> 32); sel_s[wv][2] = (unsigned)b1; sel_s[wv][3] = (unsigned)(b1 >> 32); }
                __builtin_amdgcn_wave_barrier();
                asm volatile("s_waitcnt lgkmcnt(0)" ::: "memory");
                const unsigned m0 = sel_s[wv][0], m1 = sel_s[wv][1], m2 = sel_s[wv][2], m3 = sel_s[wv][3];
                load_qp(qp, QKV + (size_t)t * NO + O_QD + h * 128);
                float c0, c1, s0, s1, w0, w1;
                naive_attn(qp, KC + kvh * 128, 256, VC + kvh * 128, 256, 0, nmax, [&](int) { return 0.f; }, NEG, lane, c0, c1);
                naive_attn(qp, QKV + O_KSLC + kvh * 128, NO, QKV + O_VSLC + kvh * 128, NO, 0, t, [&](int s) { const int b = s >> 6; const unsigned mm = (b < 32) ? m0 : (b < 64 ? m1 : (b < 96 ? m2 : m3)); return ((mm >> (b & 31)) & 1u) ? 0.f : NEG; }, NEG, lane, s0, s1);
                const int lo = t - 511 > 0 ? t - 511 : 0;
                naive_attn(qp, QKV + O_KWIN + kvh * 128, NO, QKV + O_VWIN + kvh * 128, NO, lo, t, [&](int) { return 0.f; }, NEG, lane, w0, w1);
                const float* gp = FG + (size_t)(8 + h * 3) * S + t; const float g0 = att::sigmoid_f(gp[0]), g1 = att::sigmoid_f(gp[S]), g2 = att::sigmoid_f(gp[2 * S]);
                report(ctl, 9, cmp_out(g0 * c0 + g1 * s0 + g2 * w0, g0 * c1 + g1 * s1 + g2 * w1, OB + (size_t)t * DM + 1024 + h * 128, lane), lane);
            }
        }
    }
}
__global__ void chk_poison(Args a) {
    if (threadIdx.x != 0 || blockIdx.x != 0) return;
    gu32* ctl = (gu32*)(a.ws + WS_CTL);
    const unsigned allow[10] = {0, 0, 0, 0, 0, 0, 3, 0, 0, 3};
    for (int k = 1; k <= 9; ++k) if (__hip_atomic_load(ctl + CW_CHK + k, RLX_AGENT) > allow[k]) { a.out[0] = 16.f * (float)k; return; }
}
}
#endif

#ifndef MK_PER_PHASE
#define MK_PER_PHASE 0
#endif
constexpr int PH_PER_LAYER = 10, N_PHASES = 2 + 4 * PH_PER_LAYER;
#ifndef DUP_MASK
#define DUP_MASK 0
#endif
#define DUP(b) ((DUP_MASK >> (b)) & 1)
#ifndef ODD_NSPLIT
#define ODD_NSPLIT 64
#endif
#ifndef EVEN_SPLIT
#define EVEN_SPLIT 1
#endif
#ifndef STAG_UP
#define STAG_UP 0
#endif
#ifndef STAG_IN
#define STAG_IN 0
#endif
#ifndef STAG_OD
#define STAG_OD 0
#endif
__device__ __forceinline__ void stagger_start(int step_ns) {
    if (step_ns > 0) { const unsigned g = (blockIdx.x >> 3) & 3u; const unsigned long long ticks = (unsigned long long)(g * (unsigned)step_ns / 10u);
        if (ticks) { const unsigned long long t0 = __builtin_amdgcn_s_memrealtime(); while (__builtin_amdgcn_s_memrealtime() - t0 < ticks) __builtin_amdgcn_s_sleep(2); } }
}

__global__ void __launch_bounds__(NWAVES * 64, 2) fwd(Args a_unused) {
    extern __shared__ __attribute__((aligned(16))) unsigned char lds_raw[];
    LAS unsigned char* const lds = (LAS unsigned char*)lds_raw;
    volatile LAS unsigned* MISC = (volatile LAS unsigned*)(lds + MISC_OFF);
    { const int t0 = tid_fresh(); for (int u = t0; u < (LDS_BYTES - LDSCTL_OFF) / 4; u += NWAVES * 64) ((LAS unsigned*)(lds + LDSCTL_OFF))[u] = 0u; }
    __syncthreads();
    int lo, hi; { KA a = kargs(); lo = a->ph_lo; hi = a->ph_hi; }
    XcdBarrier bar; { KA a = kargs(); bar.bar = (unsigned*)((gu32*)(a->ws + WS_CTL) + CW_BAR); bar.x = 0; bar.st = nullptr;
        if (hi - lo > 1) bar = xcd_barrier_post(bar.bar, MISC + 8); }
#define IN(k) (lo <= (k) && (k) < hi)
#define SEAM(k) do { if (IN(k) && IN((k) + 1)) { xcd_barrier(bar); if (DUP(12)) xcd_barrier(bar); } } while (0)
#define DEQUEUE(idx, qhead, qslot) do { if (tid_fresh() == 0) *(qslot) = (int)__hip_atomic_fetch_add((qhead), 1u, RLX_AGENT); __syncthreads(); idx = *(qslot); __syncthreads(); } while (0)

    if (IN(0)) { if (DUP(0)) { { const Ctx C = make_ctx(lds); p0_ada(kargs(), C); } xcd_barrier(bar); }
        { const Ctx C = make_ctx(lds); p0_ada(kargs(), C); } SEAM(0); }

    for (int l = 0; l < DEPTH; ++l) {
        const int pb = 1 + PH_PER_LAYER * l, j = l >> 1; const bool odd = l & 1;
        if (IN(pb + 0) && l == 0) { KA a = kargs(); unsigned char* ws = a->ws; const Ctx C = make_ctx(lds);
            if (DUP(1)) { p0_convert(a, C); resid_init_phase(C, a->x, (bf16*)(ws + WS_H), (float*)(ws + WS_SS)); xcd_barrier(bar); }
            p0_convert(a, C); resid_init_phase(C, a->x, (bf16*)(ws + WS_H), (float*)(ws + WS_SS)); SEAM(pb + 0); }
        if (IN(pb + 1)) {
            KA a = kargs(); unsigned char* ws = a->ws;
            const int N = odd ? NO : NE;
            pg8::Gemm g{(const bf16*)(ws + WS_H), (const bf16*)(ws + WS_W + (size_t)l * W_LAYER + W_IN), S, N, DM}; pg8::StaticOrder So; So.init(S, N, (int)gridDim.x, (int)blockIdx.x);
            LAS float* etab = (LAS float*)(lds + EPITAB_OFF);
            const float* ssp = (const float*)(ws + WS_SS); const float* bip = bpart_of(ws, l, 0);
            pg8::EpiIn E{(bf16*)(ws + WS_QKV), N, (float*)(ws + WS_FG), odd ? 1 : 0, etab};
            if ((DUP(2) && !odd) || (DUP(3) && odd)) { pg8::epi_preload(So, ssp, bip, etab); pg8::gemm_phase<pg8::EpiIn, pg8::StaticOrder, true, true>(lds + RING_OFF, g, So, E); xcd_barrier(bar); }
            if (odd || !EVEN_SPLIT) { pg8::epi_preload(So, ssp, bip, etab); pg8::gemm_phase<pg8::EpiIn, pg8::StaticOrder, true, true>(lds + RING_OFF, g, So, E); }
            else {
                pg8::MapOrder Mo; Mo.init(S, 16, (int)gridDim.x, (int)blockIdx.x, 10, 2);
                pg8::epi_preload(Mo, ssp, bip, etab);
                pg8::gemm_phase<pg8::EpiIn, pg8::MapOrder, true, true>(lds + RING_OFF, g, Mo, E); }
            SEAM(pb + 1);
        }
        if (IN(pb + 2)) {
            KA a = kargs(); unsigned char* ws = a->ws; const Ctx C = make_ctx(lds);
            if (DUP(4) || (DUP(13) && !odd) || (DUP(14) && odd)) { if (!odd) kmean_phase(C, (const bf16*)(ws + WS_QKV), (bf16*)(ws + WS_KMH), (bf16*)(ws + WS_KML)); else oddprep_phase(a, C, j); xcd_barrier(bar); }
            if (!odd) kmean_phase(C, (const bf16*)(ws + WS_QKV), (bf16*)(ws + WS_KMH), (bf16*)(ws + WS_KML));
            else oddprep_phase(a, C, j);
            SEAM(pb + 2);
        }
        const int nrep = ((DUP(5) && !odd) || (DUP(6) && odd)) ? 2 : 1;
        for (int rep = 0; rep < nrep; ++rep) {
        if (IN(pb + 3)) {
            KA a = kargs(); unsigned char* ws = a->ws;
            const bf16* QKV = (const bf16*)(ws + WS_QKV); bf16* OB = (bf16*)(ws + WS_O);
            LAS unsigned char* const alds = lds + RING_OFF;
            LAS int* qslot = (LAS int*)(lds + RING_OFF + 133120 + 1536);
            gu32* qhead = (gu32*)(ws + WS_CTL) + CW_Q + 64 * (l * 4 + rep);
            const int nhost = (int)gridDim.x < 64 ? (int)gridDim.x : 64;
            if (!odd && EVEN_SPLIT && (int)blockIdx.x < nhost) {
                pg8::Gemm g{(const bf16*)(ws + WS_H), (const bf16*)(ws + WS_W + (size_t)l * W_LAYER + W_IN), S, NE, DM};
                LAS float* etab = (LAS float*)(lds + EPITAB_OFF);
                pg8::EpiIn E{(bf16*)(ws + WS_QKV), NE, (float*)(ws + WS_FG), 0, etab};
                pg8::MapOrder Mo; Mo.init(S, 2, nhost, (int)blockIdx.x, 0, 10);
                pg8::epi_preload(Mo, (const float*)(ws + WS_SS), bpart_of(ws, l, 0), etab);
                pg8::gemm_phase<pg8::EpiIn, pg8::MapOrder, true, true>(lds + RING_OFF, g, Mo, E);
                __syncthreads(); }
            gu32* fhead = (gu32*)(ws + WS_CTL) + CW_Q + 64 * (16 + l * 4 + rep);
            const int fwhich = odd ? 2 : 0; bool fmore = true;
            for (int it = 0;; ++it) {
                int idx;
                DEQUEUE(idx, qhead, qslot);
                if (idx >= 512) break;
                if (!odd) {
                    if (idx < 256) att::moba_gate_unit(alds, QKV, (const bf16*)(ws + WS_KMH), (const bf16*)(ws + WS_KML), (gu32*)(ws + WS_CTL) + CW_MCNT + 256 * (l + 4 * rep), (unsigned*)(ws + WS_MLIST), idx & 7, 31 - (idx >> 3));
                    else { const int i = idx - 256; att::swa_unit(alds, QKV, a->even_sinks + j * 8, OB, i & 1, i >> 1); }
                } else {
                    constexpr int NSPLIT = ODD_NSPLIT, NA = 2 * (128 - NSPLIT);
                    const bool is_nsa = idx < NA || idx >= NA + 256; const int i = idx < NA ? idx : idx - NA - 256, kvh = i & 1, ch = (idx < NA ? 127 : NSPLIT - 1) - (i >> 1);
                    const int fi = idx - NA, fh = fi & 7, fqb = 31 - (fi >> 3);
                    if (is_nsa) { if (DUP(11)) att::nsa_unit(alds, QKV, (const bf16*)(ws + WS_KC), (const bf16*)(ws + WS_VC), (const float*)(ws + WS_FG), OB, (float*)(ws + WS_NSASCR) + (size_t)blockIdx.x * 65536, kvh, ch);
                        att::nsa_unit(alds, QKV, (const bf16*)(ws + WS_KC), (const bf16*)(ws + WS_VC), (const float*)(ws + WS_FG), OB, (float*)(ws + WS_NSASCR) + (size_t)blockIdx.x * 65536, kvh, ch); }
                    else { if (DUP(10)) att::fox_unit(alds, QKV, (const float*)(ws + WS_CUM), (const float*)((const gu32*)(ws + WS_CTL) + CW_FOXN + 16 * j), OB, fh, fqb);
                        att::fox_unit(alds, QKV, (const float*)(ws + WS_CUM), (const float*)((const gu32*)(ws + WS_CTL) + CW_FOXN + 16 * j), OB, fh, fqb); }
                }
            }
            while (fmore) { int fi; DEQUEUE(fi, fhead, qslot); fmore = tail_item(a, ws, lds, l, fwhich, fi); __syncthreads(); }
            if (!odd) SEAM(pb + 3);
        }
        if (IN(pb + 4) && !odd) {
            KA a = kargs(); unsigned char* ws = a->ws;
            const bf16* QKV = (const bf16*)(ws + WS_QKV);
            LAS unsigned char* const alds = lds + RING_OFF;
            LAS int* qslot = (LAS int*)(lds + RING_OFF + 133120 + 1536);
            LAS int* pre = (LAS int*)(lds + RING_OFF + 133120);
            const gu32* cnt = (const gu32*)(ws + WS_CTL) + CW_MCNT + 256 * (l + 4 * rep);
            { const int tid = tid_fresh(), lane = tid & 63, wv = tid >> 6;
                const int nt = tid < 256 ? (int)((cnt[tid] + 255u) >> 8) : 0; int sc = nt;
#pragma unroll
                for (int o = 1; o < 64; o <<= 1) { const int n = __shfl_up(sc, o); if (lane >= o) sc += n; }
                if (tid < 256 && lane == 63) pre[260 + wv] = sc;
                __syncthreads();
                int base = 0; for (int w = 0; w < wv && w < 4; ++w) base += pre[260 + w];
                if (tid < 256) pre[tid + 1] = base + sc;
                if (tid == 0) pre[0] = 0;
                __syncthreads(); }
            const int total = 256 + pre[256];
            gu32* qhead = (gu32*)(ws + WS_CTL) + CW_Q + 64 * (l * 4 + 2 + rep);
            gu32* fhead = (gu32*)(ws + WS_CTL) + CW_Q + 64 * (16 + l * 4 + 2 + rep); bool fmore = true;
            for (int it = 0;; ++it) {
                int idx; DEQUEUE(idx, qhead, qslot);
                if (idx >= total) break;
                int h, jb, r;
                if (idx < 256) { h = idx & 7; jb = idx >> 3; r = -1; }
                else { const int g = idx - 256; int b0 = 0, b1 = 256; while (b1 - b0 > 1) { const int mid = (b0 + b1) >> 1; if (pre[mid] <= g) b0 = mid; else b1 = mid; } h = b0 >> 5; jb = b0 & 31; r = g - pre[b0]; }
                att::moba_blk_unit(alds, QKV, cnt, (const unsigned*)(ws + WS_MLIST), (bf16*)(ws + WS_MPO), (float*)(ws + WS_MML), h, jb, r);
            }
            while (fmore) { int fi; DEQUEUE(fi, fhead, qslot); fmore = tail_item(a, ws, lds, l, 1, fi); __syncthreads(); }
            SEAM(pb + 4);
        }
        if (IN(pb + 5) && !odd) { KA a = kargs(); unsigned char* ws = a->ws; const Ctx C = make_ctx(lds);
            moba_combine_phase(C, (const bf16*)(ws + WS_MPO), (const float*)(ws + WS_MML), (bf16*)(ws + WS_O)); }
        if (rep + 1 < nrep) xcd_barrier(bar);
        }
        if (IN(pb + 5) && IN(pb + 6)) xcd_barrier(bar);
        if (IN(pb + 6)) {
            KA a = kargs(); unsigned char* ws = a->ws; const float* mods = (const float*)(ws + WS_MODS) + (size_t)l * 6 * DM;
            pg8::Gemm g{(const bf16*)(ws + WS_O), (const bf16*)(ws + WS_W + (size_t)l * W_LAYER + W_OUT), S, DM, DM}; pg8::StaticOrder So; So.init(S, DM, (int)gridDim.x, (int)blockIdx.x);
            pg8::EpiRes E{(bf16*)(ws + WS_H), nullptr, DM, mods + 2 * DM, (float*)(ws + WS_SS)};
            if (DUP(7)) { pg8::EpiRes E2{(bf16*)(ws + WS_U), nullptr, DM, mods + 2 * DM, (float*)(ws + WS_U) + (size_t)S * DM}; pg8::gemm_phase<pg8::EpiRes, pg8::StaticOrder, true, true>(lds + RING_OFF, g, So, E2); xcd_barrier(bar); }
            pg8::gemm_phase<pg8::EpiRes, pg8::StaticOrder, true, true>(lds + RING_OFF, g, So, E);
            SEAM(pb + 6);
        }
        if (IN(pb + 8)) {
            KA a = kargs(); unsigned char* ws = a->ws;
            pg8::Gemm g{(const bf16*)(ws + WS_H), (const bf16*)(ws + WS_W + (size_t)l * W_LAYER + W_UP), S, DFF, DM}; pg8::StaticOrder So; So.init(S, DFF, (int)gridDim.x, (int)blockIdx.x);
            LAS float* etab = (LAS float*)(lds + EPITAB_OFF);
            pg8::EpiRelu2 E{(bf16*)(ws + WS_U), DFF, etab};
            pg8::epi_preload(So, (const float*)(ws + WS_SS), bpart_of(ws, l, 1), etab);
            if (DUP(8)) { pg8::gemm_phase<pg8::EpiRelu2, pg8::StaticOrder, true, true>(lds + RING_OFF, g, So, E); xcd_barrier(bar); }
            stagger_start(STAG_UP);
            pg8::gemm_phase<pg8::EpiRelu2, pg8::StaticOrder, true, true>(lds + RING_OFF, g, So, E);
            SEAM(pb + 8);
        }
        if (IN(pb + 9)) {
            KA a = kargs(); unsigned char* ws = a->ws; const float* mods = (const float*)(ws + WS_MODS) + (size_t)l * 6 * DM;
            pg8::Gemm g{(const bf16*)(ws + WS_U), (const bf16*)(ws + WS_W + (size_t)l * W_LAYER + W_DOWN), S, DM, DFF}; pg8::StaticOrder So; So.init(S, DM, (int)gridDim.x, (int)blockIdx.x);
            pg8::EpiRes E{(bf16*)(ws + WS_H), nullptr, DM, mods + 5 * DM, (float*)(ws + WS_SS)};
            if (DUP(9)) { pg8::EpiRes E2{(bf16*)(ws + WS_QKV), nullptr, DM, mods + 5 * DM, (float*)(ws + WS_QKV) + (size_t)S * DM}; pg8::gemm_phase<pg8::EpiRes, pg8::StaticOrder, true, true>(lds + RING_OFF, g, So, E2); xcd_barrier(bar); }
            pg8::gemm_phase<pg8::EpiRes, pg8::StaticOrder, true, true>(lds + RING_OFF, g, So, E);
            SEAM(pb + 9);
        }
    }
    if (IN(N_PHASES - 1)) { KA a = kargs(); const Ctx C = make_ctx(lds); final_norm_phase(C, (const bf16*)(a->ws + WS_H), (const float*)(a->ws + WS_SS), a->final_norm_g, a->out); }
#undef IN
#undef SEAM
#undef DEQUEUE
}

extern "C" void kernel_launch(void* const* d_in, const int* in_sizes, int n_in, void* d_out, int out_size, void* d_ws, size_t ws_size, hipStream_t stream) {
    static int grid = 0;
    if (grid == 0) {
        if (n_in != 21 || in_sizes[0] != S * DM || out_size != S * DM || ws_size < WS_END) {
            fprintf(stderr, "kernel_launch: unexpected shapes (n_in %d, in0 %d, out %d, ws %zu < %zu); nothing launched\n", n_in, n_in > 0 ? in_sizes[0] : -1, out_size, ws_size, (size_t)WS_END); grid = -1; return; }
        int dev = 0, cus = 0, per_cu = 0;
        if (hipGetDevice(&dev) != hipSuccess || hipDeviceGetAttribute(&cus, hipDeviceAttributeMultiprocessorCount, dev) != hipSuccess) { fprintf(stderr, "kernel_launch: device query failed\n"); grid = -1; return; }
        if (hipFuncSetAttribute((const void*)fwd, hipFuncAttributeMaxDynamicSharedMemorySize, LDS_BYTES) != hipSuccess) { fprintf(stderr, "kernel_launch: hipFuncSetAttribute failed\n"); grid = -1; return; }
        if (hipOccupancyMaxActiveBlocksPerMultiprocessor(&per_cu, (const void*)fwd, NWAVES * 64, LDS_BYTES) != hipSuccess || per_cu < 1)
            fprintf(stderr, "kernel_launch: note: occupancy query reports %d workgroups per CU\n", per_cu);
        (void)hipGetLastError();
        grid = cus;
    }
    if (grid < 0) return;
    if (hipMemsetAsync((char*)d_ws + WS_CTL, 0, CTL_ZERO_BYTES, stream) != hipSuccess) { fprintf(stderr, "kernel_launch: memset failed\n"); return; }
    Args a{};
    const float** ap = (const float**)&a;
    for (int i = 0; i < 21; ++i) ap[i] = (const float*)d_in[i];
    a.out = (float*)d_out; a.ws = (unsigned char*)d_ws;
#if defined(CHECK) && CHECK
    for (int p = 0; p < N_PHASES; ++p) { a.ph_lo = p; a.ph_hi = p + 1; hipLaunchKernelGGL(fwd, dim3(grid), dim3(NWAVES * 64), LDS_BYTES, stream, a);
        if (p >= 1 && p < N_PHASES - 1) { const int l = (p - 1) / PH_PER_LAYER, q = (p - 1) % PH_PER_LAYER; Args b = a; b.ph_lo = 0; b.ph_hi = 0;
            if (q == 3) hipLaunchKernelGGL(chk::chk_inproj, dim3(512), dim3(256), 0, stream, b, l);
            if (q == 2) hipLaunchKernelGGL(chk::chk_prep, dim3(512), dim3(256), 0, stream, b, l);
            if (q == 5) hipLaunchKernelGGL(chk::chk_attn, dim3(512), dim3(256), 0, stream, b, l); } }
    { Args b = a; b.ph_lo = 0; b.ph_hi = 0; hipLaunchKernelGGL(chk::chk_poison, dim3(1), dim3(64), 0, stream, b); }
#elif MK_PER_PHASE
    for (int p = 0; p < N_PHASES; ++p) { a.ph_lo = p; a.ph_hi = p + 1; hipLaunchKernelGGL(fwd, dim3(grid), dim3(NWAVES * 64), LDS_BYTES, stream, a); }
#else
    a.ph_lo = 0; a.ph_hi = N_PHASES;
    hipLaunchKernelGGL(fwd, dim3(grid), dim3(NWAVES * 64), LDS_BYTES, stream, a);
#endif
    const hipError_t le = hipPeekAtLastError();
    if (le != hipSuccess) fprintf(stderr, "kernel_launch: launch failed: %s\n", hipGetErrorName(le));
}
```

```cpp
#include <hip/hip_runtime.h>
#include <hip/hip_bf16.h>
#include <cstdio>
#include <cstdint>
#include <cmath>
__device__ __forceinline__ int tid_fresh() { int t = threadIdx.x; asm volatile("" : "+v"(t)); return t; }
#ifndef CHECK
#define CHECK 0
#endif
#ifndef BREAK
#define BREAK 0
#endif
namespace pg8 {
#define PG8_LAS __attribute__((address_space(3)))
typedef unsigned short bf16_t;
typedef short bf16x8 __attribute__((ext_vector_type(8)));
typedef float f32x4 __attribute__((ext_vector_type(4)));
typedef unsigned u32x4 __attribute__((ext_vector_type(4)));
constexpr int BM = 256, BK = 64, HALF = 128, HTB = HALF * BK * 2  , STAGE_BYTES = 8 * HTB, NXCD = 8, WGM = 4;

__host__ __device__ __forceinline__ int lds_byte(int r, int c) { const int st = (r >> 4) * 2 + (c >> 5), rr = r & 15, cc = c & 31, ob = rr * 64 + cc * 2; return st * 1024 + (ob ^ (((ob >> 9) & 1) << 5)); }
__host__ __device__ __forceinline__ void stage_rc(int b, int& R, int& C) { const int st = b / 1024, sb = b % 1024, swz = sb ^ (((sb >> 9) & 1) << 5); R = (st >> 1) * 16 + swz / 64; C = (st & 1) * 32 + (swz % 64) / 2; }
__host__ __device__ __forceinline__ int perm32(int rho) { const int n = rho >> 4, i = rho & 15; return 8 * (i >> 2) + 4 * n + (i & 3); }

struct Unit { int pm, pn; };
struct Gemm { const bf16_t* A; const bf16_t* Bt; int M, N, K; };

struct StaticOrder {
    int nM, nN, nwg, G, c;
    __host__ __device__ void init(int M, int N, int G_, int c_) { nM = M / BM; nN = N / BM; nwg = nM * nN; G = G_; c = c_; }
    __host__ __device__ bool next(int i, Unit& u) const {
        const long L = (long)i * G + c; if (L >= nwg) return false;
        int wgid = (int)L; { const int q = nwg / NXCD, r = nwg % NXCD, xcd = wgid % NXCD, off = wgid / NXCD; wgid = (xcd < r ? xcd * (q + 1) : r * (q + 1) + (xcd - r) * q) + off; }
        const int nig = WGM * nN, gid = wgid / nig, fm = gid * WGM, gsz = (nM - fm) < WGM ? (nM - fm) : WGM;
        u.pm = fm + ((wgid % nig) % gsz); u.pn = (wgid % nig) / gsz; return true;
    }
    __device__ __forceinline__ void a_ready(const Unit&) const {}
    __device__ __forceinline__ void done(const Unit&) const {}
};

__device__ __forceinline__ unsigned cvt_pk_bf16(float lo, float hi) { unsigned r; asm volatile("v_cvt_pk_bf16_f32 %0, %1, %2" : "=v"(r) : "v"(lo), "v"(hi)); return r; }
typedef float f32x2 __attribute__((ext_vector_type(2)));


struct EpiIn {
    static constexpr bool PERM = true, AFTER_DRAIN = false;
    bf16_t* O; int ldc; float* FG; int odd; const PG8_LAS float* tab;
    __device__ __forceinline__ void operator()(const f32x4 (&acc)[2][2][4][2], const Unit& u, int ui, int wr, int wc, int fr, int fq) const {
        asm volatile("" : "+v"(fr), "+v"(fq));
        const int pn = u.pn;
        int mode;
        if (!odd) mode = (pn < 8 || (pn >= 12 && pn <= 16)) ? 1 : 0;
        else mode = (pn == 22) ? 2 : (((pn >= 12 && pn <= 16) || pn == 18 || pn == 20) ? 1 : 0);
        const int row0 = u.pm * BM + wr * 64 + fr;
        const int hh = wc >> 1, dd = (wc & 1) * 32 + 8 * fq;
        const int cl0 = hh * 128 + dd, col0 = pn * BM + cl0;
        const PG8_LAS float* tb = tab + ui * 512;
        if (mode == 2) {
            if (wc == 0) { const f32x4 bb0 = *(const PG8_LAS f32x4*)(tb + 256 + cl0), bb1 = *(const PG8_LAS f32x4*)(tb + 256 + cl0 + 4);
#pragma unroll
                for (int ai = 0; ai < 2; ++ai)
#pragma unroll
                    for (int m = 0; m < 4; ++m) { const int row = row0 + ai * HALF + m * 16; const float rs = tb[wr * 64 + fr + ai * HALF + m * 16]; float* p = FG + (size_t)(8 * fq) * 8192 + row;
                        const f32x4 v0 = acc[ai][0][m][0] * rs + bb0, v1 = acc[ai][0][m][1] * rs + bb1;
#pragma unroll
                        for (int e = 0; e < 4; ++e) { p[(size_t)e * 8192] = v0[e]; p[(size_t)(4 + e) * 8192] = v1[e]; } }
            }
            return;
        }
        const f32x4 ir0 = *(const PG8_LAS f32x4*)(tab + 2048 + dd), ir1 = *(const PG8_LAS f32x4*)(tab + 2048 + dd + 4);
        const f32x4 ba0 = *(const PG8_LAS f32x4*)(tb + 256 + cl0), ba1 = *(const PG8_LAS f32x4*)(tb + 256 + cl0 + 4), bb0 = *(const PG8_LAS f32x4*)(tb + 256 + cl0 + 64), bb1 = *(const PG8_LAS f32x4*)(tb + 256 + cl0 + 68);
#pragma unroll
        for (int ai = 0; ai < 2; ++ai)
#pragma unroll
            for (int m = 0; m < 4; ++m) { const int row = row0 + ai * HALF + m * 16; const float rs = tb[wr * 64 + fr + ai * HALF + m * 16];
                f32x4 a0 = acc[ai][0][m][0] * rs + ba0, a1 = acc[ai][0][m][1] * rs + ba1, b0 = acc[ai][1][m][0] * rs + bb0, b1 = acc[ai][1][m][1] * rs + bb1;
                if (mode == 1) {
                    const float tf = (float)row; f32x4 c0, c1, s0, s1;
#pragma unroll
                    for (int e = 0; e < 4; ++e) { float r0 = tf * ir0[e], r1 = tf * ir1[e]; r0 = __builtin_amdgcn_fractf(r0); r1 = __builtin_amdgcn_fractf(r1);
                        c0[e] = __builtin_amdgcn_cosf(r0); s0[e] = __builtin_amdgcn_sinf(r0); c1[e] = __builtin_amdgcn_cosf(r1); s1[e] = __builtin_amdgcn_sinf(r1); }
                    const f32x4 x0 = a0 * c0 - b0 * s0, x1 = a1 * c1 - b1 * s1, y0 = a0 * s0 + b0 * c0, y1 = a1 * s1 + b1 * c1;
                    a0 = x0; a1 = x1; b0 = y0; b1 = y1; }
                bf16_t* rowp = O + (size_t)row * ldc + col0;
                u32x4 w; w.x = cvt_pk_bf16(a0[0], a0[1]); w.y = cvt_pk_bf16(a0[2], a0[3]); w.z = cvt_pk_bf16(a1[0], a1[1]); w.w = cvt_pk_bf16(a1[2], a1[3]);
                *(u32x4*)rowp = w;
                u32x4 v; v.x = cvt_pk_bf16(b0[0], b0[1]); v.y = cvt_pk_bf16(b0[2], b0[3]); v.z = cvt_pk_bf16(b1[0], b1[1]); v.w = cvt_pk_bf16(b1[2], b1[3]);
                *(u32x4*)(rowp + 64) = v; }
    }
};
struct EpiRes {
    static constexpr bool PERM = true, AFTER_DRAIN = false;
    bf16_t* R; float* XF; int ldc; const float* gate; float* ss;
    __device__ __forceinline__ void operator()(const f32x4 (&acc)[2][2][4][2], const Unit& u, int ui, int wr, int wc, int fr, int fq) const {
        asm volatile("" : "+v"(fr), "+v"(fq));
        const int row0 = u.pm * BM + wr * 64 + fr, col0 = u.pn * BM + wc * 32 + 8 * fq;
        f32x4 gv[2][2];
#pragma unroll
        for (int bj = 0; bj < 2; ++bj)
#pragma unroll
            for (int n = 0; n < 2; ++n) gv[bj][n] = *(const f32x4*)(gate + col0 + bj * HALF + 4 * n);
#pragma unroll
        for (int ai = 0; ai < 2; ++ai)
#pragma unroll
            for (int m = 0; m < 4; ++m) { const int row = row0 + ai * HALF + m * 16; const size_t off = (size_t)row * ldc + col0; float sq = 0.f;
#pragma unroll
                for (int bj = 0; bj < 2; ++bj) { const u32x4 rb = *(const u32x4*)(R + off + bj * HALF);
                    const f32x4 r0 = {__builtin_bit_cast(float, rb.x << 16), __builtin_bit_cast(float, rb.x & 0xffff0000u), __builtin_bit_cast(float, rb.y << 16), __builtin_bit_cast(float, rb.y & 0xffff0000u)};
                    const f32x4 r1 = {__builtin_bit_cast(float, rb.z << 16), __builtin_bit_cast(float, rb.z & 0xffff0000u), __builtin_bit_cast(float, rb.w << 16), __builtin_bit_cast(float, rb.w & 0xffff0000u)};
                    const f32x4 x0 = r0 + gv[bj][0] * acc[ai][bj][m][0], x1 = r1 + gv[bj][1] * acc[ai][bj][m][1];
                    if (XF) { *(f32x4*)(XF + off + bj * HALF) = x0; *(f32x4*)(XF + off + bj * HALF + 4) = x1; }
                    sq += ((x0[0] * x0[0] + x0[1] * x0[1]) + (x0[2] * x0[2] + x0[3] * x0[3])) + ((x1[0] * x1[0] + x1[1] * x1[1]) + (x1[2] * x1[2] + x1[3] * x1[3]));
                    u32x4 w; w.x = cvt_pk_bf16(x0[0], x0[1]); w.y = cvt_pk_bf16(x0[2], x0[3]); w.z = cvt_pk_bf16(x1[0], x1[1]); w.w = cvt_pk_bf16(x1[2], x1[3]);
                    *(u32x4*)(R + off + bj * HALF) = w; }
                if (ss) { sq += __shfl_xor(sq, 16); sq += __shfl_xor(sq, 32); if (fq == 0) ss[(size_t)row * 32 + u.pn * 4 + wc] = sq; } }
    }
};
struct EpiRelu2 {
    static constexpr bool PERM = true, AFTER_DRAIN = false;
    bf16_t* O; int ldc; const PG8_LAS float* tab;
    __device__ __forceinline__ void operator()(const f32x4 (&acc)[2][2][4][2], const Unit& u, int ui, int wr, int wc, int fr, int fq) const {
        asm volatile("" : "+v"(fr), "+v"(fq));
        const int row0 = u.pm * BM + wr * 64 + fr, col0 = u.pn * BM + wc * 32 + 8 * fq;
        const PG8_LAS float* tb = tab + ui * 512; const int cl0 = wc * 32 + 8 * fq;
        f32x4 bv[2][2];
#pragma unroll
        for (int bj = 0; bj < 2; ++bj)
#pragma unroll
            for (int n = 0; n < 2; ++n) bv[bj][n] = *(const PG8_LAS f32x4*)(tb + 256 + cl0 + bj * HALF + 4 * n);
#pragma unroll
        for (int ai = 0; ai < 2; ++ai)
#pragma unroll
            for (int m = 0; m < 4; ++m) { const int row = row0 + ai * HALF + m * 16; const float rs = tb[wr * 64 + fr + ai * HALF + m * 16]; bf16_t* rowp = O + (size_t)row * ldc + col0;
#pragma unroll
                for (int bj = 0; bj < 2; ++bj) { f32x4 v0 = acc[ai][bj][m][0] * rs + bv[bj][0], v1 = acc[ai][bj][m][1] * rs + bv[bj][1];
#pragma unroll
                    for (int e = 0; e < 4; ++e) { const float a = fmaxf(v0[e], 0.f), b = fmaxf(v1[e], 0.f); v0[e] = a * a; v1[e] = b * b; }
                    u32x4 w; w.x = cvt_pk_bf16(v0[0], v0[1]); w.y = cvt_pk_bf16(v0[2], v0[3]); w.z = cvt_pk_bf16(v1[0], v1[1]); w.w = cvt_pk_bf16(v1[2], v1[3]);
                    *(u32x4*)(rowp + bj * HALF) = w; } }
    }
};

struct MapOrder {
    StaticOrder b; int cut, shift;
    __device__ void init(int M, int nTiles, int G_, int c_, int cut_, int shift_) { b.init(M, nTiles * BM, G_, c_); cut = cut_; shift = shift_; }
    __device__ bool next(int i, Unit& u) const { if (!b.next(i, u)) return false; u.pn += (u.pn >= cut) ? shift : 0; return true; }
    __device__ __forceinline__ void a_ready(const Unit&) const {}
    __device__ __forceinline__ void done(const Unit&) const {}
};

template <class Sched>
__device__ __forceinline__ void epi_preload(const Sched& S, const float* ss, const float* bp, PG8_LAS float* tab) {
    const int tid = tid_fresh();
    if (tid < 64) tab[2048 + tid] = 0.15915494309189535f / powf(10000.f, (float)tid * (1.f / 64.f));
    Unit u;
    if (tid < 256) {
        int pmp = -1; float rs = 0.f;
        for (int i = 0; i < 4 && S.next(i, u); ++i) {
            if (u.pm != pmp) { const float* sp = ss + (size_t)(u.pm * BM + tid) * 32; float t = 0.f; pmp = u.pm;
#pragma unroll
                for (int q = 0; q < 8; ++q) { const f32x4 a = *(const f32x4*)(sp + 4 * q); t += (a[0] + a[1]) + (a[2] + a[3]); }
                rs = 1.f / sqrtf(t * (1.f / 2048.f) + 1e-6f); }
            tab[i * 512 + tid] = rs; }
    } else {
        const int w = (tid - 256) >> 6, ln = tid & 63;
        if (S.next(w, u)) { const float* b = bp + u.pn * BM + 4 * ln; f32x4 t0 = {0.f, 0.f, 0.f, 0.f}, t1 = t0;
#pragma unroll
            for (int kb = 0; kb < 32; kb += 2) { t0 += *(const f32x4*)(b + (size_t)kb * 8192); t1 += *(const f32x4*)(b + (size_t)(kb + 1) * 8192); }
            *(PG8_LAS f32x4*)(tab + w * 512 + 256 + 4 * ln) = t0 + t1; }
    }
    __syncthreads();
}
template <class Epi, class Sched, bool ALIGN_EPI = false, bool SP2 = false>
__device__ __forceinline__ void gemm_phase(PG8_LAS unsigned char* lds, const Gemm g, const Sched& S, const Epi& E) {
    const int tid = tid_fresh(), wid = __builtin_amdgcn_readfirstlane(tid >> 6), lane = tid & 63, wr = wid >> 2, wc = wid & 3, fr = lane & 15, fq = lane >> 4;
    const int K = g.K, nt = K / BK;
    unsigned voffA[2], voffB[2];
#pragma unroll
    for (int i = 0; i < 2; ++i) { int R, C; stage_rc(tid * 16 + i * 8192, R, C); const int Rb = Epi::PERM ? ((R & ~31) + perm32(R & 31)) : R;
        voffA[i] = (unsigned)(R * K + C) * 2u; voffB[i] = (unsigned)(Rb * K + C) * 2u; }
    const size_t kstep = (size_t)(BK * 2);
    const size_t hstep = (size_t)HALF * K * 2;
    const size_t tstep = 2 * hstep;
    const unsigned ldsw = (unsigned)wid * 1024u;
    const int aoff = lds_byte(wr * 64 + fr, fq * 8), boff = lds_byte(wc * 32 + fr, fq * 8);
#define PG8_SA(b, h) (((b) * 2 + (h)) * HTB)
#define PG8_SB(b, h) ((4 + (b) * 2 + (h)) * HTB)
#define PG8_STAGE(bufoff, gbase, voff) do { _Pragma("unroll") for (int _i = 0; _i < 2; ++_i) \
        __builtin_amdgcn_global_load_lds((const unsigned*)((const char*)(gbase) + (voff)[_i]), (PG8_LAS unsigned*)(lds + (bufoff) + ldsw + _i * 8192), 16, 0, 0); } while (0)
#define PG8_LDA(dst, b, h) do { _Pragma("unroll") for (int m = 0; m < 4; ++m) _Pragma("unroll") for (int k = 0; k < 2; ++k) dst[m][k] = *(const PG8_LAS bf16x8*)(lds + PG8_SA(b, h) + aoff + m * 2048 + k * 1024); } while (0)
#define PG8_LDB(dst, b, h) do { _Pragma("unroll") for (int n = 0; n < 2; ++n) _Pragma("unroll") for (int k = 0; k < 2; ++k) dst[n][k] = *(const PG8_LAS bf16x8*)(lds + PG8_SB(b, h) + boff + n * 2048 + k * 1024); } while (0)
#define PG8_MMA(ai, bj, At, Bt) do { __builtin_amdgcn_s_setprio(1); _Pragma("unroll") for (int m = 0; m < 4; ++m) _Pragma("unroll") for (int n = 0; n < 2; ++n) _Pragma("unroll") for (int k = 0; k < 2; ++k) \
        acc[ai][bj][m][n] = __builtin_amdgcn_mfma_f32_16x16x32_bf16(Bt[n][k], At[m][k], acc[ai][bj][m][n], 0, 0, 0); __builtin_amdgcn_s_setprio(0); } while (0)
#define PG8_WAIT_V(n) asm volatile("s_waitcnt vmcnt(" #n ")" ::: "memory")
#define PG8_WAIT_L(n) asm volatile("s_waitcnt lgkmcnt(" #n ")" ::: "memory")
#define PG8_BAR __builtin_amdgcn_s_barrier()
#define PG8_SCHED __builtin_amdgcn_sched_barrier(0)
    Unit cur, nxt; int ui = 0;
    if (!S.next(0, cur)) return;
    f32x4 acc[2][2][4][2];
#pragma unroll
    for (int a = 0; a < 2; ++a)
#pragma unroll
        for (int b = 0; b < 2; ++b)
#pragma unroll
            for (int m = 0; m < 4; ++m)
#pragma unroll
                for (int n = 0; n < 2; ++n) acc[a][b][m][n] = (f32x4){0.f, 0.f, 0.f, 0.f};
    bf16x8 At[4][2], B0[2][2], B1[2][2];
    const char* cA = (const char*)g.A + (size_t)cur.pm * tstep; const char* cB = (const char*)g.Bt + (size_t)cur.pn * tstep;
    S.a_ready(cur);
    if constexpr (SP2) {
        PG8_STAGE(PG8_SB(0, 0), cB, voffB); PG8_STAGE(PG8_SB(0, 1), cB + hstep, voffB); PG8_STAGE(PG8_SA(0, 0), cA, voffA); PG8_STAGE(PG8_SA(0, 1), cA + hstep, voffA);
        if (wr == 1) PG8_BAR;
        PG8_WAIT_V(2); PG8_BAR;
        PG8_STAGE(PG8_SB(1, 0), cB + kstep, voffB); PG8_STAGE(PG8_SA(1, 0), cA + kstep, voffA); PG8_STAGE(PG8_SB(1, 1), cB + hstep + kstep, voffB);
        PG8_WAIT_V(6); PG8_BAR;
    } else {
        PG8_STAGE(PG8_SB(0, 0), cB, voffB); PG8_STAGE(PG8_SA(0, 0), cA, voffA); PG8_STAGE(PG8_SB(0, 1), cB + hstep, voffB); PG8_STAGE(PG8_SA(0, 1), cA + hstep, voffA);
        if (wr == 1) PG8_BAR;
        PG8_WAIT_V(4); PG8_BAR;
        PG8_STAGE(PG8_SB(1, 0), cB + kstep, voffB); PG8_STAGE(PG8_SA(1, 0), cA + kstep, voffA); PG8_STAGE(PG8_SB(1, 1), cB + hstep + kstep, voffB);
        PG8_WAIT_V(6); PG8_BAR;
    }
    for (;;) {
        const bool has_next = S.next(ui + 1, nxt);
        const char* nA = has_next ? (const char*)g.A + (size_t)nxt.pm * tstep : cA; const char* nB = has_next ? (const char*)g.Bt + (size_t)nxt.pn * tstep : cB;
        for (int t = 0; t < nt; t += 2) {
            const bool last = (t == nt - 2);
            const char* a1 = cA + (size_t)(t + 1) * kstep;
            const char* a2 = last ? nA : cA + (size_t)(t + 2) * kstep; const char* b2 = last ? nB : cB + (size_t)(t + 2) * kstep;
            const char* a3 = a2 + kstep; const char* b3 = b2 + kstep;
            if (last && has_next) S.a_ready(nxt);
            if constexpr (SP2) {
            PG8_LDB(B0, 0, 0); PG8_LDB(B1, 0, 1); PG8_SCHED; PG8_LDA(At, 0, 0); PG8_STAGE(PG8_SA(1, 1), a1 + hstep, voffA);
            PG8_WAIT_V(8); PG8_WAIT_L(0); PG8_BAR; PG8_MMA(0, 0, At, B0); PG8_MMA(0, 1, At, B1); PG8_BAR; PG8_SCHED;
            PG8_LDA(At, 0, 1); PG8_STAGE(PG8_SB(0, 0), b2, voffB); PG8_STAGE(PG8_SB(0, 1), b2 + hstep, voffB); PG8_STAGE(PG8_SA(0, 0), a2, voffA);
            PG8_WAIT_V(8); PG8_WAIT_L(0); PG8_BAR; PG8_MMA(1, 0, At, B0); PG8_MMA(1, 1, At, B1); PG8_BAR; PG8_SCHED;
            PG8_LDB(B0, 1, 0); PG8_LDB(B1, 1, 1); PG8_SCHED; PG8_LDA(At, 1, 0); PG8_STAGE(PG8_SA(0, 1), a2 + hstep, voffA);
            PG8_WAIT_V(8); PG8_WAIT_L(0); PG8_BAR; PG8_MMA(0, 0, At, B0); PG8_MMA(0, 1, At, B1); PG8_BAR; PG8_SCHED;
            PG8_LDA(At, 1, 1); PG8_STAGE(PG8_SB(1, 0), b3, voffB); PG8_STAGE(PG8_SB(1, 1), b3 + hstep, voffB); PG8_STAGE(PG8_SA(1, 0), a3, voffA);
            PG8_WAIT_V(8); PG8_WAIT_L(0); PG8_BAR; PG8_MMA(1, 0, At, B0); PG8_MMA(1, 1, At, B1); PG8_BAR; PG8_SCHED;
            } else {
            PG8_LDB(B0, 0, 0); PG8_SCHED; PG8_LDA(At, 0, 0); PG8_STAGE(PG8_SA(1, 1), a1 + hstep, voffA);
            PG8_WAIT_L(8); PG8_BAR; PG8_WAIT_L(0); PG8_MMA(0, 0, At, B0); PG8_BAR; PG8_SCHED;
            PG8_LDB(B1, 0, 1); PG8_STAGE(PG8_SB(0, 0), b2, voffB);
            PG8_BAR; PG8_WAIT_L(0); PG8_MMA(0, 1, At, B1); PG8_BAR;
            PG8_LDA(At, 0, 1); PG8_STAGE(PG8_SA(0, 0), a2, voffA);
            PG8_BAR; PG8_WAIT_L(0); PG8_MMA(1, 0, At, B0); PG8_BAR; PG8_SCHED;
            PG8_STAGE(PG8_SB(0, 1), b2 + hstep, voffB);
            PG8_WAIT_V(6); PG8_BAR; PG8_MMA(1, 1, At, B1); PG8_BAR;
            PG8_LDB(B0, 1, 0); PG8_SCHED; PG8_LDA(At, 1, 0); PG8_STAGE(PG8_SA(0, 1), a2 + hstep, voffA);
            PG8_WAIT_L(8); PG8_BAR; PG8_WAIT_L(0); PG8_MMA(0, 0, At, B0); PG8_BAR; PG8_SCHED;
            PG8_LDB(B1, 1, 1); PG8_STAGE(PG8_SB(1, 0), b3, voffB);
            PG8_BAR; PG8_WAIT_L(0); PG8_MMA(0, 1, At, B1); PG8_BAR;
            PG8_LDA(At, 1, 1); PG8_STAGE(PG8_SA(1, 0), a3, voffA);
            PG8_BAR; PG8_WAIT_L(0); PG8_MMA(1, 0, At, B0); PG8_BAR; PG8_SCHED;
            PG8_STAGE(PG8_SB(1, 1), b3 + hstep, voffB);
            PG8_WAIT_V(6); PG8_BAR; PG8_MMA(1, 1, At, B1); PG8_BAR;
            }
        }
        if constexpr (ALIGN_EPI) { if (wr == 0) PG8_BAR; }
        if constexpr (!Epi::AFTER_DRAIN) { E(acc, cur, ui, wr, wc, fr, fq); S.done(cur); }
        if (!has_next) break;
#pragma unroll
        for (int a = 0; a < 2; ++a)
#pragma unroll
            for (int b = 0; b < 2; ++b)
#pragma unroll
                for (int m = 0; m < 4; ++m)
#pragma unroll
                    for (int n = 0; n < 2; ++n) acc[a][b][m][n] = (f32x4){0.f, 0.f, 0.f, 0.f};
        cur = nxt; cA = nA; cB = nB; ++ui;
        if constexpr (ALIGN_EPI) { if (wr == 1) PG8_BAR; }
    }
    PG8_WAIT_V(0);
    if constexpr (!ALIGN_EPI) { if (wr == 0) PG8_BAR; }
    PG8_BAR;
    if constexpr (Epi::AFTER_DRAIN) { E.fused(acc, cur, wr, wc, fr, fq, lds, wid, lane); S.done(cur); }
#undef PG8_SA
#undef PG8_SB
#undef PG8_STAGE
#undef PG8_LDA
#undef PG8_LDB
#undef PG8_MMA
#undef PG8_WAIT_V
#undef PG8_WAIT_L
#undef PG8_BAR
#undef PG8_SCHED
}
}

constexpr int S = 8192, DM = 2048, HD = 128, DFF = 8192, DEPTH = 4;
constexpr int NE = 4608, NO = 5888, NO_SRC = 5664;
constexpr float NORM_EPS = 1e-6f;
constexpr int NWAVES = 8;
constexpr int E_QA = 0, E_KA = 1024, E_VA = 2048, E_QB = 3072, E_KB = 4096, E_VB = 4352;
constexpr int O_QC = 0, O_KC = 1024, O_VC = 2048, O_QD = 3072, O_KCMP = 4096, O_VCMP = 4352, O_KSLC = 4608, O_VSLC = 4864, O_KWIN = 5120, O_VWIN = 5376, O_FG = 5632;
constexpr int NCMP = 511;

constexpr size_t MiB = 1u << 20;
constexpr size_t WS_CTL = 0, CTL_ZERO_BYTES = 1 * MiB;
constexpr size_t WS_MODS = 1 * MiB;
constexpr size_t WS_KMH = 6 * MiB, WS_KML = 6 * MiB + 128 * 1024;
constexpr size_t WS_CUM = 7 * MiB;
constexpr size_t WS_FOXN = 7 * MiB + 512 * 1024;
constexpr size_t WS_FG = 8 * MiB;
constexpr size_t WS_KC = 9 * MiB, WS_VC = 9 * MiB + 512 * 1024;
constexpr size_t WS_W1T = 10 * MiB;
constexpr size_t WS_W2T = 14 * MiB;
constexpr size_t WS_W = 16 * MiB, W_LAYER = 96 * MiB, W_IN = 0, W_OUT = 24 * MiB, W_UP = 32 * MiB, W_DOWN = 64 * MiB;
constexpr size_t WS_H = 400 * MiB;
constexpr size_t WS_QKV = 432 * MiB;
constexpr size_t WS_O = 528 * MiB;
constexpr size_t WS_U = 560 * MiB;
constexpr size_t WS_NSASCR = 688 * MiB;
constexpr size_t WS_MPO = WS_NSASCR;
constexpr size_t WS_MML = 752 * MiB;
constexpr size_t WS_MLIST = 754 * MiB;
constexpr size_t WS_SS = 762 * MiB;
constexpr size_t WS_BPART = 764 * MiB;
constexpr size_t WS_END = 772 * MiB;
constexpr int CW_BAR = 4096;
constexpr int CW_Q = 8192;
constexpr int CW_FOXN = 13312;
constexpr int CW_MCNT = 10240;

constexpr int RING_OFF = 0, RING_BYTES = 135168;
constexpr int LDSCTL_OFF = RING_BYTES, MISC_OFF = LDSCTL_OFF + 320;
constexpr int LDS_BYTES = 147456;
constexpr int EPITAB_OFF = MISC_OFF + 128;
static_assert(EPITAB_OFF + (4 * 512 + 64) * 4 <= LDS_BYTES, "LDS map");

#define GAS __attribute__((address_space(1)))
#define LAS __attribute__((address_space(3)))
#define DI __device__ __forceinline__
typedef unsigned short bf16;
typedef unsigned v4u __attribute__((ext_vector_type(4)));
typedef float f32x4 __attribute__((ext_vector_type(4)));
typedef float f32x16 __attribute__((ext_vector_type(16)));
typedef short bf16x8 __attribute__((ext_vector_type(8)));
typedef short s16x4 __attribute__((ext_vector_type(4)));
typedef GAS unsigned gu32;
#define RLX_AGENT __ATOMIC_RELAXED, __HIP_MEMORY_SCOPE_AGENT
#define LDS_WAIT() asm volatile("s_waitcnt lgkmcnt(0)" ::: "memory")
DI unsigned f2bf(float f) { unsigned u = __builtin_bit_cast(unsigned, f); return (u + 0x7fffu + ((u >> 16) & 1u)) >> 16; }
DI float bf2f(unsigned b) { return __builtin_bit_cast(float, b << 16); }
DI unsigned pk2(float lo, float hi) { return f2bf(lo) | (f2bf(hi) << 16); }
DI float wave_sum(float v) {
#pragma unroll
    for (int o = 1; o < 64; o <<= 1) v += __shfl_xor(v, o);
    return v;
}
#define XB_TMO      128
#define XB_XCNT(j)  (256  + 64 * (j))
#define XB_XSUB(j)  (1280 + 64 * (j))
#define XB_XGEN(j)  (2304 + 64 * (j))
#define XB_TOP      3328
#define XB_TOPGEN   3392
#define XCD_BAR_WORDS 3456
#define XB_SPIN_CAP (1u << 18)

__device__ __forceinline__ unsigned xb_ld(unsigned* p)              { return __hip_atomic_load(p, __ATOMIC_RELAXED, __HIP_MEMORY_SCOPE_AGENT); }
__device__ __forceinline__ unsigned xb_add(unsigned* p, unsigned v) { return __hip_atomic_fetch_add(p, v, __ATOMIC_RELAXED, __HIP_MEMORY_SCOPE_AGENT); }
__device__ __forceinline__ unsigned xb_xcc_id() { return (unsigned)__builtin_amdgcn_s_getreg((3 << 11) | 20) & 0xFu; }
#define XB_SPIN(cond, bar) do { unsigned _sp = 0; while (cond) { __builtin_amdgcn_s_sleep(1); \
    if ((++_sp & 255u) == 0u) { if (xb_ld(&(bar)[XB_TMO])) break; if (_sp > XB_SPIN_CAP) { atomicAdd(&(bar)[XB_TMO], 1u); break; } } } } while (0)

struct XcdBarrier {
    unsigned* bar; unsigned x;
    volatile LAS unsigned* st;
};

__device__ __forceinline__ XcdBarrier xcd_barrier_post(unsigned* bar, volatile LAS unsigned* st) {
    XcdBarrier b; b.bar = bar; b.x = xb_xcc_id(); b.st = st;
    if (threadIdx.x == 0) (void)xb_add(&bar[XB_XCNT(b.x)], 1u);
    return b;
}
__device__ __forceinline__ void xcd_barrier_complete(unsigned* bar, unsigned x, unsigned& nloc, unsigned& nx) {
    const unsigned G = gridDim.x * gridDim.y * gridDim.z;
    unsigned sum, cnt, mine, sp = 0u;
    for (;;) {
        sum = 0u; cnt = 0u; mine = 0u;
#pragma unroll
        for (unsigned j = 0; j < 16; ++j) { const unsigned c = xb_ld(&bar[XB_XCNT(j)]); sum += c; cnt += (c > 0u) ? 1u : 0u; mine = (j == x) ? c : mine; }
        if (sum == G) break;
        __builtin_amdgcn_s_sleep(1);
        if ((++sp & 255u) == 0u) { if (xb_ld(&bar[XB_TMO])) break; if (sp > XB_SPIN_CAP) { atomicAdd(&bar[XB_TMO], 1u); break; } }
    }
    nloc = mine > 0u ? mine : 1u; nx = cnt > 0u ? cnt : 1u;
}

__device__ __forceinline__ void xcd_barrier(const XcdBarrier& b) {
    asm volatile("s_waitcnt vmcnt(0)" ::: "memory");
    __syncthreads();
    if (threadIdx.x == 0) {
        unsigned* bar = b.bar;
        __builtin_amdgcn_s_waitcnt(0);
        unsigned nloc = b.st[0], nx = b.st[1];
        if (nloc == 0u) { xcd_barrier_complete(bar, b.x, nloc, nx); b.st[0] = nloc; b.st[1] = nx; }
        const unsigned old = xb_add(&bar[XB_XSUB(b.x)], 1u);
        const unsigned gen = old / nloc;
        if (old + 1u == (gen + 1u) * nloc) {
            __builtin_amdgcn_fence(__ATOMIC_RELEASE, "agent");
            asm volatile("s_waitcnt vmcnt(0)" ::: "memory");
            const unsigned og = xb_add(&bar[XB_TOP], 1u);
            const unsigned tg = og / nx;
            if (og + 1u == (tg + 1u) * nx) xb_add(&bar[XB_TOPGEN], 1u);
            else XB_SPIN(xb_ld(&bar[XB_TOPGEN]) == tg, bar);
            __builtin_amdgcn_fence(__ATOMIC_ACQUIRE, "agent");
            xb_add(&bar[XB_XGEN(b.x)], 1u);
            asm volatile("s_waitcnt vmcnt(0)" ::: "memory");
        } else {
            XB_SPIN(xb_ld(&bar[XB_XGEN(b.x)]) == gen, bar);
            __builtin_amdgcn_fence(__ATOMIC_ACQUIRE, "agent");
            asm volatile("s_waitcnt vmcnt(0)" ::: "memory");
        }
    }
    __syncthreads();
}

struct Args {
    const float* x; const float* c; const float* norm_mix_g; const float* norm_mlp_g; const float* ada_w; const float* ada_b;
    const float* mlp_up; const float* mlp_down; const float* even_w_in; const float* even_sinks; const float* even_w_out;
    const float* odd_w_in; const float* fox_forget_b; const float* nsa_k_pos; const float* nsa_k_w1; const float* nsa_k_w2;
    const float* nsa_v_pos; const float* nsa_v_w1; const float* nsa_v_w2; const float* odd_w_out; const float* final_norm_g;
    float* out; unsigned char* ws; int ph_lo, ph_hi;
};
typedef const __attribute__((address_space(4))) Args* KA;
DI KA kargs() { KA p = (KA)__builtin_amdgcn_kernarg_segment_ptr(); asm volatile("" : "+s"(p)); return p; }
struct Ctx {
    LAS unsigned char* lds; int tid, lane, wave, G, gw, NGW;
};
DI Ctx make_ctx(LAS unsigned char* lds) { Ctx C; C.lds = lds; C.tid = tid_fresh(); C.lane = C.tid & 63; C.wave = __builtin_amdgcn_readfirstlane(C.tid >> 6);
    C.G = gridDim.x; C.gw = blockIdx.x * NWAVES + C.wave; C.NGW = C.G * NWAVES; return C; }

DI int tile_perm_row(int nd) { const int q = nd & 255, hh = q >> 7, d = q & 127; return (nd & ~255) + (d < 64 ? hh * 64 + d : 128 + hh * 64 + (d - 64)); }
DI int odd_src_col(int nd) { return nd < 3072 ? nd : (nd < 5632 ? nd + 8 : (nd < 5640 ? 3072 + (nd - 5632) : (nd < 5664 ? nd : -1))); }
struct TJob { const float* W; int K, Nsrc, Ndst; bf16* WT; int mode; const float* Ak  ; const float* Sk  ; float* bp  ; };
DI float* bpart_of(unsigned char* ws, int l, int kind) { return (float*)(ws + WS_BPART) + (size_t)(l * 2 + kind) * 32 * 8192; }
DI void tr_load(const TJob& J, int item, int lane, float (&v)[64], int& sc) {
    const int nblk = J.Ndst / 64, kb = item / nblk, nb = item % nblk, k0 = 64 * kb, n0 = 64 * nb;
    const int ndl = n0 + lane;
    sc = (J.mode == 2) ? odd_src_col(ndl) : ndl;
    const int scl = sc >= 0 ? sc : 0;
#pragma unroll
    for (int i = 0; i < 64; ++i) { const float* rowp = J.W + (size_t)(k0 + i) * J.Nsrc; v[i] = __builtin_nontemporal_load(rowp + scl); }
    if (J.Ak) {
        const unsigned a_l = __builtin_bit_cast(unsigned, J.Ak[k0 + lane]), s_l = __builtin_bit_cast(unsigned, J.Sk[k0 + lane]);
        float part = 0.f;
#pragma unroll
        for (int i = 0; i < 64; ++i) { const float w = (sc >= 0) ? v[i] : 0.f;
            part = fmaf(__builtin_bit_cast(float, __builtin_amdgcn_readlane(s_l, i)), w, part); v[i] = w * __builtin_bit_cast(float, __builtin_amdgcn_readlane(a_l, i)); }
        J.bp[(size_t)kb * 8192 + ndl] = part; }
}
DI void tr_store(const TJob& J, int item, int lane, const float (&v)[64], int sc, LAS float* scr) {
    const int nblk = J.Ndst / 64, kb = item / nblk, nb = item % nblk, k0 = 64 * kb, n0 = 64 * nb;
#pragma unroll
    for (int i = 0; i < 64; ++i) scr[i * 65 + lane] = (sc >= 0) ? v[i] : 0.f;
    LDS_WAIT(); asm volatile("" ::: "memory");
    const int c = lane & 7;
#pragma unroll
    for (int j = 0; j < 8; ++j) { const int n = (lane >> 3) + 8 * j; const LAS float* s = scr + (8 * c) * 65 + n;
        v4u o; o.x = pk2(s[0 * 65], s[1 * 65]); o.y = pk2(s[2 * 65], s[3 * 65]); o.z = pk2(s[4 * 65], s[5 * 65]); o.w = pk2(s[6 * 65], s[7 * 65]);
        const int drow = (J.mode == 0) ? (n0 + n) : tile_perm_row(n0 + n);
        *(GAS v4u*)(J.WT + (size_t)drow * J.K + k0 + 8 * c) = o; }
    LDS_WAIT(); asm volatile("" ::: "memory");
}
DI void p0_transpose_item(const float* W, int K, int Nsrc, int Ndst, bf16* WT, LAS float* scr, int item, int lane, int mode) {
    const TJob J{W, K, Nsrc, Ndst, WT, mode, nullptr, nullptr, nullptr}; float v[64]; int sc; tr_load(J, item, lane, v, sc); tr_store(J, item, lane, v, sc, scr);
}
DI void transpose_job_item(const TJob& J, LAS float* scr, int item, int lane) { float v[64]; int sc; tr_load(J, item, lane, v, sc); tr_store(J, item, lane, v, sc, scr); }
DI float silu_f(float v) { return v / (1.f + expf(-v)); }

DI int conv_items(int l, int x) { return x == 0 ? (DM / 64) * (((l & 1) ? NO : NE) / 64) : (x == 1 ? (DM / 64) * (DM / 64) : (DM / 64) * (DFF / 64)); }
DI TJob conv_job(KA a, unsigned char* ws, int l, int x) {
    const int j = l >> 1; const bool odd = l & 1;
    unsigned char* wl = ws + WS_W + (size_t)l * W_LAYER; const float* mods = (const float*)(ws + WS_MODS) + (size_t)l * 6 * DM;
    if (x == 0) { if (!odd) return TJob{a->even_w_in + (size_t)j * DM * NE, DM, NE, NE, (bf16*)(wl + W_IN), 1, mods + 1 * DM, mods, bpart_of(ws, l, 0)};
                  return TJob{a->odd_w_in + (size_t)j * DM * NO_SRC, DM, NO_SRC, NO, (bf16*)(wl + W_IN), 2, mods + 1 * DM, mods, bpart_of(ws, l, 0)}; }
    if (x == 1) return TJob{(odd ? a->odd_w_out : a->even_w_out) + (size_t)j * DM * DM, DM, DM, DM, (bf16*)(wl + W_OUT), 0, nullptr, nullptr, nullptr};
    if (x == 2) return TJob{a->mlp_up + (size_t)l * DM * DFF, DM, DFF, DFF, (bf16*)(wl + W_UP), 0, mods + 4 * DM, mods + 3 * DM, bpart_of(ws, l, 1)};
    return TJob{a->mlp_down + (size_t)l * DFF * DM, DFF, DM, DM, (bf16*)(wl + W_DOWN), 0, nullptr, nullptr, nullptr};
}
DI void conv_item(KA a, unsigned char* ws, int l, int x, int item, LAS float* scr, int lane) { const TJob J = conv_job(a, ws, l, x); transpose_job_item(J, scr, item, lane); }
DI void p0_ada(KA a, const Ctx& C) {
    unsigned char* ws = a->ws;
    {
        LAS float* red = (LAS float*)(C.lds + RING_OFF);
        for (int u = blockIdx.x; u < 4 * 48; u += C.G) {
            const int l = u / 48, cg = u % 48;
            const float* Wb = a->ada_w + (size_t)l * DM * (6 * DM) + cg * 256 + 4 * C.lane;
            f32x4 acc = {0.f, 0.f, 0.f, 0.f};
            const int kbeg = C.wave * 256;
#pragma unroll 8
            for (int k = 0; k < 256; ++k) { const float sc = silu_f(a->c[kbeg + k]); const f32x4 w = *(const f32x4*)(Wb + (size_t)(kbeg + k) * (6 * DM)); acc += w * sc; }
            __syncthreads();
            *(LAS f32x4*)(red + C.wave * 256 + 4 * C.lane) = acc;
            __syncthreads();
            if (C.tid < 256) { float v = 0.f;
#pragma unroll
                for (int w = 0; w < 8; ++w) v += red[w * 256 + C.tid];
                const int j = cg * 256 + C.tid, sec = j / DM, col = j % DM;
                v += a->ada_b[(size_t)l * 6 * DM + j];
                if (sec == 1) v = a->norm_mix_g[l * DM + col] * (1.f + v);
                if (sec == 4) v = a->norm_mlp_g[l * DM + col] * (1.f + v);
                ((float*)(ws + WS_MODS))[(size_t)l * 6 * DM + j] = v; }
        }
        __syncthreads();
    }
}
DI void p0_convert(KA a, const Ctx& C) {
    unsigned char* ws = a->ws;
    {
        LAS float* scr = (LAS float*)(C.lds + RING_OFF + C.wave * 16640);
        constexpr int I_W1 = (4096 / 64) * (128 / 64), I_W2 = (128 / 64) * (128 / 64);
        const int n0 = conv_items(0, 0) + conv_items(0, 1) + conv_items(0, 2) + conv_items(0, 3), n1 = conv_items(1, 0);
        const int total = n0 + n1 + 4 * (I_W1 + I_W2);
        for (int it = C.gw; it < total; it += C.NGW) {
            if (it < n0) { int r = it, x = 0; while (r >= conv_items(0, x)) { r -= conv_items(0, x); ++x; } conv_item(a, ws, 0, x, r, scr, C.lane); }
            else if (it < n0 + n1) conv_item(a, ws, 1, 0, it - n0, scr, C.lane);
            else { int r = it - n0 - n1; const int q = r / (I_W1 + I_W2); r %= (I_W1 + I_W2); const int j = q >> 1, kind = q & 1;
                if (r < I_W1) p0_transpose_item((kind ? a->nsa_v_w1 : a->nsa_k_w1) + (size_t)j * 4096 * 128, 4096, 128, 128, (bf16*)(ws + WS_W1T) + (size_t)q * 128 * 4096, scr, r, C.lane, 0);
                else p0_transpose_item((kind ? a->nsa_v_w2 : a->nsa_k_w2) + (size_t)j * 128 * 128, 128, 128, 128, (bf16*)(ws + WS_W2T) + (size_t)q * 128 * 128, scr, r - I_W1, C.lane, 0); }
        }
    }
}

DI void resid_init_phase(const Ctx& C, const float* X, bf16* R, float* ss) {
    for (int m = C.gw; m < S; m += C.NGW) {
        const GAS f32x4* xr = (const GAS f32x4*)(X + (size_t)m * DM) + C.lane;
        f32x4 v[8]; float s = 0.f;
#pragma unroll
        for (int j = 0; j < 8; ++j) { v[j] = xr[64 * j]; s += (v[j].x * v[j].x + v[j].y * v[j].y) + (v[j].z * v[j].z + v[j].w * v[j].w); }
        const float tot = wave_sum(s);
        if (C.lane < 32) ss[(size_t)m * 32 + C.lane] = C.lane == 0 ? tot : 0.f;
        GAS unsigned long long* o8 = (GAS unsigned long long*)(R + (size_t)m * DM) + C.lane;
#pragma unroll
        for (int j = 0; j < 8; ++j) o8[64 * j] = (unsigned long long)pk2(v[j].x, v[j].y) | ((unsigned long long)pk2(v[j].z, v[j].w) << 32);
    }
}
DI bool tail_item(KA a, unsigned char* ws, LAS unsigned char* lds, int l, int which, int ti) {
    const bool n1 = l + 1 < DEPTH, n2 = l + 2 < DEPTH;
    int jl[4], jx[4], nj = 0;
    if (which == 0) { if (n1) { jl[nj] = l + 1; jx[nj++] = 1; jl[nj] = l + 1; jx[nj++] = 2; jl[nj] = l + 1; jx[nj++] = 3; } }
    else if (which == 1) { if (n2) { jl[nj] = l + 2; jx[nj++] = 0; } }
    else { if (n1) { jl[nj] = l + 1; jx[nj++] = 1; jl[nj] = l + 1; jx[nj++] = 2; jl[nj] = l + 1; jx[nj++] = 3; } if (n2) { jl[nj] = l + 2; jx[nj++] = 0; } }
    const int tid = tid_fresh(), lane = tid & 63, wave = __builtin_amdgcn_readfirstlane(tid >> 6);
    LAS float* scr = (LAS float*)(lds + RING_OFF + wave * 16640);
#pragma unroll
    for (int q = 0; q < 4; ++q) { if (q < nj) { const int cnt = conv_items(jl[q], jx[q]) >> 3; if (ti < cnt) { conv_item(a, ws, jl[q], jx[q], ti * 8 + wave, scr, lane); return true; } ti -= cnt; } }
    return false;
}
DI void final_norm_phase(const Ctx& C, const bf16* R, const float* ss, const float* g, float* OUT) {
    for (int m = C.gw; m < S; m += C.NGW) {
        float s = C.lane < 32 ? ss[(size_t)m * 32 + C.lane] : 0.f;
        const float rstd = 1.f / sqrtf(wave_sum(s) * (1.f / DM) + NORM_EPS);
        const GAS v4u* rr = (const GAS v4u*)(R + (size_t)m * DM) + C.lane;
        GAS f32x4* orow = (GAS f32x4*)(OUT + (size_t)m * DM);
        v4u w[4];
#pragma unroll
        for (int j = 0; j < 4; ++j) w[j] = rr[64 * j];
#pragma unroll
        for (int j = 0; j < 4; ++j) { const int c4 = 128 * j + 2 * C.lane;
            const f32x4 g0 = *((const f32x4*)g + c4), g1 = *((const f32x4*)g + c4 + 1);
            const f32x4 x0 = {bf2f(w[j].x & 0xffffu), bf2f(w[j].x >> 16), bf2f(w[j].y & 0xffffu), bf2f(w[j].y >> 16)}, x1 = {bf2f(w[j].z & 0xffffu), bf2f(w[j].z >> 16), bf2f(w[j].w & 0xffffu), bf2f(w[j].w >> 16)};
            orow[c4] = x0 * rstd * g0; orow[c4 + 1] = x1 * rstd * g1; }
    }
}


DI void kmean_phase(const Ctx& C, const bf16* QKV, bf16* KMH, bf16* KML) {
    LAS float* part = (LAS float*)(C.lds + RING_OFF);
    for (int u = blockIdx.x; u < 256; u += C.G) {
        const int h = u >> 5, blk = u & 31;
        const int dch = C.tid & 15, kg = C.tid >> 4;
        float s[8];
#pragma unroll
        for (int e = 0; e < 8; ++e) s[e] = 0.f;
#pragma unroll
        for (int i = 0; i < 8; ++i) { const v4u w = *(const GAS v4u*)(QKV + (size_t)(blk * 256 + kg * 8 + i) * NE + E_KA + h * 128 + dch * 8);
            s[0] += bf2f(w.x & 0xffffu); s[1] += bf2f(w.x >> 16); s[2] += bf2f(w.y & 0xffffu); s[3] += bf2f(w.y >> 16);
            s[4] += bf2f(w.z & 0xffffu); s[5] += bf2f(w.z >> 16); s[6] += bf2f(w.w & 0xffffu); s[7] += bf2f(w.w >> 16); }
        __syncthreads();
#pragma unroll
        for (int e = 0; e < 8; ++e) part[kg * 128 + dch * 8 + e] = s[e];
        __syncthreads();
        if (C.tid < 128) { float v = 0.f;
#pragma unroll
            for (int g = 0; g < 32; ++g) v += part[g * 128 + C.tid];
            v *= (1.f / 256.f);
            const unsigned hb = f2bf(v); const float lo = v - bf2f(hb);
            KMH[(size_t)u * 128 + C.tid] = (bf16)hb; KML[(size_t)u * 128 + C.tid] = (bf16)f2bf(lo); }
    }
    __syncthreads();
}

DI float log_sigmoid_f(float x) { const float t = __builtin_amdgcn_exp2f(-fabsf(x) * 1.4426950408889634f); return fminf(x, 0.f) - 0.6931471805599453f * __builtin_amdgcn_logf(1.f + t); }
DI float gelu_tanh_f(float x) { return 0.5f * x * (1.f + tanhf(0.7978845608028654f * (x + 0.044715f * x * x * x))); }
DI f32x4 mfma16(bf16x8 a, bf16x8 b, f32x4 c) { return __builtin_amdgcn_mfma_f32_16x16x32_bf16(a, b, c, 0, 0, 0); }

#ifndef OP_DUP
#define OP_DUP 0
#endif
DI void oddprep_phase(KA a, const Ctx& C, int j  ) {
    unsigned char* ws = a->ws;
    const float* FG = (const float*)(ws + WS_FG); float* CUM = (float*)(ws + WS_CUM);
    const bf16* QKV = (const bf16*)(ws + WS_QKV);
    for (int u = blockIdx.x; u < 8 + 128 + 64; u += C.G) {
      for (int oprep_ = 0; oprep_ < ((u >= 136 ? (OP_DUP & 4) : (u < 8 ? (OP_DUP & 1) : (OP_DUP & 2))) ? 2 : 1); ++oprep_) {
        if (u >= 8 + 128) {
            const int hw = (u - 136) >> 2, part = (u - 136) & 3, h = hw >> 1, which = hw & 1; const int col = (which ? O_KC : O_QC) + h * 128;
            LAS float* wm = (LAS float*)(C.lds + RING_OFF);
            float mx = 0.f;
#pragma unroll 2
            for (int r = part * 2048 + C.tid; r < part * 2048 + 2048; r += NWAVES * 64) { float ss = 0.f;
#pragma unroll
                for (int i = 0; i < 16; ++i) { const v4u w = *(const GAS v4u*)(QKV + (size_t)r * NO + col + 8 * i);
                    const float a0 = bf2f(w.x & 0xffffu), a1 = bf2f(w.x >> 16), a2 = bf2f(w.y & 0xffffu), a3 = bf2f(w.y >> 16), a4 = bf2f(w.z & 0xffffu), a5 = bf2f(w.z >> 16), a6 = bf2f(w.w & 0xffffu), a7 = bf2f(w.w >> 16);
                    ss += (a0 * a0 + a1 * a1) + (a2 * a2 + a3 * a3) + (a4 * a4 + a5 * a5) + (a6 * a6 + a7 * a7); }
                mx = fmaxf(mx, ss); }
#pragma unroll
            for (int o = 1; o < 64; o <<= 1) mx = fmaxf(mx, __shfl_xor(mx, o));
            __syncthreads();
            if (C.lane == 0) wm[C.wave] = mx;
            __syncthreads();
            if (C.tid == 0) { float m = 0.f; for (int w = 0; w < NWAVES; ++w) m = fmaxf(m, wm[w]);
                __hip_atomic_fetch_max((gu32*)(ws + WS_CTL) + CW_FOXN + 16 * j + h * 2 + which, __builtin_bit_cast(unsigned, sqrtf(m)), RLX_AGENT); }
            __syncthreads();
        } else if (u < 8) {
            const int h = u; const float fb = a->fox_forget_b[j * 8 + h];
            LAS float* wtot = (LAS float*)(C.lds + RING_OFF);
            float v[16]; float run = 0.f;
#pragma unroll
            for (int i = 0; i < 16; ++i) { run += log_sigmoid_f(FG[(size_t)h * S + C.tid * 16 + i] + fb); v[i] = run; }
            float sc = run;
#pragma unroll
            for (int o = 1; o < 64; o <<= 1) { const float n = __shfl_up(sc, o); if (C.lane >= o) sc += n; }
            __syncthreads();
            if (C.lane == 63) wtot[C.wave] = sc;
            __syncthreads();
            float base = sc - run;
            for (int w = 0; w < C.wave; ++w) base += wtot[w];
#pragma unroll
            for (int i = 0; i < 16; ++i) CUM[(size_t)h * S + C.tid * 16 + i] = base + v[i];
            __syncthreads();
        } else {
            const int cu = u - 8, kind = cu >> 6, hd = (cu >> 5) & 1, n0 = (cu & 31) * 16;
            const int srccol = (kind ? O_VCMP : O_KCMP) + hd * 128;
            const float* pos = (kind ? a->nsa_v_pos : a->nsa_k_pos) + (size_t)j * 32 * 128;
            const bf16* w1t = (const bf16*)(ws + WS_W1T) + (size_t)(j * 2 + kind) * 128 * 4096;
            const bf16* w2t = (const bf16*)(ws + WS_W2T) + (size_t)(j * 2 + kind) * 128 * 128;
            bf16* dst = (bf16*)(ws + (kind ? WS_VC : WS_KC));
            LAS float* red = (LAS float*)(C.lds + RING_OFF);
            LAS bf16* h1b = (LAS bf16*)(C.lds + RING_OFF + 65536);
            const int row = C.lane & 15, kg = C.lane >> 4;
            f32x4 acc[8];
#pragma unroll
            for (int cb = 0; cb < 8; ++cb) acc[cb] = (f32x4){0.f, 0.f, 0.f, 0.f};
#define CMP_LOAD(step_, w_, q0_, q1_, b_) do { const int l_ = C.wave * 4 + ((step_) >> 2), d_ = 32 * ((step_) & 3) + 8 * kg; int tok_ = 16 * (n0 + row) + l_; if (tok_ > S - 1) tok_ = S - 1; \
                w_ = *(const GAS v4u*)(QKV + (size_t)tok_ * NO + srccol + d_); q0_ = *(const f32x4*)(pos + l_ * 128 + d_); q1_ = *(const f32x4*)(pos + l_ * 128 + d_ + 4);          \
                _Pragma("unroll") for (int cb = 0; cb < 8; ++cb) b_[cb] = *(const GAS bf16x8*)(w1t + (size_t)(cb * 16 + row) * 4096 + l_ * 128 + d_); } while (0)
#define CMP_MMA(w_, q0_, q1_, b_) do { v4u aw; aw.x = pk2(bf2f(w_.x & 0xffffu) + q0_.x, bf2f(w_.x >> 16) + q0_.y); aw.y = pk2(bf2f(w_.y & 0xffffu) + q0_.z, bf2f(w_.y >> 16) + q0_.w);                 \
                aw.z = pk2(bf2f(w_.z & 0xffffu) + q1_.x, bf2f(w_.z >> 16) + q1_.y); aw.w = pk2(bf2f(w_.w & 0xffffu) + q1_.z, bf2f(w_.w >> 16) + q1_.w);                                            \
                const bf16x8 af = __builtin_bit_cast(bf16x8, aw); _Pragma("unroll") for (int cb = 0; cb < 8; ++cb) acc[cb] = mfma16(af, b_[cb], acc[cb]); } while (0)
            { v4u wa, wb; f32x4 pa0, pa1, pb0, pb1; bf16x8 ba[8], bb[8];
              CMP_LOAD(0, wa, pa0, pa1, ba);
#pragma unroll 1
              for (int st = 0; st < 16; st += 2) { CMP_LOAD(st + 1, wb, pb0, pb1, bb); CMP_MMA(wa, pa0, pa1, ba); if (st + 2 < 16) CMP_LOAD(st + 2, wa, pa0, pa1, ba); CMP_MMA(wb, pb0, pb1, bb); } }
#undef CMP_LOAD
#undef CMP_MMA
            __syncthreads();
#pragma unroll
            for (int cb = 0; cb < 8; ++cb)
#pragma unroll
                for (int e = 0; e < 4; ++e) red[(C.wave * 16 + 4 * kg + e) * 128 + cb * 16 + row] = acc[cb][e];
            __syncthreads();
            for (int e = C.tid; e < 16 * 128; e += NWAVES * 64) { float v = 0.f;
#pragma unroll
                for (int w = 0; w < 8; ++w) v += red[w * 2048 + e];
                h1b[(e >> 7) * 136 + (e & 127)] = (bf16)f2bf(gelu_tanh_f(v)); }
            __syncthreads();
            {
                f32x4 o = {0.f, 0.f, 0.f, 0.f};
#pragma unroll
                for (int ks = 0; ks < 4; ++ks) { const bf16x8 af = *(const LAS bf16x8*)(h1b + row * 136 + 32 * ks + 8 * kg);
                    const bf16x8 bfr = *(const GAS bf16x8*)(w2t + (size_t)(C.wave * 16 + row) * 128 + 32 * ks + 8 * kg);
                    o = mfma16(af, bfr, o); }
#pragma unroll
                for (int e = 0; e < 4; ++e) { const int n = n0 + 4 * kg + e; dst[(size_t)n * 256 + hd * 128 + C.wave * 16 + row] = (n < NCMP) ? (bf16)f2bf(o[e]) : (bf16)0; }
            }
            __syncthreads();
        }
      }
    }
}

DI void moba_combine_phase(const Ctx& C, const bf16* PO, const float* PML, bf16* O) {
    constexpr float C2 = 0.08838834764831845f * 1.4426950408889634f;
    for (int item = C.gw; item < 8 * S; item += C.NGW) {
        const int token = item >> 3, h = item & 7; const int nsel = (token >> 8) < 3 ? (token >> 8) : 3;
        const size_t pb = ((size_t)h * S + token) * 4;
        const f32x4 ml01 = *(const f32x4*)(PML + pb * 2), ml23 = *(const f32x4*)(PML + pb * 2 + 4);
        const float m0 = ml01.x, l0 = ml01.y, m1 = ml01.z, l1 = ml01.w, m2 = ml23.x, l2 = ml23.y, m3 = ml23.z, l3 = ml23.w;
        float M = m3; if (nsel > 0) M = fmaxf(M, m0); if (nsel > 1) M = fmaxf(M, m1); if (nsel > 2) M = fmaxf(M, m2);
        const float w3 = l3 * __builtin_amdgcn_exp2f((m3 - M) * C2);
        const float w0 = nsel > 0 ? l0 * __builtin_amdgcn_exp2f((m0 - M) * C2) : 0.f, w1 = nsel > 1 ? l1 * __builtin_amdgcn_exp2f((m1 - M) * C2) : 0.f, w2 = nsel > 2 ? l2 * __builtin_amdgcn_exp2f((m2 - M) * C2) : 0.f;
        const GAS unsigned* po = (const GAS unsigned*)(PO + pb * 128) + C.lane;
        const unsigned u3 = po[3 * 64]; float a0 = w3 * bf2f(u3 & 0xffffu), a1 = w3 * bf2f(u3 >> 16);
        if (nsel > 0) { const unsigned u = po[0]; a0 += w0 * bf2f(u & 0xffffu); a1 += w0 * bf2f(u >> 16); }
        if (nsel > 1) { const unsigned u = po[64]; a0 += w1 * bf2f(u & 0xffffu); a1 += w1 * bf2f(u >> 16); }
        if (nsel > 2) { const unsigned u = po[128]; a0 += w2 * bf2f(u & 0xffffu); a1 += w2 * bf2f(u >> 16); }
        const float inv = 1.f / (w0 + w1 + w2 + w3);
        *((GAS unsigned*)(O + (size_t)token * DM + h * 128) + C.lane) = pk2(a0 * inv, a1 * inv);
    }
}

namespace att {
#ifndef FOX_SKIP
#define FOX_SKIP 1
#endif
#ifndef NSA_DUP
#define NSA_DUP 0
#endif
constexpr float SCALE = 0.08838834764831845f, LOG2E = 1.4426950408889634f, C2 = SCALE * LOG2E, INV_SCALE = 11.313708498984761f;
constexpr float THR = 8.f;
constexpr int KVBLK = 64, SHM_K = 16384, SHM_V = 16384;
constexpr int L_V = 0, L_K = 2 * SHM_V, L_WS = 65536, L_BIAS = L_WS + 2048, L_MISC = L_BIAS + 512, L_IMP = L_MISC + 1536, IMP_STRIDE = 132, L_SEL = L_IMP + 64 * IMP_STRIDE * 4, L_END = L_SEL + 1024;
static_assert(L_END <= RING_BYTES, "attention LDS map");
#define KSWZ(row, colB) ((row) * 256 + ((colB) ^ (((row) & 15) << 4)))
#define SBAR() __builtin_amdgcn_sched_barrier(0)
DI int v_st(int k, int c) { const int kk = (k & ~0xC) | ((k & 4) << 1) | ((k & 8) >> 1); return ((kk >> 3) * 4 + (c >> 5)) * 512 + ((kk & 7) * 32 + (c & 31)) * 2; }
DI int v_rd_base(int lane) { return ((lane & 3) << 3) | (((lane >> 2) & 3) << 6) | (((lane >> 4) & 1) << 5) | (((lane >> 5) & 1) << 8); }
constexpr int v_rd_off(int d0, int ks, int half) { return d0 * 512 + ks * 4096 + half * 2048; }
DI int crow(int r, int hi) { return (r & 3) + 8 * (r >> 2) + 4 * hi; }
DI unsigned cvtpk(float lo, float hi) { unsigned r; asm volatile("v_cvt_pk_bf16_f32 %0, %1, %2" : "=v"(r) : "v"(lo), "v"(hi)); return r; }

struct Cx {
    LAS char* lds; int tid, wid, lane, r32, hi, sr, sc, kws, vst0, vst1, vb0; LAS float* li_l; LAS float* al_l;
};
DI Cx make_cx(LAS unsigned char* lds_) {
    Cx c; c.lds = (LAS char*)lds_; c.tid = tid_fresh(); c.wid = __builtin_amdgcn_readfirstlane(c.tid >> 6); c.lane = c.tid & 63; c.r32 = c.lane & 31; c.hi = c.lane >> 5;
    c.sr = c.tid >> 4; c.sc = (c.tid & 15) * 8; c.kws = KSWZ(c.sr, c.sc * 2); c.vst0 = v_st(c.sr, c.sc); c.vst1 = v_st(32 + c.sr, c.sc);
    c.vb0 = (int)(unsigned)(uintptr_t)(c.lds + L_V) + v_rd_base(c.lane);
    c.li_l = (LAS float*)(c.lds + L_WS) + c.wid * 64; c.al_l = c.li_l + 32;
    return c;
}
struct Stage { bf16x8 k0, k1, v0, v1; float ex; };

DI void qkt(f32x16& p0, f32x16& p1, const LAS char* Kb, int r32, int hi, const bf16x8* qr) {
#pragma unroll
    for (int r = 0; r < 16; ++r) { p0[r] = 0.f; p1[r] = 0.f; }
    const LAS char* kbase = Kb + r32 * 256; const int xs = ((r32 & 15) ^ hi) << 4;
#pragma unroll
    for (int d0 = 0; d0 < 8; ++d0) { const LAS char* a = kbase + ((d0 * 32) ^ xs);
        const bf16x8 b0 = *(const LAS bf16x8*)a, b1 = *(const LAS bf16x8*)(a + 32 * 256);
        p0 = __builtin_amdgcn_mfma_f32_32x32x16_bf16(b0, qr[d0], p0, 0, 0, 0);
        p1 = __builtin_amdgcn_mfma_f32_32x32x16_bf16(b1, qr[d0], p1, 0, 0, 0); }
}
DI void partialSM(f32x16& p0, f32x16& p1, float& m_reg, float& mn, float& alpha) {
    float pmax = p0[0];
#pragma unroll
    for (int r = 1; r < 16; ++r) pmax = fmaxf(pmax, p0[r]);
#pragma unroll
    for (int r = 0; r < 16; ++r) pmax = fmaxf(pmax, p1[r]);
    { auto rr = __builtin_amdgcn_permlane32_swap(__float_as_uint(pmax), __float_as_uint(pmax), false, false);
      pmax = fmaxf(__uint_as_float(rr[0]), __uint_as_float(rr[1])); }
    if (__builtin_expect(__all((pmax - m_reg) * SCALE <= THR), 1)) { mn = m_reg; alpha = 1.f; }
    else { mn = fmaxf(m_reg, pmax); alpha = __builtin_amdgcn_exp2f((m_reg - mn) * C2); m_reg = mn; }
    const float mnL = -mn * C2;
#pragma unroll
    for (int r = 0; r < 16; ++r) p0[r] = fmaf(p0[r], C2, mnL);
#pragma unroll
    for (int r = 0; r < 16; ++r) p1[r] = fmaf(p1[r], C2, mnL);
#pragma unroll
    for (int r = 0; r < 16; ++r) p0[r] = __builtin_amdgcn_exp2f(p0[r]);
}
DI void pack_p(const f32x16& p0, const f32x16& p1, bf16x8& pa0, bf16x8& pa1, bf16x8& pa2, bf16x8& pa3) {
#define PK4(P, B_, OUT) do { unsigned a0 = cvtpk(P[B_+0], P[B_+1]), a1 = cvtpk(P[B_+2], P[B_+3]);                          \
        unsigned b0 = cvtpk(P[B_+4], P[B_+5]), b1 = cvtpk(P[B_+6], P[B_+7]);                                             \
        auto r0 = __builtin_amdgcn_permlane32_swap(a0, b0, false, false); auto r1 = __builtin_amdgcn_permlane32_swap(a1, b1, false, false); \
        v4u w = {r0[0], r1[0], r0[1], r1[1]}; OUT = __builtin_bit_cast(bf16x8, w); } while (0)
    PK4(p0, 0, pa0); PK4(p0, 8, pa1); PK4(p1, 0, pa2); PK4(p1, 8, pa3);
#undef PK4
}
DI void finishSM(f32x16& p0, f32x16& p1, float alpha, float& l_reg, bf16x8& pa0, bf16x8& pa1, bf16x8& pa2, bf16x8& pa3) {
#pragma unroll
    for (int r = 0; r < 16; ++r) p1[r] = __builtin_amdgcn_exp2f(p1[r]);
    float ps = 0;
#pragma unroll
    for (int r = 0; r < 16; ++r) ps += p0[r];
#pragma unroll
    for (int r = 0; r < 16; ++r) ps += p1[r];
    { auto rr = __builtin_amdgcn_permlane32_swap(__float_as_uint(ps), __float_as_uint(ps), false, false);
      ps = __uint_as_float(rr[0]) + __uint_as_float(rr[1]); }
    l_reg = l_reg * alpha + ps;
    pack_p(p0, p1, pa0, pa1, pa2, pa3);
}
DI void pv_tile(f32x16* o, int vb0, bf16x8 pa0, bf16x8 pa1, bf16x8 pa2, bf16x8 pa3) {
#define TRRD(dst, off) asm volatile("ds_read_b64_tr_b16 %0, %1 offset:%2" : "=&v"(dst) : "v"(vb0), "i"(off) : "memory")
#define PV_D0(d0) do { s16x4 l0, l1, l2, l3, h0, h1, h2, h3; constexpr int b_ = v_rd_off(d0, 0, 0); \
        TRRD(l0, b_); TRRD(h0, b_ + 2048); TRRD(l1, b_ + 4096); TRRD(h1, b_ + 6144); TRRD(l2, b_ + 8192); TRRD(h2, b_ + 10240); TRRD(l3, b_ + 12288); TRRD(h3, b_ + 14336); \
        asm volatile("s_waitcnt lgkmcnt(0)" ::: "memory"); SBAR();   \
        o[d0] = __builtin_amdgcn_mfma_f32_32x32x16_bf16(pa0, (bf16x8){l0[0], l0[1], l0[2], l0[3], h0[0], h0[1], h0[2], h0[3]}, o[d0], 0, 0, 0);   \
        o[d0] = __builtin_amdgcn_mfma_f32_32x32x16_bf16(pa1, (bf16x8){l1[0], l1[1], l1[2], l1[3], h1[0], h1[1], h1[2], h1[3]}, o[d0], 0, 0, 0);   \
        o[d0] = __builtin_amdgcn_mfma_f32_32x32x16_bf16(pa2, (bf16x8){l2[0], l2[1], l2[2], l2[3], h2[0], h2[1], h2[2], h2[3]}, o[d0], 0, 0, 0);   \
        o[d0] = __builtin_amdgcn_mfma_f32_32x32x16_bf16(pa3, (bf16x8){l3[0], l3[1], l3[2], l3[3], h3[0], h3[1], h3[2], h3[3]}, o[d0], 0, 0, 0); } while (0)
    PV_D0(0); PV_D0(1); PV_D0(2); PV_D0(3);
#undef PV_D0
#undef TRRD
}
DI void rescale_o(const Cx& c, f32x16* o, float alpha) {
    if (__any(alpha < 1.f)) { if (c.hi == 0) c.al_l[c.r32] = alpha; asm volatile("s_waitcnt lgkmcnt(0)" ::: "memory");
#pragma unroll
        for (int d = 0; d < 4; ++d)
#pragma unroll
            for (int r = 0; r < 16; ++r) o[d][r] *= c.al_l[crow(r, c.hi)];
    }
}
DI void mask_tile(f32x16& p0, f32x16& p1, int dq, unsigned W) {
    const float NEG = -__builtin_inff();
#pragma unroll
    for (int r = 0; r < 16; ++r) { const int cc = (r & 3) + 8 * (r >> 2);
        if ((unsigned)(dq - cc) >= W) p0[r] = NEG;
        if ((unsigned)(dq - cc - 32) >= W) p1[r] = NEG; }
}
DI void kill_tile(f32x16& p0, f32x16& p1) { const float NEG = -__builtin_inff();
#pragma unroll
    for (int r = 0; r < 16; ++r) { p0[r] = NEG; p1[r] = NEG; } }

template <int MODE, class P>
DI void run(const Cx& c, P& prob, const bf16x8* qr, float& m_reg, float& l_reg, f32x16* o) {
    const int nt = prob.ntiles();
    if (nt <= 0) return;
    Stage st;
    { const bf16 *kp, *vp; int kpitch, vpitch; prob.src(0, kp, vp, kpitch, vpitch);
      st.k0 = *(const GAS bf16x8*)(kp + (size_t)c.sr * kpitch + c.sc); st.k1 = *(const GAS bf16x8*)(kp + (size_t)(32 + c.sr) * kpitch + c.sc);
      if (MODE == 0) { st.v0 = *(const GAS bf16x8*)(vp + (size_t)c.sr * vpitch + c.sc); st.v1 = *(const GAS bf16x8*)(vp + (size_t)(32 + c.sr) * vpitch + c.sc); }
      st.ex = prob.extra(0); }
    const float inv_l = (MODE == 1) ? (l_reg > 0.f ? 1.f / l_reg : 0.f) : 0.f;
    for (int t = 0; t < nt; ++t) {
        const int buf = t & 1;
        *(LAS bf16x8*)(c.lds + L_K + buf * SHM_K + c.kws) = st.k0; *(LAS bf16x8*)(c.lds + L_K + buf * SHM_K + c.kws + 32 * 256) = st.k1;
        if (MODE == 0) { *(LAS bf16x8*)(c.lds + L_V + buf * SHM_V + c.vst0) = st.v0; *(LAS bf16x8*)(c.lds + L_V + buf * SHM_V + c.vst1) = st.v1; }
        prob.put_extra(t, buf, st.ex);
        __syncthreads();
        if (t + 1 < nt) { const bf16 *kp, *vp; int kpitch, vpitch; prob.src(t + 1, kp, vp, kpitch, vpitch);
            st.k0 = *(const GAS bf16x8*)(kp + (size_t)c.sr * kpitch + c.sc); st.k1 = *(const GAS bf16x8*)(kp + (size_t)(32 + c.sr) * kpitch + c.sc);
            if (MODE == 0) { st.v0 = *(const GAS bf16x8*)(vp + (size_t)c.sr * vpitch + c.sc); st.v1 = *(const GAS bf16x8*)(vp + (size_t)(32 + c.sr) * vpitch + c.sc); }
            st.ex = prob.extra(t + 1); }
        if (prob.active(t)) {
            f32x16 p0, p1;
            qkt(p0, p1, c.lds + L_K + buf * SHM_K, c.r32, c.hi, qr);
            prob.mask(p0, p1, t, buf);
            if (MODE == 0) {
                float mn, alpha; partialSM(p0, p1, m_reg, mn, alpha);
                rescale_o(c, o, alpha);
                bf16x8 pa0, pa1, pa2, pa3; finishSM(p0, p1, alpha, l_reg, pa0, pa1, pa2, pa3);
                pv_tile(o, c.vb0 + buf * SHM_V, pa0, pa1, pa2, pa3);
            } else {
                const float mnL = -m_reg * C2;
#pragma unroll
                for (int r = 0; r < 16; ++r) { p0[r] = __builtin_amdgcn_exp2f(fmaf(p0[r], C2, mnL)) * inv_l; p1[r] = __builtin_amdgcn_exp2f(fmaf(p1[r], C2, mnL)) * inv_l; }
                prob.post(p0, p1, t, true);
            }
        } else if (MODE == 1) { f32x16 z0, z1; prob.post(z0, z1, t, false); }
    }
    __syncthreads();
}

DI void load_q(bf16x8* qr, const bf16* Q, int pitch, int token, int col, int hi) {
#pragma unroll
    for (int d0 = 0; d0 < 8; ++d0) qr[d0] = *(const GAS bf16x8*)(Q + (size_t)token * pitch + col + d0 * 16 + hi * 8);
}
DI void row_coefs(const Cx& c, float coef, float* rc) {
    if (c.hi == 0) c.li_l[c.r32] = coef; asm volatile("s_waitcnt lgkmcnt(0)" ::: "memory");
#pragma unroll
    for (int r = 0; r < 16; ++r) rc[r] = c.li_l[crow(r, c.hi)];
    asm volatile("s_waitcnt lgkmcnt(0)" ::: "memory");
}
template <bool GQA>
DI void store_o(const Cx& c, const f32x16* o, const float* rc, bf16* O, int tok0  , int col0  ) {
#pragma unroll
    for (int r = 0; r < 16; ++r) { const int rr = crow(r, c.hi);
        const int token = GQA ? tok0 + (rr >> 2) : tok0 + rr; const int col = GQA ? col0 + (rr & 3) * 128 : col0;
#pragma unroll
        for (int d0 = 0; d0 < 4; ++d0) { const float v = o[d0][r] * rc[r]; const float vn = __shfl_xor(v, 1);
            if ((c.r32 & 1) == 0) *(GAS unsigned*)(O + (size_t)token * DM + col + d0 * 32 + c.r32) = cvtpk(v, vn); } }
}

DI void moba_gate_unit(LAS unsigned char* lds_, const bf16* QKV, const bf16* KMH, const bf16* KML, gu32* cnt  , unsigned* list  , int h, int qb) {
    if (qb == 0) return;
    const Cx c = make_cx(lds_);
    const int P0 = qb * 256, token = P0 + c.wid * 32 + c.r32;
    bf16x8 qr[8]; load_q(qr, QKV, NE, token, E_QA + h * 128, c.hi);
    unsigned taken = 0u;
    {
        f32x16 g;
#pragma unroll
        for (int r = 0; r < 16; ++r) g[r] = 0.f;
#pragma unroll
        for (int d0 = 0; d0 < 8; ++d0) { const size_t off = ((size_t)h * 32 + c.r32) * 128 + d0 * 16 + c.hi * 8;
            const bf16x8 kh = *(const GAS bf16x8*)(KMH + off), kl = *(const GAS bf16x8*)(KML + off);
            g = __builtin_amdgcn_mfma_f32_32x32x16_bf16(kh, qr[d0], g, 0, 0, 0); g = __builtin_amdgcn_mfma_f32_32x32x16_bf16(kl, qr[d0], g, 0, 0, 0); }
        const float NEG = -__builtin_inff();
#pragma unroll
        for (int it = 0; it < (BREAK == 6 ? 2 : 3); ++it) { float best = NEG; int bi = 99;
#pragma unroll
            for (int r = 0; r < 16; ++r) { const int b = crow(r, c.hi); const float v = (b < qb && !((taken >> b) & 1u)) ? g[r] : NEG; if (v > best) { best = v; bi = b; } }
            const float ob = __shfl_xor(best, 32); const int obi = __shfl_xor(bi, 32);
            if (ob > best || (ob == best && obi < bi)) { best = ob; bi = obi; }
            if (best > NEG) taken |= 1u << bi; }
    }
    const unsigned lt = (1u << c.r32) - 1u;
    unsigned my_n = 0u;
    for (int j = 0; j < qb; ++j) { const unsigned long long b = __ballot(c.hi == 0 && ((taken >> j) & 1u)); if (c.lane == j) my_n = (unsigned)__popcll(b); }
    unsigned base = 0u;
    if (c.lane < qb && my_n) base = __hip_atomic_fetch_add(cnt + h * 32 + c.lane, my_n, RLX_AGENT);
    for (int j = 0; j < qb; ++j) { const bool sl = c.hi == 0 && ((taken >> j) & 1u); const unsigned m = (unsigned)__ballot(sl); const unsigned bj = __shfl(base, j);
        if (sl) list[((size_t)h * 32 + j) * 8192 + bj + __popc(m & lt)] = (unsigned)token | ((unsigned)__popc(taken & ((1u << j) - 1u)) << 16); }
}
struct BlkProb {
    const bf16* QKV; int h, key0, causal, qlo, qpos, hi; bool wact  ;
    DI int ntiles() const { return 4; }
    DI void src(int t, const bf16*& k, const bf16*& v, int& kp, int& vp) const { const size_t kk = (size_t)(key0 + t * 64); k = QKV + kk * NE + E_KA + h * 128; v = QKV + kk * NE + E_VA + h * 128; kp = NE; vp = NE; }
    DI float extra(int) const { return 0.f; }
    DI void put_extra(int, int, float) const {}
    DI bool active(int t) const { return causal ? (key0 + t * 64 <= qlo + 31) : wact; }
    DI void mask(f32x16& p0, f32x16& p1, int t, int) const { if (causal) { const int kb = key0 + t * 64; if (kb + 63 > qlo) mask_tile(p0, p1, qpos - 4 * hi - kb, 0x7fffffffu); } }
    DI void post(f32x16&, f32x16&, int, bool) const {}
};
DI void moba_blk_unit(LAS unsigned char* lds_, const bf16* QKV, const gu32* cnt, const unsigned* list, bf16* PO, float* PML, int h, int j, int r) {
    const Cx c = make_cx(lds_);
    int token, slot; bool valid = true;
    if (r < 0) { token = j * 256 + c.wid * 32 + c.r32; slot = 3; }
    else { const int n = (int)cnt[h * 32 + j], row = r * 256 + c.wid * 32 + c.r32; valid = row < n;
        const unsigned e = list[((size_t)h * 32 + j) * 8192 + (valid ? row : 0)]; token = (int)(e & 0xffffu); slot = (int)(e >> 16); }
    bf16x8 qr[8]; load_q(qr, QKV, NE, token, E_QA + h * 128, c.hi);
    BlkProb pr; pr.QKV = QKV; pr.h = h; pr.key0 = j * 256; pr.causal = r < 0 ? 1 : 0; pr.qlo = j * 256 + c.wid * 32; pr.qpos = token; pr.hi = c.hi; pr.wact = __any(valid);
    float m_reg = -1e30f, l_reg = 0.f; f32x16 o[4];
#pragma unroll
    for (int d = 0; d < 4; ++d)
#pragma unroll
        for (int q = 0; q < 16; ++q) o[d][q] = 0.f;
    run<0>(c, pr, qr, m_reg, l_reg, o);
    const int dest = valid ? (((h * 8192 + token) << 2) + slot) : -1;
    if (valid && c.hi == 0) { GAS float* ml = (GAS float*)PML + (size_t)dest * 2; ml[0] = m_reg; ml[1] = l_reg; }
    float rc[16]; row_coefs(c, l_reg > 0.f ? 1.f / l_reg : 0.f, rc);
    int dst[16];
    { LAS int* il = (LAS int*)c.li_l; if (c.hi == 0) il[c.r32] = dest; asm volatile("s_waitcnt lgkmcnt(0)" ::: "memory");
#pragma unroll
      for (int q = 0; q < 16; ++q) dst[q] = il[crow(q, c.hi)];
      asm volatile("s_waitcnt lgkmcnt(0)" ::: "memory"); }
#pragma unroll
    for (int q = 0; q < 16; ++q) {
#pragma unroll
        for (int d0 = 0; d0 < 4; ++d0) { const float v = o[d0][q] * rc[q]; const float vn = __shfl_xor(v, 1);
            if ((c.r32 & 1) == 0 && dst[q] >= 0) *(GAS unsigned*)(PO + (size_t)dst[q] * 128 + d0 * 32 + c.r32) = cvtpk(v, vn); } }
}

struct WinProb {
    const bf16* QKV; int pitch, kcol, vcol, t0  , nt, qlo  , qpos, hi; unsigned W;
    DI int ntiles() const { return nt; }
    DI void src(int t, const bf16*& k, const bf16*& v, int& kp, int& vp) const { const size_t key0 = (size_t)(t0 + t) * 64; k = QKV + key0 * pitch + kcol; v = QKV + key0 * pitch + vcol; kp = pitch; vp = pitch; }
    DI float extra(int) const { return 0.f; }
    DI void put_extra(int, int, float) const {}
    DI bool active(int t) const { const int kb = (t0 + t) * 64; return kb <= qlo + 7 && kb + 63 >= qlo - (int)W + 1; }
    DI void mask(f32x16& p0, f32x16& p1, int t, int) const { const int kb = (t0 + t) * 64; if (kb + 63 > qlo || kb <= qlo + 7 - (int)W) mask_tile(p0, p1, qpos - 4 * hi - kb, W); }
    DI void post(f32x16&, f32x16&, int, bool) const {}
};
DI void swa_unit(LAS unsigned char* lds_, const bf16* QKV, const float* sinks, bf16* O, int kvh, int ch) {
    const Cx c = make_cx(lds_);
    const int T0 = ch * 64, token = T0 + c.wid * 8 + (c.r32 >> 2), hq = kvh * 4 + (c.r32 & 3);
    bf16x8 qr[8]; load_q(qr, QKV, NE, token, E_QB + hq * 128, c.hi);
    WinProb pr; pr.QKV = QKV; pr.pitch = NE; pr.kcol = E_KB + kvh * 128; pr.vcol = E_VB + kvh * 128; pr.t0 = ch >= 2 ? ch - 2 : 0; pr.nt = ch + 1 - pr.t0;
    pr.qlo = T0 + c.wid * 8; pr.qpos = token; pr.hi = c.hi; pr.W = 128u;
    float m_reg = sinks[hq] * INV_SCALE, l_reg = 1.f; f32x16 o[4];
#pragma unroll
    for (int d = 0; d < 4; ++d)
#pragma unroll
        for (int r = 0; r < 16; ++r) o[d][r] = 0.f;
    run<0>(c, pr, qr, m_reg, l_reg, o);
    float rc[16]; row_coefs(c, 1.f / l_reg, rc);
    store_o<true>(c, o, rc, O, T0 + c.wid * 8, 1024 + kvh * 512);
}

struct FoxProb {
    const bf16* QKV; const float* cum  ; float cb; int h, qb, qlo, qpos, hi, tid, a0  ; const LAS float* bias;
    DI int ntiles() const { return 4 * (qb + 1) - a0; }
    DI void src(int t, const bf16*& k, const bf16*& v, int& kp, int& vp) const { const size_t key0 = (size_t)(a0 + t) * 64; k = QKV + key0 * NO + O_KC + h * 128; v = QKV + key0 * NO + O_VC + h * 128; kp = NO; vp = NO; }
    DI float extra(int t) const { return tid < 64 ? cum[(a0 + t) * 64 + tid] : 0.f; }
    DI void put_extra(int, int buf, float ex) const { if (tid < 64) ((LAS float*)bias)[buf * 64 + tid] = (cb - ex) * INV_SCALE; }
    DI bool active(int t) const { return (a0 + t) * 64 <= qlo + 31; }
    DI void mask(f32x16& p0, f32x16& p1, int t, int buf) const {
        const LAS float* b = bias + buf * 64 + 4 * hi;
#pragma unroll
        for (int g = 0; g < 4; ++g) { const f32x4 b0 = *(const LAS f32x4*)(b + 8 * g), b1 = *(const LAS f32x4*)(b + 32 + 8 * g);
#pragma unroll
            for (int e = 0; e < 4; ++e) { p0[4 * g + e] += b0[e]; p1[4 * g + e] += b1[e]; } }
        const int kb = (a0 + t) * 64; if (kb + 63 > qlo) mask_tile(p0, p1, qpos + (BREAK == 8 ? 1 : 0) - 4 * hi - kb, 0x7fffffffu);
    }
    DI void post(f32x16&, f32x16&, int, bool) const {}
};
DI void fox_unit(LAS unsigned char* lds_, const bf16* QKV, const float* CUM, const float* FOXN, bf16* O, int h, int qb) {
    const Cx c = make_cx(lds_);
    const int P0 = qb * 256, token = P0 + c.wid * 32 + c.r32;
    bf16x8 qr[8]; load_q(qr, QKV, NO, token, O_QC + h * 128, c.hi);
    FoxProb pr; pr.QKV = QKV; pr.cum = CUM + (size_t)h * S; pr.cb = pr.cum[P0]; pr.h = h; pr.qb = qb; pr.qlo = P0 + c.wid * 32; pr.qpos = token; pr.hi = c.hi; pr.tid = c.tid;
    pr.bias = (const LAS float*)(c.lds + L_BIAS);
    {
        LAS int* a0w = (LAS int*)(c.lds + L_MISC);
        float dl = 0.f;
#pragma unroll
        for (int d0 = 0; d0 < 8; ++d0) { const v4u kw = *(const GAS v4u*)(QKV + (size_t)token * NO + O_KC + h * 128 + d0 * 16 + c.hi * 8); const v4u qw = __builtin_bit_cast(v4u, qr[d0]);
            dl += bf2f(qw.x & 0xffffu) * bf2f(kw.x & 0xffffu) + bf2f(qw.x >> 16) * bf2f(kw.x >> 16) + bf2f(qw.y & 0xffffu) * bf2f(kw.y & 0xffffu) + bf2f(qw.y >> 16) * bf2f(kw.y >> 16);
            dl += bf2f(qw.z & 0xffffu) * bf2f(kw.z & 0xffffu) + bf2f(qw.z >> 16) * bf2f(kw.z >> 16) + bf2f(qw.w & 0xffffu) * bf2f(kw.w & 0xffffu) + bf2f(qw.w >> 16) * bf2f(kw.w >> 16); }
        dl = (dl + __shfl_xor(dl, 32)) * SCALE;
#pragma unroll
        for (int ofs = 1; ofs < 32; ofs <<= 1) dl = fminf(dl, __shfl_xor(dl, ofs));
        LAS float* dmin = (LAS float*)(c.lds + L_MISC) + 16;
        if (c.lane == 0) dmin[c.wid] = dl;
        if (c.tid == 0) *a0w = 4 * qb;
        __syncthreads();
        float dlmin = dmin[0];
#pragma unroll
        for (int w = 1; w < NWAVES; ++w) dlmin = fminf(dlmin, dmin[w]);
        const float Bqk = FOXN[h * 2] * FOXN[h * 2 + 1] * SCALE * 1.01f + 1.f;
        const float thr = 110.f + Bqk - fmaxf(fminf(dlmin, Bqk), -Bqk) + 1.f;
        if (c.tid < 4 * qb && pr.cb - pr.cum[c.tid * 64 + 63] >= -thr) __hip_atomic_fetch_min(a0w, c.tid, __ATOMIC_RELAXED, __HIP_MEMORY_SCOPE_WORKGROUP);
        __syncthreads();
        pr.a0 = FOX_SKIP ? *a0w : 0;
        __syncthreads();
    }
    float m_reg = -1e30f, l_reg = 0.f; f32x16 o[4];
#pragma unroll
    for (int d = 0; d < 4; ++d)
#pragma unroll
        for (int r = 0; r < 16; ++r) o[d][r] = 0.f;
    run<0>(c, pr, qr, m_reg, l_reg, o);
    float rc[16]; row_coefs(c, l_reg > 0.f ? 1.f / l_reg : 0.f, rc);
    store_o<false>(c, o, rc, O, P0 + c.wid * 32, h * 128);
}

struct CmpProb {
    const bf16* KC; const bf16* VC; int kvh, nt, nmax  , wnmax  , hi, r32, wid; LAS float* imp; float carry;
    DI int ntiles() const { return nt; }
    DI void src(int t, const bf16*& k, const bf16*& v, int& kp, int& vp) const { k = KC + (size_t)t * 64 * 256 + kvh * 128; v = VC + (size_t)t * 64 * 256 + kvh * 128; kp = 256; vp = 256; }
    DI float extra(int) const { return 0.f; }
    DI void put_extra(int, int, float) const {}
    DI bool active(int t) const { return t * 64 <= wnmax; }
    DI void mask(f32x16& p0, f32x16& p1, int t, int) const { mask_tile(p0, p1, nmax - 4 * hi - t * 64, 0x7fffffffu); }
    DI void post(f32x16& p0, f32x16& p1, int t, bool act) {
        if (!act) { carry = 0.f; return; }
        float G[8], L[8];
#pragma unroll
        for (int q = 0; q < 4; ++q) { G[q] = (p0[4 * q] + p0[4 * q + 1]) + (p0[4 * q + 2] + p0[4 * q + 3]); L[q] = p0[4 * q + 3];
                                      G[4 + q] = (p1[4 * q] + p1[4 * q + 1]) + (p1[4 * q + 2] + p1[4 * q + 3]); L[4 + q] = p1[4 * q + 3]; }
        float PL[8];
#pragma unroll
        for (int q = 0; q < 8; ++q) PL[q] = __shfl_xor(L[q], 32);
        float v[8];
        if (hi) {
#pragma unroll
            for (int q = 0; q < 8; ++q) v[q] = G[q] + PL[q];
        } else {
            v[0] = G[0] + carry;
#pragma unroll
            for (int q = 1; q < 8; ++q) v[q] = G[q] + PL[q - 1];
            carry = PL[7];
        }
#pragma unroll
        for (int q = 0; q < 8; ++q) { float s = v[q]; s += __shfl_xor(s, 1); s += __shfl_xor(s, 2);
            if ((r32 & 3) == 0) imp[(wid * 8 + (r32 >> 2)) * IMP_STRIDE + 16 * t + 2 * q + hi] = s; }
    }
};
struct SlcProb {
    const bf16* QKV; int kvh, ch, qlo, qpos, hi; const LAS unsigned* sw;
    DI int ntiles() const { return ch + 1; }
    DI void src(int t, const bf16*& k, const bf16*& v, int& kp, int& vp) const { const size_t key0 = (size_t)t * 64; k = QKV + key0 * NO + O_KSLC + kvh * 128; v = QKV + key0 * NO + O_VSLC + kvh * 128; kp = NO; vp = NO; }
    DI float extra(int) const { return 0.f; }
    DI void put_extra(int, int, float) const {}
    DI bool sel(int t) const { return (sw[t >> 5] >> (t & 31)) & 1u; }
    DI bool active(int t) const { return __any(sel(t)); }
    DI void mask(f32x16& p0, f32x16& p1, int t, int) const { if (!sel(t)) kill_tile(p0, p1); else if (t == ch) mask_tile(p0, p1, qpos - 4 * hi - t * 64, 0x7fffffffu); }
    DI void post(f32x16&, f32x16&, int, bool) const {}
};
DI float sigmoid_f(float v) { return 1.f / (1.f + expf(-v)); }
#define ZERO_O(o) do { _Pragma("unroll") for (int d_ = 0; d_ < 4; ++d_) _Pragma("unroll") for (int r_ = 0; r_ < 16; ++r_) o[d_][r_] = 0.f; } while (0)
DI void nsa_unit(LAS unsigned char* lds_, const bf16* QKV, const bf16* KC, const bf16* VC, const float* FG, bf16* O, float* scr  , int kvh, int ch) {
    const int T0 = ch * 64;
    LAS float* imp = (LAS float*)((LAS char*)lds_ + L_IMP);
    LAS unsigned short* sel16 = (LAS unsigned short*)((LAS char*)lds_ + L_SEL);
    { const int t0_ = tid_fresh(); for (int e = t0_; e < 64 * IMP_STRIDE; e += NWAVES * 64) imp[e] = 0.f; }
    for (int rep_ = 0; rep_ < ((NSA_DUP & 1) ? 2 : 1); ++rep_) {
        const Cx c = make_cx(lds_); const int tl = c.wid * 8 + (c.r32 >> 2), hq = kvh * 4 + (c.r32 & 3);
        int token = T0 + tl;
        bf16x8 qr[8]; load_q(qr, QKV, NO, token, O_QD + hq * 128, c.hi);
        f32x16 o[4]; float rc[16];
        CmpProb pr; pr.KC = KC; pr.VC = VC; pr.kvh = kvh; pr.hi = c.hi; pr.r32 = c.r32; pr.wid = c.wid; pr.imp = imp; pr.carry = 0.f;
        const int nmax_chunk = (T0 + 63 - 31) >> 4;
        pr.nt = nmax_chunk / 64 + 1; pr.nmax = (token - 31) >> 4; pr.wnmax = (T0 + c.wid * 8 + 7 - 31) >> 4;
        float m_reg = -1e30f, l_reg = 0.f; ZERO_O(o);
        run<0>(c, pr, qr, m_reg, l_reg, o);
        const float g_cmp = sigmoid_f(FG[(size_t)(8 + hq * 3 + 0) * S + token]);
        row_coefs(c, l_reg > 0.f ? g_cmp / l_reg : 0.f, rc);
        { GAS f32x4* sp = (GAS f32x4*)(scr + (size_t)c.tid * 64);
#pragma unroll
        for (int d = 0; d < 4; ++d)
#pragma unroll
            for (int q = 0; q < 4; ++q) sp[d * 4 + q] = (f32x4){o[d][4 * q] * rc[4 * q], o[d][4 * q + 1] * rc[4 * q + 1], o[d][4 * q + 2] * rc[4 * q + 2], o[d][4 * q + 3] * rc[4 * q + 3]}; }
        pr.carry = 0.f;
        run<1>(c, pr, qr, m_reg, l_reg, o);
    }
    for (int rep_ = 0; rep_ < ((NSA_DUP & 2) ? 2 : 1); ++rep_) {
        const int tf_ = tid_fresh(); const int tk = tf_ >> 3, q = tf_ & 7;
        const LAS float* row = imp + tk * IMP_STRIDE;
        int kv[16], rank[16]; const int q16 = 16 * q;
#pragma unroll
        for (int e = 0; e < 16; ++e) { const int j = q16 + e; int k = __float_as_int(row[j]); if (j == 0 || j == ch || j == ch - 1) k = 0x7f800000; if (j > ch) k = -1; kv[e] = k; rank[e] = 0; }
        for (int i0 = 0; i0 <= ch; i0 += 4) { const f32x4 xr = *(const LAS f32x4*)(row + i0);
#pragma unroll
            for (int u = 0; u < 4; ++u) { const int i = i0 + u; int k = __float_as_int(xr[u]); if (i == 0 || i == ch || i == ch - 1) k = 0x7f800000; if (i > ch) k = -1; k += (i < q16) ? 1 : 0;
#pragma unroll
                for (int e = 0; e < 16; ++e) rank[e] += (k > kv[e]) ? 1 : 0; } }
#pragma unroll
        for (int e2 = 1; e2 < 16; ++e2)
#pragma unroll
            for (int e1 = 0; e1 < e2; ++e1) rank[e2] += (kv[e1] == kv[e2]) ? 1 : 0;
        unsigned m = 0u;
#pragma unroll
        for (int e = 0; e < 16; ++e) { const int j = 16 * q + e; if (j <= ch && rank[e] < (BREAK == 9 ? 15 : 16)) m |= 1u << e; }
        sel16[tk * 8 + q] = (unsigned short)m;
    }
    __syncthreads();
    for (int rep_ = 0; rep_ < ((NSA_DUP & 4) ? 2 : 1); ++rep_) {
        const Cx c = make_cx(lds_); const int tl = c.wid * 8 + (c.r32 >> 2), hq = kvh * 4 + (c.r32 & 3);
        int token = T0 + tl;
        bf16x8 qr[8]; load_q(qr, QKV, NO, token, O_QD + hq * 128, c.hi);
        f32x16 o[4]; float rc[16];
        SlcProb pr; pr.QKV = QKV; pr.kvh = kvh; pr.ch = ch; pr.qlo = T0 + c.wid * 8; pr.qpos = token; pr.hi = c.hi;
        pr.sw = (const LAS unsigned*)(c.lds + L_SEL) + tl * 4;
        float m_reg = -1e30f, l_reg = 0.f; ZERO_O(o);
        run<0>(c, pr, qr, m_reg, l_reg, o);
        const float g_slc = sigmoid_f(FG[(size_t)(8 + hq * 3 + 1) * S + token]);
        row_coefs(c, l_reg > 0.f ? g_slc / l_reg : 0.f, rc);
        { GAS f32x4* sp = (GAS f32x4*)(scr + 32768 + (size_t)c.tid * 64);
#pragma unroll
        for (int d = 0; d < 4; ++d)
#pragma unroll
            for (int q = 0; q < 4; ++q) sp[d * 4 + q] = (f32x4){o[d][4 * q] * rc[4 * q], o[d][4 * q + 1] * rc[4 * q + 1], o[d][4 * q + 2] * rc[4 * q + 2], o[d][4 * q + 3] * rc[4 * q + 3]}; }
    }
    for (int rep_ = 0; rep_ < ((NSA_DUP & 8) ? 2 : 1); ++rep_) {
        const Cx c = make_cx(lds_); const int tl = c.wid * 8 + (c.r32 >> 2), hq = kvh * 4 + (c.r32 & 3);
        int token = T0 + tl;
        bf16x8 qr[8]; load_q(qr, QKV, NO, token, O_QD + hq * 128, c.hi);
        f32x16 o[4]; float rc[16];
        WinProb pr; pr.QKV = QKV; pr.pitch = NO; pr.kcol = O_KWIN + kvh * 128; pr.vcol = O_VWIN + kvh * 128; pr.t0 = ch >= 8 ? ch - 8 : 0; pr.nt = ch + 1 - pr.t0;
        pr.qlo = T0 + c.wid * 8; pr.qpos = token; pr.hi = c.hi; pr.W = 512u;
        float m_reg = -1e30f, l_reg = 0.f; ZERO_O(o);
        run<0>(c, pr, qr, m_reg, l_reg, o);
        const float g_win = sigmoid_f(FG[(size_t)(8 + hq * 3 + 2) * S + token]);
        row_coefs(c, l_reg > 0.f ? g_win / l_reg : 0.f, rc);
        { const GAS f32x4* s0 = (const GAS f32x4*)(scr + (size_t)c.tid * 64); const GAS f32x4* s1 = (const GAS f32x4*)(scr + 32768 + (size_t)c.tid * 64);
#pragma unroll
        for (int d = 0; d < 4; ++d) {
#pragma unroll
            for (int q = 0; q < 4; ++q) { const f32x4 x = s0[d * 4 + q] + s1[d * 4 + q];
#pragma unroll
                for (int e = 0; e < 4; ++e) o[d][4 * q + e] = o[d][4 * q + e] * rc[4 * q + e] + x[e]; }
            asm volatile("" ::: "memory"); } }
#pragma unroll
        for (int r = 0; r < 16; ++r) rc[r] = 1.f;
        store_o<true>(c, o, rc, O, T0 + c.wid * 8, 1024 + kvh * 512);
    }
}
}

#if defined(CHECK) && CHECK
namespace chk {
constexpr int CW_CHK = 12288;
DI float wmax(float v) {
#pragma unroll
    for (int o = 1; o < 64; o <<= 1) v = fmaxf(v, __shfl_xor(v, o));
    return v; }
DI float wsum(float v) {
#pragma unroll
    for (int o = 1; o < 64; o <<= 1) v += __shfl_xor(v, o);
    return v; }
DI float ldbf(const bf16* p) { return bf2f((unsigned)*p); }
DI int sample_token(int i) {
    const int fixed[40] = {0, 1, 2, 15, 16, 30, 31, 32, 46, 47, 48, 63, 64, 65, 95, 126, 127, 128, 129, 191, 255, 256, 257, 300, 511, 512, 513, 767, 1023, 1024, 1025, 2047, 2048, 4095, 4096, 4097, 6000, 8000, 8190, 8191};
    if (i < 40) return fixed[i];
    return (int)(((unsigned)i * 2654435761u) >> 19) & 8191; }
DI void report(gu32* ctl, int id, bool bad, int lane) { if (bad && lane == 0) __hip_atomic_fetch_add(ctl + CW_CHK + id, 1u, RLX_AGENT); }

DI float dot128(const unsigned* qp, const bf16* krow) {
    float acc = 0.f;
#pragma unroll
    for (int i = 0; i < 16; ++i) { const v4u w = *(const GAS v4u*)(krow + 8 * i);
        acc += bf2f(qp[4 * i] & 0xffffu) * bf2f(w.x & 0xffffu) + bf2f(qp[4 * i] >> 16) * bf2f(w.x >> 16);
        acc += bf2f(qp[4 * i + 1] & 0xffffu) * bf2f(w.y & 0xffffu) + bf2f(qp[4 * i + 1] >> 16) * bf2f(w.y >> 16);
        acc += bf2f(qp[4 * i + 2] & 0xffffu) * bf2f(w.z & 0xffffu) + bf2f(qp[4 * i + 2] >> 16) * bf2f(w.z >> 16);
        acc += bf2f(qp[4 * i + 3] & 0xffffu) * bf2f(w.w & 0xffffu) + bf2f(qp[4 * i + 3] >> 16) * bf2f(w.w >> 16); }
    return acc; }
template <class Vis>
DI void naive_attn(const unsigned* qp, const bf16* K, int kpitch, const bf16* V, int vpitch, int s_lo, int s_hi, Vis vis, float sink, int lane, float& o0, float& o1) {
    const float NEG = -__builtin_inff();
    float m = sink;
    for (int s0 = s_lo; s0 <= s_hi; s0 += 64) { const int s = s0 + lane; float lg = NEG;
        if (s <= s_hi) { const float b = vis(s); if (b > NEG) lg = dot128(qp, K + (size_t)s * kpitch) * att::SCALE + b; }
        m = fmaxf(m, wmax(lg)); }
    float l = 0.f, a0 = 0.f, a1 = 0.f;
    if (m > NEG) {
        if (sink > NEG) l = expf(sink - m);
        for (int s0 = s_lo; s0 <= s_hi; s0 += 64) { const int s = s0 + lane; float p = 0.f;
            if (s <= s_hi) { const float b = vis(s); if (b > NEG) p = expf(dot128(qp, K + (size_t)s * kpitch) * att::SCALE + b - m); }
            l += wsum(p);
            const int nk = (s_hi - s0 + 1) < 64 ? (s_hi - s0 + 1) : 64;
            for (int k = 0; k < nk; ++k) { const float pk = __shfl(p, k); if (pk != 0.f) { const unsigned w = *(const GAS unsigned*)(V + (size_t)(s0 + k) * vpitch + 2 * lane); a0 += pk * bf2f(w & 0xffffu); a1 += pk * bf2f(w >> 16); } } }
    }
    const float inv = l > 0.f ? 1.f / l : 0.f; o0 = a0 * inv; o1 = a1 * inv; }
DI void load_qp(unsigned* qp, const bf16* qrow) {
#pragma unroll
    for (int i = 0; i < 16; ++i) { const v4u w = *(const GAS v4u*)(qrow + 8 * i); qp[4 * i] = w.x; qp[4 * i + 1] = w.y; qp[4 * i + 2] = w.z; qp[4 * i + 3] = w.w; } }
DI bool cmp_out(float o0, float o1, const bf16* orow, int lane) {
    const unsigned w = *(const GAS unsigned*)(orow + 2 * lane); const float f0 = bf2f(w & 0xffffu), f1 = bf2f(w >> 16);
    const float d = wmax(fmaxf(fabsf(f0 - o0), fabsf(f1 - o1))), sc = wmax(fmaxf(fabsf(o0), fabsf(o1)));
    return !(d <= 0.012f * sc + 2e-5f); }

__global__ void __launch_bounds__(256) chk_inproj(Args a, int l) {
    const int lane = threadIdx.x & 63, gw = (blockIdx.x * 256 + threadIdx.x) >> 6, nw = gridDim.x * 4; const bool odd = l & 1; const int j = l >> 1;
    gu32* ctl = (gu32*)(a.ws + WS_CTL); const bf16* QKV = (const bf16*)(a.ws + WS_QKV); const float* FG = (const float*)(a.ws + WS_FG);
    const int N = odd ? NO : NE, NS = odd ? NO_SRC : NE; const float* W = odd ? a.odd_w_in + (size_t)j * DM * NO_SRC : a.even_w_in + (size_t)j * DM * NE;
    for (int smp = gw; smp < 6000; smp += nw) {
        const int t = sample_token(smp % 97), nd = (int)(((unsigned)smp * 2246822519u) >> 8) % (odd ? 5664 : NE);
        const int sec_rope = odd ? ((nd >= O_QD && nd < O_VCMP) || (nd >= O_KSLC && nd < O_VSLC) || (nd >= O_KWIN && nd < O_VWIN)) : (nd < E_VA || (nd >= E_QB && nd < E_VB));
        const int d = nd & 127, ndp = sec_rope ? (d < 64 ? nd + 64 : nd - 64) : nd;
        const int sc0 = odd ? odd_src_col(nd) : nd, sc1 = odd ? odd_src_col(ndp) : ndp;
        const bf16* xr = (const bf16*)(a.ws + WS_H) + (size_t)t * DM; const float* mods = (const float*)(a.ws + WS_MODS) + (size_t)l * 6 * DM;
        float sq = 0.f; for (int k = lane; k < DM; k += 64) sq += ldbf(xr + k) * ldbf(xr + k);
        const float rstd = 1.f / sqrtf(wsum(sq) * (1.f / DM) + NORM_EPS);
        float s0 = 0.f, s1 = 0.f;
        for (int k = lane; k < DM; k += 64) { const float h = ldbf(xr + k) * rstd * mods[DM + k] + mods[k]; s0 += h * W[(size_t)k * NS + sc0]; s1 += h * W[(size_t)k * NS + sc1]; }
        s0 = wsum(s0); s1 = wsum(s1);
        float ref = s0;
        if (sec_rope) { const int dd = d & 63; const float inv = 1.0f / powf(10000.0f, (float)dd / 64.0f); const float ang = (float)t * inv; const float cv = cosf(ang), sv = sinf(ang);
            ref = (d < 64) ? s0 * cv - s1 * sv : s1 * sv + s0 * cv; }
        float got;
        if (odd && nd >= O_FG) got = FG[(size_t)(nd - O_FG) * S + t]; else got = ldbf(QKV + (size_t)t * N + nd);
        report(ctl, 1 + (odd ? 1 : 0), !(fabsf(got - ref) <= 0.03f * (fabsf(ref) + 0.3f)), lane);
    }
}
__global__ void __launch_bounds__(256) chk_prep(Args a, int l) {
    const int lane = threadIdx.x & 63, gw = (blockIdx.x * 256 + threadIdx.x) >> 6, nw = gridDim.x * 4; const bool odd = l & 1; const int j = l >> 1;
    gu32* ctl = (gu32*)(a.ws + WS_CTL); const bf16* QKV = (const bf16*)(a.ws + WS_QKV);
    if (!odd) {
        const bf16* KMH = (const bf16*)(a.ws + WS_KMH); const bf16* KML = (const bf16*)(a.ws + WS_KML);
        for (int u = gw; u < 256; u += nw) { const int h = u >> 5, blk = u & 31; float s0 = 0.f, s1 = 0.f;
            for (int k = 0; k < 256; ++k) { const unsigned w = *(const GAS unsigned*)(QKV + (size_t)(blk * 256 + k) * NE + E_KA + h * 128 + 2 * lane); s0 += bf2f(w & 0xffffu); s1 += bf2f(w >> 16); }
            s0 *= (1.f / 256.f); s1 *= (1.f / 256.f);
            const float g0 = ldbf(KMH + (size_t)u * 128 + 2 * lane) + ldbf(KML + (size_t)u * 128 + 2 * lane), g1 = ldbf(KMH + (size_t)u * 128 + 2 * lane + 1) + ldbf(KML + (size_t)u * 128 + 2 * lane + 1);
            const float dd = wmax(fmaxf(fabsf(g0 - s0), fabsf(g1 - s1)));
            report(ctl, 3, !(dd <= 3e-5f), lane); }
    } else {
        const float* FG = (const float*)(a.ws + WS_FG); const float* CUM = (const float*)(a.ws + WS_CUM);
        if (gw < 8) { const int h = gw;
            bool bad = false;
            if (lane == 0) { double run = 0.0; const float fb = a.fox_forget_b[j * 8 + h];
                for (int t = 0; t < S; ++t) { const double x = (double)FG[(size_t)h * S + t] + (double)fb; run += (x < 0 ? x - log1p(exp(x)) : -log1p(exp(-x)));
                    if (!(fabs((double)CUM[(size_t)h * S + t] - run) <= 2e-3 + 1e-5 * fabs(run))) bad = true; } }
            report(ctl, 4, __any(bad), lane); }
        for (int smp = gw; smp < 8 + 600; smp += nw) { if (smp < 8) continue;
            const int q = smp - 8, kind = q & 1, hd = (q >> 1) & 1, n = (q < 40) ? (q < 20 ? (q >> 2) : 510 - ((q - 20) >> 2)) : (int)(((unsigned)q * 2654435761u) >> 20) % NCMP;
            const int srccol = (kind ? O_VCMP : O_KCMP) + hd * 128;
            const float* pos = (kind ? a.nsa_v_pos : a.nsa_k_pos) + (size_t)j * 32 * 128; const float* w1 = (kind ? a.nsa_v_w1 : a.nsa_k_w1) + (size_t)j * 4096 * 128; const float* w2 = (kind ? a.nsa_v_w2 : a.nsa_k_w2) + (size_t)j * 128 * 128;
            float h0 = 0.f, h1 = 0.f;
            for (int k = 0; k < 4096; ++k) { const int ll = k >> 7, d = k & 127; const float x = ldbf(QKV + (size_t)(16 * n + ll) * NO + srccol + d) + pos[ll * 128 + d]; h0 += x * w1[(size_t)k * 128 + lane]; h1 += x * w1[(size_t)k * 128 + lane + 64]; }
            h0 = gelu_tanh_f(h0); h1 = gelu_tanh_f(h1);
            float o0 = 0.f, o1 = 0.f;
            for (int c = 0; c < 128; ++c) { const float hv = __shfl(c < 64 ? h0 : h1, c & 63); o0 += hv * w2[c * 128 + lane]; o1 += hv * w2[c * 128 + lane + 64]; }
            const bf16* dst = (const bf16*)(a.ws + (kind ? WS_VC : WS_KC)) + (size_t)n * 256 + hd * 128;
            const float f0 = ldbf(dst + lane), f1 = ldbf(dst + lane + 64);
            const float dd = wmax(fmaxf(fabsf(f0 - o0), fabsf(f1 - o1))), sc = wmax(fmaxf(fabsf(o0), fabsf(o1)));
            report(ctl, 5, !(dd <= 0.03f * sc + 1e-3f), lane); }
    }
}
__global__ void __launch_bounds__(256) chk_attn(Args a, int l) {
    __shared__ float imp_s[4][128]; __shared__ unsigned sel_s[4][4];
    const int lane = threadIdx.x & 63, wv = threadIdx.x >> 6, gw = (blockIdx.x * 256 + threadIdx.x) >> 6, nw = gridDim.x * 4; const bool odd = l & 1; const int j = l >> 1;
    gu32* ctl = (gu32*)(a.ws + WS_CTL); const bf16* QKV = (const bf16*)(a.ws + WS_QKV); const bf16* OB = (const bf16*)(a.ws + WS_O);
    const float NEG = -__builtin_inff();
    unsigned qp[64];
    if (!odd) {
        const bf16* KMH = (const bf16*)(a.ws + WS_KMH); const bf16* KML = (const bf16*)(a.ws + WS_KML);
        for (int smp = gw; smp < 1600; smp += nw) {
            const int t = sample_token(smp >> 3), h = smp & 7;
            {
                load_qp(qp, QKV + (size_t)t * NE + E_QA + h * 128);
                const int own = t >> 8;
                float g = NEG;
                if (lane < own) g = dot128(qp, KMH + ((size_t)h * 32 + lane) * 128) + dot128(qp, KML + ((size_t)h * 32 + lane) * 128);
                int rank = 0;
                for (int i = 0; i < 32; ++i) { const float gi = __shfl(g, i); rank += (gi > g || (gi == g && i < lane)) ? 1 : 0; }
                const unsigned long long bal = __ballot(lane < own && rank < 3);
                const unsigned selm = (unsigned)bal;
                float o0, o1;
                naive_attn(qp, QKV + E_KA + h * 128, NE, QKV + E_VA + h * 128, NE, 0, t, [&](int s) { const int b = s >> 8; return (b == own || ((selm >> b) & 1u)) ? 0.f : NEG; }, NEG, lane, o0, o1);
                report(ctl, 6, cmp_out(o0, o1, OB + (size_t)t * DM + h * 128, lane), lane);
            }
            {
                load_qp(qp, QKV + (size_t)t * NE + E_QB + h * 128);
                float o0, o1; const int lo = t - 127 > 0 ? t - 127 : 0;
                naive_attn(qp, QKV + E_KB + (h >> 2) * 128, NE, QKV + E_VB + (h >> 2) * 128, NE, lo, t, [&](int) { return 0.f; }, a.even_sinks[j * 8 + h], lane, o0, o1);
                report(ctl, 7, cmp_out(o0, o1, OB + (size_t)t * DM + 1024 + h * 128, lane), lane);
            }
        }
    } else {
        const float* CUM = (const float*)(a.ws + WS_CUM); const float* FG = (const float*)(a.ws + WS_FG);
        const bf16* KC = (const bf16*)(a.ws + WS_KC); const bf16* VC = (const bf16*)(a.ws + WS_VC);
        for (int smp = gw; smp < 1600; smp += nw) {
            const int t = sample_token(smp >> 3), h = smp & 7;
            {
                load_qp(qp, QKV + (size_t)t * NO + O_QC + h * 128);
                const float* ch = CUM + (size_t)h * S; const float ct = ch[t];
                float o0, o1;
                naive_attn(qp, QKV + O_KC + h * 128, NO, QKV + O_VC + h * 128, NO, 0, t, [&](int s) { return ct - ch[s]; }, NEG, lane, o0, o1);
                report(ctl, 8, cmp_out(o0, o1, OB + (size_t)t * DM + h * 128, lane), lane);
            }
            {
                const int kvh = h >> 2, cur = t >> 6, nmax = (t - 31) >> 4;
                for (int i = lane; i < 128; i += 64) imp_s[wv][i] = 0.f;
                __builtin_amdgcn_wave_barrier();
                for (int g = 0; g < 4; ++g) {
                    load_qp(qp, QKV + (size_t)t * NO + O_QD + (kvh * 4 + g) * 128);
                    float lg[8]; float m = NEG;
#pragma unroll
                    for (int i = 0; i < 8; ++i) { const int n = lane + 64 * i; lg[i] = (n <= nmax) ? dot128(qp, KC + (size_t)n * 256 + kvh * 128) * att::SCALE : NEG; m = fmaxf(m, lg[i]); }
                    m = wmax(m);
                    if (m > NEG) { float ls = 0.f;
#pragma unroll
                        for (int i = 0; i < 8; ++i) { lg[i] = (lg[i] > NEG) ? expf(lg[i] - m) : 0.f; ls += lg[i]; }
                        ls = wsum(ls);
#pragma unroll
                        for (int i = 0; i < 8; ++i) { const int n = lane + 64 * i; const float p = lg[i] / ls;
                            if (p != 0.f) { atomicAdd(&imp_s[wv][n >> 2], p); if ((n & 3) == 3 && (n >> 2) + 1 < 128) atomicAdd(&imp_s[wv][(n >> 2) + 1], p); } } }
                }
                __builtin_amdgcn_wave_barrier();
                asm volatile("s_waitcnt lgkmcnt(0)" ::: "memory");
                float v0, v1; { const int j0 = lane, j1 = lane + 64; v0 = imp_s[wv][j0]; v1 = imp_s[wv][j1];
                    if (j0 == 0 || j0 == cur || j0 == cur - 1) v0 = __builtin_inff(); if (j0 > cur) v0 = NEG;
                    if (j1 == 0 || j1 == cur || j1 == cur - 1) v1 = __builtin_inff(); if (j1 > cur) v1 = NEG; }
                int r0 = 0, r1 = 0;
                for (int i = 0; i < 128; ++i) { const float x = __shfl(i < 64 ? v0 : v1, i & 63); r0 += (x > v0 || (x == v0 && i < lane)) ? 1 : 0; r1 += (x > v1 || (x == v1 && i < lane + 64)) ? 1 : 0; }
                const unsigned long long b0 = __ballot(r0 < 16 && lane <= cur), b1 = __ballot(r1 < 16 && lane + 64 <= cur);
                if (lane == 0) { sel_s[wv][0] = (unsigned)b0; sel_s[wv][1] = (unsigned)(b0 >> 32); sel_s[wv][2] = (unsigned)b1; sel_s[wv][3] = (unsigned)(b1 >> 32); }
                __builtin_amdgcn_wave_barrier();
                asm volatile("s_waitcnt lgkmcnt(0)" ::: "memory");
                const unsigned m0 = sel_s[wv][0], m1 = sel_s[wv][1], m2 = sel_s[wv][2], m3 = sel_s[wv][3];
                load_qp(qp, QKV + (size_t)t * NO + O_QD + h * 128);
                float c0, c1, s0, s1, w0, w1;
                naive_attn(qp, KC + kvh * 128, 256, VC + kvh * 128, 256, 0, nmax, [&](int) { return 0.f; }, NEG, lane, c0, c1);
                naive_attn(qp, QKV + O_KSLC + kvh * 128, NO, QKV + O_VSLC + kvh * 128, NO, 0, t, [&](int s) { const int b = s >> 6; const unsigned mm = (b < 32) ? m0 : (b < 64 ? m1 : (b < 96 ? m2 : m3)); return ((mm >> (b & 31)) & 1u) ? 0.f : NEG; }, NEG, lane, s0, s1);
                const int lo = t - 511 > 0 ? t - 511 : 0;
                naive_attn(qp, QKV + O_KWIN + kvh * 128, NO, QKV + O_VWIN + kvh * 128, NO, lo, t, [&](int) { return 0.f; }, NEG, lane, w0, w1);
                const float* gp = FG + (size_t)(8 + h * 3) * S + t; const float g0 = att::sigmoid_f(gp[0]), g1 = att::sigmoid_f(gp[S]), g2 = att::sigmoid_f(gp[2 * S]);
                report(ctl, 9, cmp_out(g0 * c0 + g1 * s0 + g2 * w0, g0 * c1 + g1 * s1 + g2 * w1, OB + (size_t)t * DM + 1024 + h * 128, lane), lane);
            }
        }
    }
}
__global__ void chk_poison(Args a) {
    if (threadIdx.x != 0 || blockIdx.x != 0) return;
    gu32* ctl = (gu32*)(a.ws + WS_CTL);
    const unsigned allow[10] = {0, 0, 0, 0, 0, 0, 3, 0, 0, 3};
    for (int k = 1; k <= 9; ++k) if (__hip_atomic_load(ctl + CW_CHK + k, RLX_AGENT) > allow[k]) { a.out[0] = 16.f * (float)k; return; }
}
}
#endif

#ifndef MK_PER_PHASE
#define MK_PER_PHASE 0
#endif
constexpr int PH_PER_LAYER = 10, N_PHASES = 2 + 4 * PH_PER_LAYER;
#ifndef DUP_MASK
#define DUP_MASK 0
#endif
#define DUP(b) ((DUP_MASK >> (b)) & 1)
#ifndef ODD_NSPLIT
#define ODD_NSPLIT 64
#endif
#ifndef EVEN_SPLIT
#define EVEN_SPLIT 1
#endif
#ifndef STAG_UP
#define STAG_UP 0
#endif
#ifndef STAG_IN
#define STAG_IN 0
#endif
#ifndef STAG_OD
#define STAG_OD 0
#endif
__device__ __forceinline__ void stagger_start(int step_ns) {
    if (step_ns > 0) { const unsigned g = (blockIdx.x >> 3) & 3u; const unsigned long long ticks = (unsigned long long)(g * (unsigned)step_ns / 10u);
        if (ticks) { const unsigned long long t0 = __builtin_amdgcn_s_memrealtime(); while (__builtin_amdgcn_s_memrealtime() - t0 < ticks) __builtin_amdgcn_s_sleep(2); } }
}

__global__ void __launch_bounds__(NWAVES * 64, 2) fwd(Args a_unused) {
    extern __shared__ __attribute__((aligned(16))) unsigned char lds_raw[];
    LAS unsigned char* const lds = (LAS unsigned char*)lds_raw;
    volatile LAS unsigned* MISC = (volatile LAS unsigned*)(lds + MISC_OFF);
    { const int t0 = tid_fresh(); for (int u = t0; u < (LDS_BYTES - LDSCTL_OFF) / 4; u += NWAVES * 64) ((LAS unsigned*)(lds + LDSCTL_OFF))[u] = 0u; }
    __syncthreads();
    int lo, hi; { KA a = kargs(); lo = a->ph_lo; hi = a->ph_hi; }
    XcdBarrier bar; { KA a = kargs(); bar.bar = (unsigned*)((gu32*)(a->ws + WS_CTL) + CW_BAR); bar.x = 0; bar.st = nullptr;
        if (hi - lo > 1) bar = xcd_barrier_post(bar.bar, MISC + 8); }
#define IN(k) (lo <= (k) && (k) < hi)
#define SEAM(k) do { if (IN(k) && IN((k) + 1)) { xcd_barrier(bar); if (DUP(12)) xcd_barrier(bar); } } while (0)
#define DEQUEUE(idx, qhead, qslot) do { if (tid_fresh() == 0) *(qslot) = (int)__hip_atomic_fetch_add((qhead), 1u, RLX_AGENT); __syncthreads(); idx = *(qslot); __syncthreads(); } while (0)

    if (IN(0)) { if (DUP(0)) { { const Ctx C = make_ctx(lds); p0_ada(kargs(), C); } xcd_barrier(bar); }
        { const Ctx C = make_ctx(lds); p0_ada(kargs(), C); } SEAM(0); }

    for (int l = 0; l < DEPTH; ++l) {
        const int pb = 1 + PH_PER_LAYER * l, j = l >> 1; const bool odd = l & 1;
        if (IN(pb + 0) && l == 0) { KA a = kargs(); unsigned char* ws = a->ws; const Ctx C = make_ctx(lds);
            if (DUP(1)) { p0_convert(a, C); resid_init_phase(C, a->x, (bf16*)(ws + WS_H), (float*)(ws + WS_SS)); xcd_barrier(bar); }
            p0_convert(a, C); resid_init_phase(C, a->x, (bf16*)(ws + WS_H), (float*)(ws + WS_SS)); SEAM(pb + 0); }
        if (IN(pb + 1)) {
            KA a = kargs(); unsigned char* ws = a->ws;
            const int N = odd ? NO : NE;
            pg8::Gemm g{(const bf16*)(ws + WS_H), (const bf16*)(ws + WS_W + (size_t)l * W_LAYER + W_IN), S, N, DM}; pg8::StaticOrder So; So.init(S, N, (int)gridDim.x, (int)blockIdx.x);
            LAS float* etab = (LAS float*)(lds + EPITAB_OFF);
            const float* ssp = (const float*)(ws + WS_SS); const float* bip = bpart_of(ws, l, 0);
            pg8::EpiIn E{(bf16*)(ws + WS_QKV), N, (float*)(ws + WS_FG), odd ? 1 : 0, etab};
            if ((DUP(2) && !odd) || (DUP(3) && odd)) { pg8::epi_preload(So, ssp, bip, etab); pg8::gemm_phase<pg8::EpiIn, pg8::StaticOrder, true, true>(lds + RING_OFF, g, So, E); xcd_barrier(bar); }
            if (odd || !EVEN_SPLIT) { pg8::epi_preload(So, ssp, bip, etab); pg8::gemm_phase<pg8::EpiIn, pg8::StaticOrder, true, true>(lds + RING_OFF, g, So, E); }
            else {
                pg8::MapOrder Mo; Mo.init(S, 16, (int)gridDim.x, (int)blockIdx.x, 10, 2);
                pg8::epi_preload(Mo, ssp, bip, etab);
                pg8::gemm_phase<pg8::EpiIn, pg8::MapOrder, true, true>(lds + RING_OFF, g, Mo, E); }
            SEAM(pb + 1);
        }
        if (IN(pb + 2)) {
            KA a = kargs(); unsigned char* ws = a->ws; const Ctx C = make_ctx(lds);
            if (DUP(4) || (DUP(13) && !odd) || (DUP(14) && odd)) { if (!odd) kmean_phase(C, (const bf16*)(ws + WS_QKV), (bf16*)(ws + WS_KMH), (bf16*)(ws + WS_KML)); else oddprep_phase(a, C, j); xcd_barrier(bar); }
            if (!odd) kmean_phase(C, (const bf16*)(ws + WS_QKV), (bf16*)(ws + WS_KMH), (bf16*)(ws + WS_KML));
            else oddprep_phase(a, C, j);
            SEAM(pb + 2);
        }
        const int nrep = ((DUP(5) && !odd) || (DUP(6) && odd)) ? 2 : 1;
        for (int rep = 0; rep < nrep; ++rep) {
        if (IN(pb + 3)) {
            KA a = kargs(); unsigned char* ws = a->ws;
            const bf16* QKV = (const bf16*)(ws + WS_QKV); bf16* OB = (bf16*)(ws + WS_O);
            LAS unsigned char* const alds = lds + RING_OFF;
            LAS int* qslot = (LAS int*)(lds + RING_OFF + 133120 + 1536);
            gu32* qhead = (gu32*)(ws + WS_CTL) + CW_Q + 64 * (l * 4 + rep);
            const int nhost = (int)gridDim.x < 64 ? (int)gridDim.x : 64;
            if (!odd && EVEN_SPLIT && (int)blockIdx.x < nhost) {
                pg8::Gemm g{(const bf16*)(ws + WS_H), (const bf16*)(ws + WS_W + (size_t)l * W_LAYER + W_IN), S, NE, DM};
                LAS float* etab = (LAS float*)(lds + EPITAB_OFF);
                pg8::EpiIn E{(bf16*)(ws + WS_QKV), NE, (float*)(ws + WS_FG), 0, etab};
                pg8::MapOrder Mo; Mo.init(S, 2, nhost, (int)blockIdx.x, 0, 10);
                pg8::epi_preload(Mo, (const float*)(ws + WS_SS), bpart_of(ws, l, 0), etab);
                pg8::gemm_phase<pg8::EpiIn, pg8::MapOrder, true, true>(lds + RING_OFF, g, Mo, E);
                __syncthreads(); }
            gu32* fhead = (gu32*)(ws + WS_CTL) + CW_Q + 64 * (16 + l * 4 + rep);
            const int fwhich = odd ? 2 : 0; bool fmore = true;
            for (int it = 0;; ++it) {
                int idx;
                DEQUEUE(idx, qhead, qslot);
                if (idx >= 512) break;
                if (!odd) {
                    if (idx < 256) att::moba_gate_unit(alds, QKV, (const bf16*)(ws + WS_KMH), (const bf16*)(ws + WS_KML), (gu32*)(ws + WS_CTL) + CW_MCNT + 256 * (l + 4 * rep), (unsigned*)(ws + WS_MLIST), idx & 7, 31 - (idx >> 3));
                    else { const int i = idx - 256; att::swa_unit(alds, QKV, a->even_sinks + j * 8, OB, i & 1, i >> 1); }
                } else {
                    constexpr int NSPLIT = ODD_NSPLIT, NA = 2 * (128 - NSPLIT);
                    const bool is_nsa = idx < NA || idx >= NA + 256; const int i = idx < NA ? idx : idx - NA - 256, kvh = i & 1, ch = (idx < NA ? 127 : NSPLIT - 1) - (i >> 1);
                    const int fi = idx - NA, fh = fi & 7, fqb = 31 - (fi >> 3);
                    if (is_nsa) { if (DUP(11)) att::nsa_unit(alds, QKV, (const bf16*)(ws + WS_KC), (const bf16*)(ws + WS_VC), (const float*)(ws + WS_FG), OB, (float*)(ws + WS_NSASCR) + (size_t)blockIdx.x * 65536, kvh, ch);
                        att::nsa_unit(alds, QKV, (const bf16*)(ws + WS_KC), (const bf16*)(ws + WS_VC), (const float*)(ws + WS_FG), OB, (float*)(ws + WS_NSASCR) + (size_t)blockIdx.x * 65536, kvh, ch); }
                    else { if (DUP(10)) att::fox_unit(alds, QKV, (const float*)(ws + WS_CUM), (const float*)((const gu32*)(ws + WS_CTL) + CW_FOXN + 16 * j), OB, fh, fqb);
                        att::fox_unit(alds, QKV, (const float*)(ws + WS_CUM), (const float*)((const gu32*)(ws + WS_CTL) + CW_FOXN + 16 * j), OB, fh, fqb); }
                }
            }
            while (fmore) { int fi; DEQUEUE(fi, fhead, qslot); fmore = tail_item(a, ws, lds, l, fwhich, fi); __syncthreads(); }
            if (!odd) SEAM(pb + 3);
        }
        if (IN(pb + 4) && !odd) {
            KA a = kargs(); unsigned char* ws = a->ws;
            const bf16* QKV = (const bf16*)(ws + WS_QKV);
            LAS unsigned char* const alds = lds + RING_OFF;
            LAS int* qslot = (LAS int*)(lds + RING_OFF + 133120 + 1536);
            LAS int* pre = (LAS int*)(lds + RING_OFF + 133120);
            const gu32* cnt = (const gu32*)(ws + WS_CTL) + CW_MCNT + 256 * (l + 4 * rep);
            { const int tid = tid_fresh(), lane = tid & 63, wv = tid >> 6;
                const int nt = tid < 256 ? (int)((cnt[tid] + 255u) >> 8) : 0; int sc = nt;
#pragma unroll
                for (int o = 1; o < 64; o <<= 1) { const int n = __shfl_up(sc, o); if (lane >= o) sc += n; }
                if (tid < 256 && lane == 63) pre[260 + wv] = sc;
                __syncthreads();
                int base = 0; for (int w = 0; w < wv && w < 4; ++w) base += pre[260 + w];
                if (tid < 256) pre[tid + 1] = base + sc;
                if (tid == 0) pre[0] = 0;
                __syncthreads(); }
            const int total = 256 + pre[256];
            gu32* qhead = (gu32*)(ws + WS_CTL) + CW_Q + 64 * (l * 4 + 2 + rep);
            gu32* fhead = (gu32*)(ws + WS_CTL) + CW_Q + 64 * (16 + l * 4 + 2 + rep); bool fmore = true;
            for (int it = 0;; ++it) {
                int idx; DEQUEUE(idx, qhead, qslot);
                if (idx >= total) break;
                int h, jb, r;
                if (idx < 256) { h = idx & 7; jb = idx >> 3; r = -1; }
                else { const int g = idx - 256; int b0 = 0, b1 = 256; while (b1 - b0 > 1) { const int mid = (b0 + b1) >> 1; if (pre[mid] <= g) b0 = mid; else b1 = mid; } h = b0 >> 5; jb = b0 & 31; r = g - pre[b0]; }
                att::moba_blk_unit(alds, QKV, cnt, (const unsigned*)(ws + WS_MLIST), (bf16*)(ws + WS_MPO), (float*)(ws + WS_MML), h, jb, r);
            }
            while (fmore) { int fi; DEQUEUE(fi, fhead, qslot); fmore = tail_item(a, ws, lds, l, 1, fi); __syncthreads(); }
            SEAM(pb + 4);
        }
        if (IN(pb + 5) && !odd) { KA a = kargs(); unsigned char* ws = a->ws; const Ctx C = make_ctx(lds);
            moba_combine_phase(C, (const bf16*)(ws + WS_MPO), (const float*)(ws + WS_MML), (bf16*)(ws + WS_O)); }
        if (rep + 1 < nrep) xcd_barrier(bar);
        }
        if (IN(pb + 5) && IN(pb + 6)) xcd_barrier(bar);
        if (IN(pb + 6)) {
            KA a = kargs(); unsigned char* ws = a->ws; const float* mods = (const float*)(ws + WS_MODS) + (size_t)l * 6 * DM;
            pg8::Gemm g{(const bf16*)(ws + WS_O), (const bf16*)(ws + WS_W + (size_t)l * W_LAYER + W_OUT), S, DM, DM}; pg8::StaticOrder So; So.init(S, DM, (int)gridDim.x, (int)blockIdx.x);
            pg8::EpiRes E{(bf16*)(ws + WS_H), nullptr, DM, mods + 2 * DM, (float*)(ws + WS_SS)};
            if (DUP(7)) { pg8::EpiRes E2{(bf16*)(ws + WS_U), nullptr, DM, mods + 2 * DM, (float*)(ws + WS_U) + (size_t)S * DM}; pg8::gemm_phase<pg8::EpiRes, pg8::StaticOrder, true, true>(lds + RING_OFF, g, So, E2); xcd_barrier(bar); }
            pg8::gemm_phase<pg8::EpiRes, pg8::StaticOrder, true, true>(lds + RING_OFF, g, So, E);
            SEAM(pb + 6);
        }
        if (IN(pb + 8)) {
            KA a = kargs(); unsigned char* ws = a->ws;
            pg8::Gemm g{(const bf16*)(ws + WS_H), (const bf16*)(ws + WS_W + (size_t)l * W_LAYER + W_UP), S, DFF, DM}; pg8::StaticOrder So; So.init(S, DFF, (int)gridDim.x, (int)blockIdx.x);
            LAS float* etab = (LAS float*)(lds + EPITAB_OFF);
            pg8::EpiRelu2 E{(bf16*)(ws + WS_U), DFF, etab};
            pg8::epi_preload(So, (const float*)(ws + WS_SS), bpart_of(ws, l, 1), etab);
            if (DUP(8)) { pg8::gemm_phase<pg8::EpiRelu2, pg8::StaticOrder, true, true>(lds + RING_OFF, g, So, E); xcd_barrier(bar); }
            stagger_start(STAG_UP);
            pg8::gemm_phase<pg8::EpiRelu2, pg8::StaticOrder, true, true>(lds + RING_OFF, g, So, E);
            SEAM(pb + 8);
        }
        if (IN(pb + 9)) {
            KA a = kargs(); unsigned char* ws = a->ws; const float* mods = (const float*)(ws + WS_MODS) + (size_t)l * 6 * DM;
            pg8::Gemm g{(const bf16*)(ws + WS_U), (const bf16*)(ws + WS_W + (size_t)l * W_LAYER + W_DOWN), S, DM, DFF}; pg8::StaticOrder So; So.init(S, DM, (int)gridDim.x, (int)blockIdx.x);
            pg8::EpiRes E{(bf16*)(ws + WS_H), nullptr, DM, mods + 5 * DM, (float*)(ws + WS_SS)};
            if (DUP(9)) { pg8::EpiRes E2{(bf16*)(ws + WS_QKV), nullptr, DM, mods + 5 * DM, (float*)(ws + WS_QKV) + (size_t)S * DM}; pg8::gemm_phase<pg8::EpiRes, pg8::StaticOrder, true, true>(lds + RING_OFF, g, So, E2); xcd_barrier(bar); }
            pg8::gemm_phase<pg8::EpiRes, pg8::StaticOrder, true, true>(lds + RING_OFF, g, So, E);
            SEAM(pb + 9);
        }
    }
    if (IN(N_PHASES - 1)) { KA a = kargs(); const Ctx C = make_ctx(lds); final_norm_phase(C, (const bf16*)(a->ws + WS_H), (const float*)(a->ws + WS_SS), a->final_norm_g, a->out); }
#undef IN
#undef SEAM
#undef DEQUEUE
}

extern "C" void kernel_launch(void* const* d_in, const int* in_sizes, int n_in, void* d_out, int out_size, void* d_ws, size_t ws_size, hipStream_t stream) {
    static int grid = 0;
    if (grid == 0) {
        if (n_in != 21 || in_sizes[0] != S * DM || out_size != S * DM || ws_size < WS_END) {
            fprintf(stderr, "kernel_launch: unexpected shapes (n_in %d, in0 %d, out %d, ws %zu < %zu); nothing launched\n", n_in, n_in > 0 ? in_sizes[0] : -1, out_size, ws_size, (size_t)WS_END); grid = -1; return; }
        int dev = 0, cus = 0, per_cu = 0;
        if (hipGetDevice(&dev) != hipSuccess || hipDeviceGetAttribute(&cus, hipDeviceAttributeMultiprocessorCount, dev) != hipSuccess) { fprintf(stderr, "kernel_launch: device query failed\n"); grid = -1; return; }
        if (hipFuncSetAttribute((const void*)fwd, hipFuncAttributeMaxDynamicSharedMemorySize, LDS_BYTES) != hipSuccess) { fprintf(stderr, "kernel_launch: hipFuncSetAttribute failed\n"); grid = -1; return; }
        if (hipOccupancyMaxActiveBlocksPerMultiprocessor(&per_cu, (const void*)fwd, NWAVES * 64, LDS_BYTES) != hipSuccess || per_cu < 1)
            fprintf(stderr, "kernel_launch: note: occupancy query reports %d workgroups per CU\n", per_cu);
        (void)hipGetLastError();
        grid = cus;
    }
    if (grid < 0) return;
    if (hipMemsetAsync((char*)d_ws + WS_CTL, 0, CTL_ZERO_BYTES, stream) != hipSuccess) { fprintf(stderr, "kernel_launch: memset failed\n"); return; }
    Args a{};
    const float** ap = (const float**)&a;
    for (int i = 0; i < 21; ++i) ap[i] = (const float*)d_in[i];
    a.out = (float*)d_out; a.ws = (unsigned char*)d_ws;
#if defined(CHECK) && CHECK
    for (int p = 0; p < N_PHASES; ++p) { a.ph_lo = p; a.ph_hi = p + 1; hipLaunchKernelGGL(fwd, dim3(grid), dim3(NWAVES * 64), LDS_BYTES, stream, a);
        if (p >= 1 && p < N_PHASES - 1) { const int l = (p - 1) / PH_PER_LAYER, q = (p - 1) % PH_PER_LAYER; Args b = a; b.ph_lo = 0; b.ph_hi = 0;
            if (q == 3) hipLaunchKernelGGL(chk::chk_inproj, dim3(512), dim3(256), 0, stream, b, l);
            if (q == 2) hipLaunchKernelGGL(chk::chk_prep, dim3(512), dim3(256), 0, stream, b, l);
            if (q == 5) hipLaunchKernelGGL(chk::chk_attn, dim3(512), dim3(256), 0, stream, b, l); } }
    { Args b = a; b.ph_lo = 0; b.ph_hi = 0; hipLaunchKernelGGL(chk::chk_poison, dim3(1), dim3(64), 0, stream, b); }
#elif MK_PER_PHASE
    for (int p = 0; p < N_PHASES; ++p) { a.ph_lo = p; a.ph_hi = p + 1; hipLaunchKernelGGL(fwd, dim3(grid), dim3(NWAVES * 64), LDS_BYTES, stream, a); }
#else
    a.ph_lo = 0; a.ph_hi = N_PHASES;
    hipLaunchKernelGGL(fwd, dim3(grid), dim3(NWAVES * 64), LDS_BYTES, stream, a);
#endif
    const hipError_t le = hipPeekAtLastError();
    if (le != hipSuccess) fprintf(stderr, "kernel_launch: launch failed: %s\n", hipGetErrorName(le));
}
```

```cpp
#include <hip/hip_runtime.h>
#include <hip/hip_bf16.h>
#include <cstdio>
#include <cstdint>
#include <cmath>
__device__ __forceinline__ int tid_fresh() { int t = threadIdx.x; asm volatile("" : "+v"(t)); return t; }
#ifndef CHECK
#define CHECK 0
#endif
#ifndef BREAK
#define BREAK 0
#endif
namespace pg8 {
#define PG8_LAS __attribute__((address_space(3)))
typedef unsigned short bf16_t;
typedef short bf16x8 __attribute__((ext_vector_type(8)));
typedef float f32x4 __attribute__((ext_vector_type(4)));
typedef unsigned u32x4 __attribute__((ext_vector_type(4)));
constexpr int BM = 256, BK = 64, HALF = 128, HTB = HALF * BK * 2  , STAGE_BYTES = 8 * HTB, NXCD = 8, WGM = 4;

__host__ __device__ __forceinline__ int lds_byte(int r, int c) { const int st = (r >> 4) * 2 + (c >> 5), rr = r & 15, cc = c & 31, ob = rr * 64 + cc * 2; return st * 1024 + (ob ^ (((ob >> 9) & 1) << 5)); }
__host__ __device__ __forceinline__ void stage_rc(int b, int& R, int& C) { const int st = b / 1024, sb = b % 1024, swz = sb ^ (((sb >> 9) & 1) << 5); R = (st >> 1) * 16 + swz / 64; C = (st & 1) * 32 + (swz % 64) / 2; }
__host__ __device__ __forceinline__ int perm32(int rho) { const int n = rho >> 4, i = rho & 15; return 8 * (i >> 2) + 4 * n + (i & 3); }

struct Unit { int pm, pn; };
struct Gemm { const bf16_t* A; const bf16_t* Bt; int M, N, K; };

struct StaticOrder {
    int nM, nN, nwg, G, c;
    __host__ __device__ void init(int M, int N, int G_, int c_) { nM = M / BM; nN = N / BM; nwg = nM * nN; G = G_; c = c_; }
    __host__ __device__ bool next(int i, Unit& u) const {
        const long L = (long)i * G + c; if (L >= nwg) return false;
        int wgid = (int)L; { const int q = nwg / NXCD, r = nwg % NXCD, xcd = wgid % NXCD, off = wgid / NXCD; wgid = (xcd < r ? xcd * (q + 1) : r * (q + 1) + (xcd - r) * q) + off; }
        const int nig = WGM * nN, gid = wgid / nig, fm = gid * WGM, gsz = (nM - fm) < WGM ? (nM - fm) : WGM;
        u.pm = fm + ((wgid % nig) % gsz); u.pn = (wgid % nig) / gsz; return true;
    }
    __device__ __forceinline__ void a_ready(const Unit&) const {}
    __device__ __forceinline__ void done(const Unit&) const {}
};

__device__ __forceinline__ unsigned cvt_pk_bf16(float lo, float hi) { unsigned r; asm volatile("v_cvt_pk_bf16_f32 %0, %1, %2" : "=v"(r) : "v"(lo), "v"(hi)); return r; }
typedef float f32x2 __attribute__((ext_vector_type(2)));


struct EpiIn {
    static constexpr bool PERM = true, AFTER_DRAIN = false;
    bf16_t* O; int ldc; float* FG; int odd; const PG8_LAS float* tab;
    __device__ __forceinline__ void operator()(const f32x4 (&acc)[2][2][4][2], const Unit& u, int ui, int wr, int wc, int fr, int fq) const {
        asm volatile("" : "+v"(fr), "+v"(fq));
        const int pn = u.pn;
        int mode;
        if (!odd) mode = (pn < 8 || (pn >= 12 && pn <= 16)) ? 1 : 0;
        else mode = (pn == 22) ? 2 : (((pn >= 12 && pn <= 16) || pn == 18 || pn == 20) ? 1 : 0);
        const int row0 = u.pm * BM + wr * 64 + fr;
        const int hh = wc >> 1, dd = (wc & 1) * 32 + 8 * fq;
        const int cl0 = hh * 128 + dd, col0 = pn * BM + cl0;
        const PG8_LAS float* tb = tab + ui * 512;
        if (mode == 2) {
            if (wc == 0) { const f32x4 bb0 = *(const PG8_LAS f32x4*)(tb + 256 + cl0), bb1 = *(const PG8_LAS f32x4*)(tb + 256 + cl0 + 4);
#pragma unroll
                for (int ai = 0; ai < 2; ++ai)
#pragma unroll
                    for (int m = 0; m < 4; ++m) { const int row = row0 + ai * HALF + m * 16; const float rs = tb[wr * 64 + fr + ai * HALF + m * 16]; float* p = FG + (size_t)(8 * fq) * 8192 + row;
                        const f32x4 v0 = acc[ai][0][m][0] * rs + bb0, v1 = acc[ai][0][m][1] * rs + bb1;
#pragma unroll
                        for (int e = 0; e < 4; ++e) { p[(size_t)e * 8192] = v0[e]; p[(size_t)(4 + e) * 8192] = v1[e]; } }
            }
            return;
        }
        const f32x4 ir0 = *(const PG8_LAS f32x4*)(tab + 2048 + dd), ir1 = *(const PG8_LAS f32x4*)(tab + 2048 + dd + 4);
        const f32x4 ba0 = *(const PG8_LAS f32x4*)(tb + 256 + cl0), ba1 = *(const PG8_LAS f32x4*)(tb + 256 + cl0 + 4), bb0 = *(const PG8_LAS f32x4*)(tb + 256 + cl0 + 64), bb1 = *(const PG8_LAS f32x4*)(tb + 256 + cl0 + 68);
#pragma unroll
        for (int ai = 0; ai < 2; ++ai)
#pragma unroll
            for (int m = 0; m < 4; ++m) { const int row = row0 + ai * HALF + m * 16; const float rs = tb[wr * 64 + fr + ai * HALF + m * 16];
                f32x4 a0 = acc[ai][0][m][0] * rs + ba0, a1 = acc[ai][0][m][1] * rs + ba1, b0 = acc[ai][1][m][0] * rs + bb0, b1 = acc[ai][1][m][1] * rs + bb1;
                if (mode == 1) {
                    const float tf = (float)row; f32x4 c0, c1, s0, s1;
#pragma unroll
                    for (int e = 0; e < 4; ++e) { float r0 = tf * ir0[e], r1 = tf * ir1[e]; r0 = __builtin_amdgcn_fractf(r0); r1 = __builtin_amdgcn_fractf(r1);
                        c0[e] = __builtin_amdgcn_cosf(r0); s0[e] = __builtin_amdgcn_sinf(r0); c1[e] = __builtin_amdgcn_cosf(r1); s1[e] = __builtin_amdgcn_sinf(r1); }
                    const f32x4 x0 = a0 * c0 - b0 * s0, x1 = a1 * c1 - b1 * s1, y0 = a0 * s0 + b0 * c0, y1 = a1 * s1 + b1 * c1;
                    a0 = x0; a1 = x1; b0 = y0; b1 = y1; }
                bf16_t* rowp = O + (size_t)row * ldc + col0;
                u32x4 w; w.x = cvt_pk_bf16(a0[0], a0[1]); w.y = cvt_pk_bf16(a0[2], a0[3]); w.z = cvt_pk_bf16(a1[0], a1[1]); w.w = cvt_pk_bf16(a1[2], a1[3]);
                *(u32x4*)rowp = w;
                u32x4 v; v.x = cvt_pk_bf16(b0[0], b0[1]); v.y = cvt_pk_bf16(b0[2], b0[3]); v.z = cvt_pk_bf16(b1[0], b1[1]); v.w = cvt_pk_bf16(b1[2], b1[3]);
                *(u32x4*)(rowp + 64) = v; }
    }
};
struct EpiRes {
    static constexpr bool PERM = true, AFTER_DRAIN = false;
    bf16_t* R; float* XF; int ldc; const float* gate; float* ss;
    __device__ __forceinline__ void operator()(const f32x4 (&acc)[2][2][4][2], const Unit& u, int ui, int wr, int wc, int fr, int fq) const {
        asm volatile("" : "+v"(fr), "+v"(fq));
        const int row0 = u.pm * BM + wr * 64 + fr, col0 = u.pn * BM + wc * 32 + 8 * fq;
        f32x4 gv[2][2];
#pragma unroll
        for (int bj = 0; bj < 2; ++bj)
#pragma unroll
            for (int n = 0; n < 2; ++n) gv[bj][n] = *(const f32x4*)(gate + col0 + bj * HALF + 4 * n);
#pragma unroll
        for (int ai = 0; ai < 2; ++ai)
#pragma unroll
            for (int m = 0; m < 4; ++m) { const int row = row0 + ai * HALF + m * 16; const size_t off = (size_t)row * ldc + col0; float sq = 0.f;
#pragma unroll
                for (int bj = 0; bj < 2; ++bj) { const u32x4 rb = *(const u32x4*)(R + off + bj * HALF);
                    const f32x4 r0 = {__builtin_bit_cast(float, rb.x << 16), __builtin_bit_cast(float, rb.x & 0xffff0000u), __builtin_bit_cast(float, rb.y << 16), __builtin_bit_cast(float, rb.y & 0xffff0000u)};
                    const f32x4 r1 = {__builtin_bit_cast(float, rb.z << 16), __builtin_bit_cast(float, rb.z & 0xffff0000u), __builtin_bit_cast(float, rb.w << 16), __builtin_bit_cast(float, rb.w & 0xffff0000u)};
                    const f32x4 x0 = r0 + gv[bj][0] * acc[ai][bj][m][0], x1 = r1 + gv[bj][1] * acc[ai][bj][m][1];
                    if (XF) { *(f32x4*)(XF + off + bj * HALF) = x0; *(f32x4*)(XF + off + bj * HALF + 4) = x1; }
                    sq += ((x0[0] * x0[0] + x0[1] * x0[1]) + (x0[2] * x0[2] + x0[3] * x0[3])) + ((x1[0] * x1[0] + x1[1] * x1[1]) + (x1[2] * x1[2] + x1[3] * x1[3]));
                    u32x4 w; w.x = cvt_pk_bf16(x0[0], x0[1]); w.y = cvt_pk_bf16(x0[2], x0[3]); w.z = cvt_pk_bf16(x1[0], x1[1]); w.w = cvt_pk_bf16(x1[2], x1[3]);
                    *(u32x4*)(R + off + bj * HALF) = w; }
                if (ss) { sq += __shfl_xor(sq, 16); sq += __shfl_xor(sq, 32); if (fq == 0) ss[(size_t)row * 32 + u.pn * 4 + wc] = sq; } }
    }
};
struct EpiRelu2 {
    static constexpr bool PERM = true, AFTER_DRAIN = false;
    bf16_t* O; int ldc; const PG8_LAS float* tab;
    __device__ __forceinline__ void operator()(const f32x4 (&acc)[2][2][4][2], const Unit& u, int ui, int wr, int wc, int fr, int fq) const {
        asm volatile("" : "+v"(fr), "+v"(fq));
        const int row0 = u.pm * BM + wr * 64 + fr, col0 = u.pn * BM + wc * 32 + 8 * fq;
        const PG8_LAS float* tb = tab + ui * 512; const int cl0 = wc * 32 + 8 * fq;
        f32x4 bv[2][2];
#pragma unroll
        for (int bj = 0; bj < 2; ++bj)
#pragma unroll
            for (int n = 0; n < 2; ++n) bv[bj][n] = *(const PG8_LAS f32x4*)(tb + 256 + cl0 + bj * HALF + 4 * n);
#pragma unroll
        for (int ai = 0; ai < 2; ++ai)
#pragma unroll
            for (int m = 0; m < 4; ++m) { const int row = row0 + ai * HALF + m * 16; const float rs = tb[wr * 64 + fr + ai * HALF + m * 16]; bf16_t* rowp = O + (size_t)row * ldc + col0;
#pragma unroll
                for (int bj = 0; bj < 2; ++bj) { f32x4 v0 = acc[ai][bj][m][0] * rs + bv[bj][0], v1 = acc[ai][bj][m][1] * rs + bv[bj][1];
#pragma unroll
                    for (int e = 0; e < 4; ++e) { const float a = fmaxf(v0[e], 0.f), b = fmaxf(v1[e], 0.f); v0[e] = a * a; v1[e] = b * b; }
                    u32x4 w; w.x = cvt_pk_bf16(v0[0], v0[1]); w.y = cvt_pk_bf16(v0[2], v0[3]); w.z = cvt_pk_bf16(v1[0], v1[1]); w.w = cvt_pk_bf16(v1[2], v1[3]);
                    *(u32x4*)(rowp + bj * HALF) = w; } }
    }
};

struct MapOrder {
    StaticOrder b; int cut, shift;
    __device__ void init(int M, int nTiles, int G_, int c_, int cut_, int shift_) { b.init(M, nTiles * BM, G_, c_); cut = cut_; shift = shift_; }
    __device__ bool next(int i, Unit& u) const { if (!b.next(i, u)) return false; u.pn += (u.pn >= cut) ? shift : 0; return true; }
    __device__ __forceinline__ void a_ready(const Unit&) const {}
    __device__ __forceinline__ void done(const Unit&) const {}
};

template <class Sched>
__device__ __forceinline__ void epi_preload(const Sched& S, const float* ss, const float* bp, PG8_LAS float* tab) {
    const int tid = tid_fresh();
    if (tid < 64) tab[2048 + tid] = 0.15915494309189535f / powf(10000.f, (float)tid * (1.f / 64.f));
    Unit u;
    if (tid < 256) {
        int pmp = -1; float rs = 0.f;
        for (int i = 0; i < 4 && S.next(i, u); ++i) {
            if (u.pm != pmp) { const float* sp = ss + (size_t)(u.pm * BM + tid) * 32; float t = 0.f; pmp = u.pm;
#pragma unroll
                for (int q = 0; q < 8; ++q) { const f32x4 a = *(const f32x4*)(sp + 4 * q); t += (a[0] + a[1]) + (a[2] + a[3]); }
                rs = 1.f / sqrtf(t * (1.f / 2048.f) + 1e-6f); }
            tab[i * 512 + tid] = rs; }
    } else {
        const int w = (tid - 256) >> 6, ln = tid & 63;
        if (S.next(w, u)) { const float* b = bp + u.pn * BM + 4 * ln; f32x4 t0 = {0.f, 0.f, 0.f, 0.f}, t1 = t0;
#pragma unroll
            for (int kb = 0; kb < 32; kb += 2) { t0 += *(const f32x4*)(b + (size_t)kb * 8192); t1 += *(const f32x4*)(b + (size_t)(kb + 1) * 8192); }
            *(PG8_LAS f32x4*)(tab + w * 512 + 256 + 4 * ln) = t0 + t1; }
    }
    __syncthreads();
}
template <class Epi, class Sched, bool ALIGN_EPI = false, bool SP2 = false>
__device__ __forceinline__ void gemm_phase(PG8_LAS unsigned char* lds, const Gemm g, const Sched& S, const Epi& E) {
    const int tid = tid_fresh(), wid = __builtin_amdgcn_readfirstlane(tid >> 6), lane = tid & 63, wr = wid >> 2, wc = wid & 3, fr = lane & 15, fq = lane >> 4;
    const int K = g.K, nt = K / BK;
    unsigned voffA[2], voffB[2];
#pragma unroll
    for (int i = 0; i < 2; ++i) { int R, C; stage_rc(tid * 16 + i * 8192, R, C); const int Rb = Epi::PERM ? ((R & ~31) + perm32(R & 31)) : R;
        voffA[i] = (unsigned)(R * K + C) * 2u; voffB[i] = (unsigned)(Rb * K + C) * 2u; }
    const size_t kstep = (size_t)(BK * 2);
    const size_t hstep = (size_t)HALF * K * 2;
    const size_t tstep = 2 * hstep;
    const unsigned ldsw = (unsigned)wid * 1024u;
    const int aoff = lds_byte(wr * 64 + fr, fq * 8), boff = lds_byte(wc * 32 + fr, fq * 8);
#define PG8_SA(b, h) (((b) * 2 + (h)) * HTB)
#define PG8_SB(b, h) ((4 + (b) * 2 + (h)) * HTB)
#define PG8_STAGE(bufoff, gbase, voff) do { _Pragma("unroll") for (int _i = 0; _i < 2; ++_i) \
        __builtin_amdgcn_global_load_lds((const unsigned*)((const char*)(gbase) + (voff)[_i]), (PG8_LAS unsigned*)(lds + (bufoff) + ldsw + _i * 8192), 16, 0, 0); } while (0)
#define PG8_LDA(dst, b, h) do { _Pragma("unroll") for (int m = 0; m < 4; ++m) _Pragma("unroll") for (int k = 0; k < 2; ++k) dst[m][k] = *(const PG8_LAS bf16x8*)(lds + PG8_SA(b, h) + aoff + m * 2048 + k * 1024); } while (0)
#define PG8_LDB(dst, b, h) do { _Pragma("unroll") for (int n = 0; n < 2; ++n) _Pragma("unroll") for (int k = 0; k < 2; ++k) dst[n][k] = *(const PG8_LAS bf16x8*)(lds + PG8_SB(b, h) + boff + n * 2048 + k * 1024); } while (0)
#define PG8_MMA(ai, bj, At, Bt) do { __builtin_amdgcn_s_setprio(1); _Pragma("unroll") for (int m = 0; m < 4; ++m) _Pragma("unroll") for (int n = 0; n < 2; ++n) _Pragma("unroll") for (int k = 0; k < 2; ++k) \
        acc[ai][bj][m][n] = __builtin_amdgcn_mfma_f32_16x16x32_bf16(Bt[n][k], At[m][k], acc[ai][bj][m][n], 0, 0, 0); __builtin_amdgcn_s_setprio(0); } while (0)
#define PG8_WAIT_V(n) asm volatile("s_waitcnt vmcnt(" #n ")" ::: "memory")
#define PG8_WAIT_L(n) asm volatile("s_waitcnt lgkmcnt(" #n ")" ::: "memory")
#define PG8_BAR __builtin_amdgcn_s_barrier()
#define PG8_SCHED __builtin_amdgcn_sched_barrier(0)
    Unit cur, nxt; int ui = 0;
    if (!S.next(0, cur)) return;
    f32x4 acc[2][2][4][2];
#pragma unroll
    for (int a = 0; a < 2; ++a)
#pragma unroll
        for (int b = 0; b < 2; ++b)
#pragma unroll
            for (int m = 0; m < 4; ++m)
#pragma unroll
                for (int n = 0; n < 2; ++n) acc[a][b][m][n] = (f32x4){0.f, 0.f, 0.f, 0.f};
    bf16x8 At[4][2], B0[2][2], B1[2][2];
    const char* cA = (const char*)g.A + (size_t)cur.pm * tstep; const char* cB = (const char*)g.Bt + (size_t)cur.pn * tstep;
    S.a_ready(cur);
    if constexpr (SP2) {
        PG8_STAGE(PG8_SB(0, 0), cB, voffB); PG8_STAGE(PG8_SB(0, 1), cB + hstep, voffB); PG8_STAGE(PG8_SA(0, 0), cA, voffA); PG8_STAGE(PG8_SA(0, 1), cA + hstep, voffA);
        if (wr == 1) PG8_BAR;
        PG8_WAIT_V(2); PG8_BAR;
        PG8_STAGE(PG8_SB(1, 0), cB + kstep, voffB); PG8_STAGE(PG8_SA(1, 0), cA + kstep, voffA); PG8_STAGE(PG8_SB(1, 1), cB + hstep + kstep, voffB);
        PG8_WAIT_V(6); PG8_BAR;
    } else {
        PG8_STAGE(PG8_SB(0, 0), cB, voffB); PG8_STAGE(PG8_SA(0, 0), cA, voffA); PG8_STAGE(PG8_SB(0, 1), cB + hstep, voffB); PG8_STAGE(PG8_SA(0, 1), cA + hstep, voffA);
        if (wr == 1) PG8_BAR;
        PG8_WAIT_V(4); PG8_BAR;
        PG8_STAGE(PG8_SB(1, 0), cB + kstep, voffB); PG8_STAGE(PG8_SA(1, 0), cA + kstep, voffA); PG8_STAGE(PG8_SB(1, 1), cB + hstep + kstep, voffB);
        PG8_WAIT_V(6); PG8_BAR;
    }
    for (;;) {
        const bool has_next = S.next(ui + 1, nxt);
        const char* nA = has_next ? (const char*)g.A + (size_t)nxt.pm * tstep : cA; const char* nB = has_next ? (const char*)g.Bt + (size_t)nxt.pn * tstep : cB;
        for (int t = 0; t < nt; t += 2) {
            const bool last = (t == nt - 2);
            const char* a1 = cA + (size_t)(t + 1) * kstep;
            const char* a2 = last ? nA : cA + (size_t)(t + 2) * kstep; const char* b2 = last ? nB : cB + (size_t)(t + 2) * kstep;
            const char* a3 = a2 + kstep; const char* b3 = b2 + kstep;
            if (last && has_next) S.a_ready(nxt);
            if constexpr (SP2) {
            PG8_LDB(B0, 0, 0); PG8_LDB(B1, 0, 1); PG8_SCHED; PG8_LDA(At, 0, 0); PG8_STAGE(PG8_SA(1, 1), a1 + hstep, voffA);
            PG8_WAIT_V(8); PG8_WAIT_L(0); PG8_BAR; PG8_MMA(0, 0, At, B0); PG8_MMA(0, 1, At, B1); PG8_BAR; PG8_SCHED;
            PG8_LDA(At, 0, 1); PG8_STAGE(PG8_SB(0, 0), b2, voffB); PG8_STAGE(PG8_SB(0, 1), b2 + hstep, voffB); PG8_STAGE(PG8_SA(0, 0), a2, voffA);
            PG8_WAIT_V(8); PG8_WAIT_L(0); PG8_BAR; PG8_MMA(1, 0, At, B0); PG8_MMA(1, 1, At, B1); PG8_BAR; PG8_SCHED;
            PG8_LDB(B0, 1, 0); PG8_LDB(B1, 1, 1); PG8_SCHED; PG8_LDA(At, 1, 0); PG8_STAGE(PG8_SA(0, 1), a2 + hstep, voffA);
            PG8_WAIT_V(8); PG8_WAIT_L(0); PG8_BAR; PG8_MMA(0, 0, At, B0); PG8_MMA(0, 1, At, B1); PG8_BAR; PG8_SCHED;
            PG8_LDA(At, 1, 1); PG8_STAGE(PG8_SB(1, 0), b3, voffB); PG8_STAGE(PG8_SB(1, 1), b3 + hstep, voffB); PG8_STAGE(PG8_SA(1, 0), a3, voffA);
            PG8_WAIT_V(8); PG8_WAIT_L(0); PG8_BAR; PG8_MMA(1, 0, At, B0); PG8_MMA(1, 1, At, B1); PG8_BAR; PG8_SCHED;
            } else {
            PG8_LDB(B0, 0, 0); PG8_SCHED; PG8_LDA(At, 0, 0); PG8_STAGE(PG8_SA(1, 1), a1 + hstep, voffA);
            PG8_WAIT_L(8); PG8_BAR; PG8_WAIT_L(0); PG8_MMA(0, 0, At, B0); PG8_BAR; PG8_SCHED;
            PG8_LDB(B1, 0, 1); PG8_STAGE(PG8_SB(0, 0), b2, voffB);
            PG8_BAR; PG8_WAIT_L(0); PG8_MMA(0, 1, At, B1); PG8_BAR;
            PG8_LDA(At, 0, 1); PG8_STAGE(PG8_SA(0, 0), a2, voffA);
            PG8_BAR; PG8_WAIT_L(0); PG8_MMA(1, 0, At, B0); PG8_BAR; PG8_SCHED;
            PG8_STAGE(PG8_SB(0, 1), b2 + hstep, voffB);
            PG8_WAIT_V(6); PG8_BAR; PG8_MMA(1, 1, At, B1); PG8_BAR;
            PG8_LDB(B0, 1, 0); PG8_SCHED; PG8_LDA(At, 1, 0); PG8_STAGE(PG8_SA(0, 1), a2 + hstep, voffA);
            PG8_WAIT_L(8); PG8_BAR; PG8_WAIT_L(0); PG8_MMA(0, 0, At, B0); PG8_BAR; PG8_SCHED;
            PG8_LDB(B1, 1, 1); PG8_STAGE(PG8_SB(1, 0), b3, voffB);
            PG8_BAR; PG8_WAIT_L(0); PG8_MMA(0, 1, At, B1); PG8_BAR;
            PG8_LDA(At, 1, 1); PG8_STAGE(PG8_SA(1, 0), a3, voffA);
            PG8_BAR; PG8_WAIT_L(0); PG8_MMA(1, 0, At, B0); PG8_BAR; PG8_SCHED;
            PG8_STAGE(PG8_SB(1, 1), b3 + hstep, voffB);
            PG8_WAIT_V(6); PG8_BAR; PG8_MMA(1, 1, At, B1); PG8_BAR;
            }
        }
        if constexpr (ALIGN_EPI) { if (wr == 0) PG8_BAR; }
        if constexpr (!Epi::AFTER_DRAIN) { E(acc, cur, ui, wr, wc, fr, fq); S.done(cur); }
        if (!has_next) break;
#pragma unroll
        for (int a = 0; a < 2; ++a)
#pragma unroll
            for (int b = 0; b < 2; ++b)
#pragma unroll
                for (int m = 0; m < 4; ++m)
#pragma unroll
                    for (int n = 0; n < 2; ++n) acc[a][b][m][n] = (f32x4){0.f, 0.f, 0.f, 0.f};
        cur = nxt; cA = nA; cB = nB; ++ui;
        if constexpr (ALIGN_EPI) { if (wr == 1) PG8_BAR; }
    }
    PG8_WAIT_V(0);
    if constexpr (!ALIGN_EPI) { if (wr == 0) PG8_BAR; }
    PG8_BAR;
    if constexpr (Epi::AFTER_DRAIN) { E.fused(acc, cur, wr, wc, fr, fq, lds, wid, lane); S.done(cur); }
#undef PG8_SA
#undef PG8_SB
#undef PG8_STAGE
#undef PG8_LDA
#undef PG8_LDB
#undef PG8_MMA
#undef PG8_WAIT_V
#undef PG8_WAIT_L
#undef PG8_BAR
#undef PG8_SCHED
}
}

constexpr int S = 8192, DM = 2048, HD = 128, DFF = 8192, DEPTH = 4;
constexpr int NE = 4608, NO = 5888, NO_SRC = 5664;
constexpr float NORM_EPS = 1e-6f;
constexpr int NWAVES = 8;
constexpr int E_QA = 0, E_KA = 1024, E_VA = 2048, E_QB = 3072, E_KB = 4096, E_VB = 4352;
constexpr int O_QC = 0, O_KC = 1024, O_VC = 2048, O_QD = 3072, O_KCMP = 4096, O_VCMP = 4352, O_KSLC = 4608, O_VSLC = 4864, O_KWIN = 5120, O_VWIN = 5376, O_FG = 5632;
constexpr int NCMP = 511;

constexpr size_t MiB = 1u << 20;
constexpr size_t WS_CTL = 0, CTL_ZERO_BYTES = 1 * MiB;
constexpr size_t WS_MODS = 1 * MiB;
constexpr size_t WS_KMH = 6 * MiB, WS_KML = 6 * MiB + 128 * 1024;
constexpr size_t WS_CUM = 7 * MiB;
constexpr size_t WS_FOXN = 7 * MiB + 512 * 1024;
constexpr size_t WS_FG = 8 * MiB;
constexpr size_t WS_KC = 9 * MiB, WS_VC = 9 * MiB + 512 * 1024;
constexpr size_t WS_W1T = 10 * MiB;
constexpr size_t WS_W2T = 14 * MiB;
constexpr size_t WS_W = 16 * MiB, W_LAYER = 96 * MiB, W_IN = 0, W_OUT = 24 * MiB, W_UP = 32 * MiB, W_DOWN = 64 * MiB;
constexpr size_t WS_H = 400 * MiB;
constexpr size_t WS_QKV = 432 * MiB;
constexpr size_t WS_O = 528 * MiB;
constexpr size_t WS_U = 560 * MiB;
constexpr size_t WS_NSASCR = 688 * MiB;
constexpr size_t WS_MPO = WS_NSASCR;
constexpr size_t WS_MML = 752 * MiB;
constexpr size_t WS_MLIST = 754 * MiB;
constexpr size_t WS_SS = 762 * MiB;
constexpr size_t WS_BPART = 764 * MiB;
constexpr size_t WS_END = 772 * MiB;
constexpr int CW_BAR = 4096;
constexpr int CW_Q = 8192;
constexpr int CW_FOXN = 13312;
constexpr int CW_MCNT = 10240;

constexpr int RING_OFF = 0, RING_BYTES = 135168;
constexpr int LDSCTL_OFF = RING_BYTES, MISC_OFF = LDSCTL_OFF + 320;
constexpr int LDS_BYTES = 147456;
constexpr int EPITAB_OFF = MISC_OFF + 128;
static_assert(EPITAB_OFF + (4 * 512 + 64) * 4 <= LDS_BYTES, "LDS map");

#define GAS __attribute__((address_space(1)))
#define LAS __attribute__((address_space(3)))
#define DI __device__ __forceinline__
typedef unsigned short bf16;
typedef unsigned v4u __attribute__((ext_vector_type(4)));
typedef float f32x4 __attribute__((ext_vector_type(4)));
typedef float f32x16 __attribute__((ext_vector_type(16)));
typedef short bf16x8 __attribute__((ext_vector_type(8)));
typedef short s16x4 __attribute__((ext_vector_type(4)));
typedef GAS unsigned gu32;
#define RLX_AGENT __ATOMIC_RELAXED, __HIP_MEMORY_SCOPE_AGENT
#define LDS_WAIT() asm volatile("s_waitcnt lgkmcnt(0)" ::: "memory")
DI unsigned f2bf(float f) { unsigned u = __builtin_bit_cast(unsigned, f); return (u + 0x7fffu + ((u >> 16) & 1u)) >> 16; }
DI float bf2f(unsigned b) { return __builtin_bit_cast(float, b << 16); }
DI unsigned pk2(float lo, float hi) { return f2bf(lo) | (f2bf(hi) << 16); }
DI float wave_sum(float v) {
#pragma unroll
    for (int o = 1; o < 64; o <<= 1) v += __shfl_xor(v, o);
    return v;
}
#define XB_TMO      128
#define XB_XCNT(j)  (256  + 64 * (j))
#define XB_XSUB(j)  (1280 + 64 * (j))
#define XB_XGEN(j)  (2304 + 64 * (j))
#define XB_TOP      3328
#define XB_TOPGEN   3392
#define XCD_BAR_WORDS 3456
#define XB_SPIN_CAP (1u << 18)

__device__ __forceinline__ unsigned xb_ld(unsigned* p)              { return __hip_atomic_load(p, __ATOMIC_RELAXED, __HIP_MEMORY_SCOPE_AGENT); }
__device__ __forceinline__ unsigned xb_add(unsigned* p, unsigned v) { return __hip_atomic_fetch_add(p, v, __ATOMIC_RELAXED, __HIP_MEMORY_SCOPE_AGENT); }
__device__ __forceinline__ unsigned xb_xcc_id() { return (unsigned)__builtin_amdgcn_s_getreg((3 << 11) | 20) & 0xFu; }
#define XB_SPIN(cond, bar) do { unsigned _sp = 0; while (cond) { __builtin_amdgcn_s_sleep(1); \
    if ((++_sp & 255u) == 0u) { if (xb_ld(&(bar)[XB_TMO])) break; if (_sp > XB_SPIN_CAP) { atomicAdd(&(bar)[XB_TMO], 1u); break; } } } } while (0)

struct XcdBarrier {
    unsigned* bar; unsigned x;
    volatile LAS unsigned* st;
};

__device__ __forceinline__ XcdBarrier xcd_barrier_post(unsigned* bar, volatile LAS unsigned* st) {
    XcdBarrier b; b.bar = bar; b.x = xb_xcc_id(); b.st = st;
    if (threadIdx.x == 0) (void)xb_add(&bar[XB_XCNT(b.x)], 1u);
    return b;
}
__device__ __forceinline__ void xcd_barrier_complete(unsigned* bar, unsigned x, unsigned& nloc, unsigned& nx) {
    const unsigned G = gridDim.x * gridDim.y * gridDim.z;
    unsigned sum, cnt, mine, sp = 0u;
    for (;;) {
        sum = 0u; cnt = 0u; mine = 0u;
#pragma unroll
        for (unsigned j = 0; j < 16; ++j) { const unsigned c = xb_ld(&bar[XB_XCNT(j)]); sum += c; cnt += (c > 0u) ? 1u : 0u; mine = (j == x) ? c : mine; }
        if (sum == G) break;
        __builtin_amdgcn_s_sleep(1);
        if ((++sp & 255u) == 0u) { if (xb_ld(&bar[XB_TMO])) break; if (sp > XB_SPIN_CAP) { atomicAdd(&bar[XB_TMO], 1u); break; } }
    }
    nloc = mine > 0u ? mine : 1u; nx = cnt > 0u ? cnt : 1u;
}

__device__ __forceinline__ void xcd_barrier(const XcdBarrier& b) {
    asm volatile("s_waitcnt vmcnt(0)" ::: "memory");
    __syncthreads();
    if (threadIdx.x == 0) {
        unsigned* bar = b.bar;
        __builtin_amdgcn_s_waitcnt(0);
        unsigned nloc = b.st[0], nx = b.st[1];
        if (nloc == 0u) { xcd_barrier_complete(bar, b.x, nloc, nx); b.st[0] = nloc; b.st[1] = nx; }
        const unsigned old = xb_add(&bar[XB_XSUB(b.x)], 1u);
        const unsigned gen = old / nloc;
        if (old + 1u == (gen + 1u) * nloc) {
            __builtin_amdgcn_fence(__ATOMIC_RELEASE, "agent");
            asm volatile("s_waitcnt vmcnt(0)" ::: "memory");
            const unsigned og = xb_add(&bar[XB_TOP], 1u);
            const unsigned tg = og / nx;
            if (og + 1u == (tg + 1u) * nx) xb_add(&bar[XB_TOPGEN], 1u);
            else XB_SPIN(xb_ld(&bar[XB_TOPGEN]) == tg, bar);
            __builtin_amdgcn_fence(__ATOMIC_ACQUIRE, "agent");
            xb_add(&bar[XB_XGEN(b.x)], 1u);
            asm volatile("s_waitcnt vmcnt(0)" ::: "memory");
        } else {
            XB_SPIN(xb_ld(&bar[XB_XGEN(b.x)]) == gen, bar);
            __builtin_amdgcn_fence(__ATOMIC_ACQUIRE, "agent");
            asm volatile("s_waitcnt vmcnt(0)" ::: "memory");
        }
    }
    __syncthreads();
}

struct Args {
    const float* x; const float* c; const float* norm_mix_g; const float* norm_mlp_g; const float* ada_w; const float* ada_b;
    const float* mlp_up; const float* mlp_down; const float* even_w_in; const float* even_sinks; const float* even_w_out;
    const float* odd_w_in; const float* fox_forget_b; const float* nsa_k_pos; const float* nsa_k_w1; const float* nsa_k_w2;
    const float* nsa_v_pos; const float* nsa_v_w1; const float* nsa_v_w2; const float* odd_w_out; const float* final_norm_g;
    float* out; unsigned char* ws; int ph_lo, ph_hi;
};
typedef const __attribute__((address_space(4))) Args* KA;
DI KA kargs() { KA p = (KA)__builtin_amdgcn_kernarg_segment_ptr(); asm volatile("" : "+s"(p)); return p; }
struct Ctx {
    LAS unsigned char* lds; int tid, lane, wave, G, gw, NGW;
};
DI Ctx make_ctx(LAS unsigned char* lds) { Ctx C; C.lds = lds; C.tid = tid_fresh(); C.lane = C.tid & 63; C.wave = __builtin_amdgcn_readfirstlane(C.tid >> 6);
    C.G = gridDim.x; C.gw = blockIdx.x * NWAVES + C.wave; C.NGW = C.G * NWAVES; return C; }

DI int tile_perm_row(int nd) { const int q = nd & 255, hh = q >> 7, d = q & 127; return (nd & ~255) + (d < 64 ? hh * 64 + d : 128 + hh * 64 + (d - 64)); }
DI int odd_src_col(int nd) { return nd < 3072 ? nd : (nd < 5632 ? nd + 8 : (nd < 5640 ? 3072 + (nd - 5632) : (nd < 5664 ? nd : -1))); }
struct TJob { const float* W; int K, Nsrc, Ndst; bf16* WT; int mode; const float* Ak  ; const float* Sk  ; float* bp  ; };
DI float* bpart_of(unsigned char* ws, int l, int kind) { return (float*)(ws + WS_BPART) + (size_t)(l * 2 + kind) * 32 * 8192; }
DI void tr_load(const TJob& J, int item, int lane, float (&v)[64], int& sc) {
    const int nblk = J.Ndst / 64, kb = item / nblk, nb = item % nblk, k0 = 64 * kb, n0 = 64 * nb;
    const int ndl = n0 + lane;
    sc = (J.mode == 2) ? odd_src_col(ndl) : ndl;
    const int scl = sc >= 0 ? sc : 0;
#pragma unroll
    for (int i = 0; i < 64; ++i) { const float* rowp = J.W + (size_t)(k0 + i) * J.Nsrc; v[i] = __builtin_nontemporal_load(rowp + scl); }
    if (J.Ak) {
        const unsigned a_l = __builtin_bit_cast(unsigned, J.Ak[k0 + lane]), s_l = __builtin_bit_cast(unsigned, J.Sk[k0 + lane]);
        float part = 0.f;
#pragma unroll
        for (int i = 0; i < 64; ++i) { const float w = (sc >= 0) ? v[i] : 0.f;
            part = fmaf(__builtin_bit_cast(float, __builtin_amdgcn_readlane(s_l, i)), w, part); v[i] = w * __builtin_bit_cast(float, __builtin_amdgcn_readlane(a_l, i)); }
        J.bp[(size_t)kb * 8192 + ndl] = part; }
}
DI void tr_store(const TJob& J, int item, int lane, const float (&v)[64], int sc, LAS float* scr) {
    const int nblk = J.Ndst / 64, kb = item / nblk, nb = item % nblk, k0 = 64 * kb, n0 = 64 * nb;
#pragma unroll
    for (int i = 0; i < 64; ++i) scr[i * 65 + lane] = (sc >= 0) ? v[i] : 0.f;
    LDS_WAIT(); asm volatile("" ::: "memory");
    const int c = lane & 7;
#pragma unroll
    for (int j = 0; j < 8; ++j) { const int n = (lane >> 3) + 8 * j; const LAS float* s = scr + (8 * c) * 65 + n;
        v4u o; o.x = pk2(s[0 * 65], s[1 * 65]); o.y = pk2(s[2 * 65], s[3 * 65]); o.z = pk2(s[4 * 65], s[5 * 65]); o.w = pk2(s[6 * 65], s[7 * 65]);
        const int drow = (J.mode == 0) ? (n0 + n) : tile_perm_row(n0 + n);
        *(GAS v4u*)(J.WT + (size_t)drow * J.K + k0 + 8 * c) = o; }
    LDS_WAIT(); asm volatile("" ::: "memory");
}
DI void p0_transpose_item(const float* W, int K, int Nsrc, int Ndst, bf16* WT, LAS float* scr, int item, int lane, int mode) {
    const TJob J{W, K, Nsrc, Ndst, WT, mode, nullptr, nullptr, nullptr}; float v[64]; int sc; tr_load(J, item, lane, v, sc); tr_store(J, item, lane, v, sc, scr);
}
DI void transpose_job_item(const TJob& J, LAS float* scr, int item, int lane) { float v[64]; int sc; tr_load(J, item, lane, v, sc); tr_store(J, item, lane, v, sc, scr); }
DI float silu_f(float v) { return v / (1.f + expf(-v)); }

DI int conv_items(int l, int x) { return x == 0 ? (DM / 64) * (((l & 1) ? NO : NE) / 64) : (x == 1 ? (DM / 64) * (DM / 64) : (DM / 64) * (DFF / 64)); }
DI TJob conv_job(KA a, unsigned char* ws, int l, int x) {
    const int j = l >> 1; const bool odd = l & 1;
    unsigned char* wl = ws + WS_W + (size_t)l * W_LAYER; const float* mods = (const float*)(ws + WS_MODS) + (size_t)l * 6 * DM;
    if (x == 0) { if (!odd) return TJob{a->even_w_in + (size_t)j * DM * NE, DM, NE, NE, (bf16*)(wl + W_IN), 1, mods + 1 * DM, mods, bpart_of(ws, l, 0)};
                  return TJob{a->odd_w_in + (size_t)j * DM * NO_SRC, DM, NO_SRC, NO, (bf16*)(wl + W_IN), 2, mods + 1 * DM, mods, bpart_of(ws, l, 0)}; }
    if (x == 1) return TJob{(odd ? a->odd_w_out : a->even_w_out) + (size_t)j * DM * DM, DM, DM, DM, (bf16*)(wl + W_OUT), 0, nullptr, nullptr, nullptr};
    if (x == 2) return TJob{a->mlp_up + (size_t)l * DM * DFF, DM, DFF, DFF, (bf16*)(wl + W_UP), 0, mods + 4 * DM, mods + 3 * DM, bpart_of(ws, l, 1)};
    return TJob{a->mlp_down + (size_t)l * DFF * DM, DFF, DM, DM, (bf16*)(wl + W_DOWN), 0, nullptr, nullptr, nullptr};
}
DI void conv_item(KA a, unsigned char* ws, int l, int x, int item, LAS float* scr, int lane) { const TJob J = conv_job(a, ws, l, x); transpose_job_item(J, scr, item, lane); }
DI void p0_ada(KA a, const Ctx& C) {
    unsigned char* ws = a->ws;
    {
        LAS float* red = (LAS float*)(C.lds + RING_OFF);
        for (int u = blockIdx.x; u < 4 * 48; u += C.G) {
            const int l = u / 48, cg = u % 48;
            const float* Wb = a->ada_w + (size_t)l * DM * (6 * DM) + cg * 256 + 4 * C.lane;
            f32x4 acc = {0.f, 0.f, 0.f, 0.f};
            const int kbeg = C.wave * 256;
#pragma unroll 8
            for (int k = 0; k < 256; ++k) { const float sc = silu_f(a->c[kbeg + k]); const f32x4 w = *(const f32x4*)(Wb + (size_t)(kbeg + k) * (6 * DM)); acc += w * sc; }
            __syncthreads();
            *(LAS f32x4*)(red + C.wave * 256 + 4 * C.lane) = acc;
            __syncthreads();
            if (C.tid < 256) { float v = 0.f;
#pragma unroll
                for (int w = 0; w < 8; ++w) v += red[w * 256 + C.tid];
                const int j = cg * 256 + C.tid, sec = j / DM, col = j % DM;
                v += a->ada_b[(size_t)l * 6 * DM + j];
                if (sec == 1) v = a->norm_mix_g[l * DM + col] * (1.f + v);
                if (sec == 4) v = a->norm_mlp_g[l * DM + col] * (1.f + v);
                ((float*)(ws + WS_MODS))[(size_t)l * 6 * DM + j] = v; }
        }
        __syncthreads();
    }
}
DI void p0_convert(KA a, const Ctx& C) {
    unsigned char* ws = a->ws;
    {
        LAS float* scr = (LAS float*)(C.lds + RING_OFF + C.wave * 16640);
        constexpr int I_W1 = (4096 / 64) * (128 / 64), I_W2 = (128 / 64) * (128 / 64);
        const int n0 = conv_items(0, 0) + conv_items(0, 1) + conv_items(0, 2) + conv_items(0, 3), n1 = conv_items(1, 0);
        const int total = n0 + n1 + 4 * (I_W1 + I_W2);
        for (int it = C.gw; it < total; it += C.NGW) {
            if (it < n0) { int r = it, x = 0; while (r >= conv_items(0, x)) { r -= conv_items(0, x); ++x; } conv_item(a, ws, 0, x, r, scr, C.lane); }
            else if (it < n0 + n1) conv_item(a, ws, 1, 0, it - n0, scr, C.lane);
            else { int r = it - n0 - n1; const int q = r / (I_W1 + I_W2); r %= (I_W1 + I_W2); const int j = q >> 1, kind = q & 1;
                if (r < I_W1) p0_transpose_item((kind ? a->nsa_v_w1 : a->nsa_k_w1) + (size_t)j * 4096 * 128, 4096, 128, 128, (bf16*)(ws + WS_W1T) + (size_t)q * 128 * 4096, scr, r, C.lane, 0);
                else p0_transpose_item((kind ? a->nsa_v_w2 : a->nsa_k_w2) + (size_t)j * 128 * 128, 128, 128, 128, (bf16*)(ws + WS_W2T) + (size_t)q * 128 * 128, scr, r - I_W1, C.lane, 0); }
        }
    }
}

DI void resid_init_phase(const Ctx& C, const float* X, bf16* R, float* ss) {
    for (int m = C.gw; m < S; m += C.NGW) {
        const GAS f32x4* xr = (const GAS f32x4*)(X + (size_t)m * DM) + C.lane;
        f32x4 v[8]; float s = 0.f;
#pragma unroll
        for (int j = 0; j < 8; ++j) { v[j] = xr[64 * j]; s += (v[j].x * v[j].x + v[j].y * v[j].y) + (v[j].z * v[j].z + v[j].w * v[j].w); }
        const float tot = wave_sum(s);
        if (C.lane < 32) ss[(size_t)m * 32 + C.lane] = C.lane == 0 ? tot : 0.f;
        GAS unsigned long long* o8 = (GAS unsigned long long*)(R + (size_t)m * DM) + C.lane;
#pragma unroll
        for (int j = 0; j < 8; ++j) o8[64 * j] = (unsigned long long)pk2(v[j].x, v[j].y) | ((unsigned long long)pk2(v[j].z, v[j].w) << 32);
    }
}
DI bool tail_item(KA a, unsigned char* ws, LAS unsigned char* lds, int l, int which, int ti) {
    const bool n1 = l + 1 < DEPTH, n2 = l + 2 < DEPTH;
    int jl[4], jx[4], nj = 0;
    if (which == 0) { if (n1) { jl[nj] = l + 1; jx[nj++] = 1; jl[nj] = l + 1; jx[nj++] = 2; jl[nj] = l + 1; jx[nj++] = 3; } }
    else if (which == 1) { if (n2) { jl[nj] = l + 2; jx[nj++] = 0; } }
    else { if (n1) { jl[nj] = l + 1; jx[nj++] = 1; jl[nj] = l + 1; jx[nj++] = 2; jl[nj] = l + 1; jx[nj++] = 3; } if (n2) { jl[nj] = l + 2; jx[nj++] = 0; } }
    const int tid = tid_fresh(), lane = tid & 63, wave = __builtin_amdgcn_readfirstlane(tid >> 6);
    LAS float* scr = (LAS float*)(lds + RING_OFF + wave * 16640);
#pragma unroll
    for (int q = 0; q < 4; ++q) { if (q < nj) { const int cnt = conv_items(jl[q], jx[q]) >> 3; if (ti < cnt) { conv_item(a, ws, jl[q], jx[q], ti * 8 + wave, scr, lane); return true; } ti -= cnt; } }
    return false;
}
DI void final_norm_phase(const Ctx& C, float* X, const float* g) {
    for (int m = C.gw; m < S; m += C.NGW) {
        GAS f32x4* xr = (GAS f32x4*)(X + (size_t)m * DM) + C.lane;
        f32x4 v[8]; float s = 0.f;
#pragma unroll
        for (int j = 0; j < 8; ++j) { v[j] = xr[64 * j]; s += (v[j].x * v[j].x + v[j].y * v[j].y) + (v[j].z * v[j].z + v[j].w * v[j].w); }
        const float rstd = 1.f / sqrtf(wave_sum(s) * (1.f / DM) + NORM_EPS);
#pragma unroll
        for (int j = 0; j < 8; ++j) { const f32x4 gv = *((const f32x4*)g + 64 * j + C.lane); xr[64 * j] = v[j] * rstd * gv; }
    }
}


DI void kmean_phase(const Ctx& C, const bf16* QKV, bf16* KMH, bf16* KML) {
    LAS float* part = (LAS float*)(C.lds + RING_OFF);
    for (int u = blockIdx.x; u < 256; u += C.G) {
        const int h = u >> 5, blk = u & 31;
        const int dch = C.tid & 15, kg = C.tid >> 4;
        float s[8];
#pragma unroll
        for (int e = 0; e < 8; ++e) s[e] = 0.f;
#pragma unroll
        for (int i = 0; i < 8; ++i) { const v4u w = *(const GAS v4u*)(QKV + (size_t)(blk * 256 + kg * 8 + i) * NE + E_KA + h * 128 + dch * 8);
            s[0] += bf2f(w.x & 0xffffu); s[1] += bf2f(w.x >> 16); s[2] += bf2f(w.y & 0xffffu); s[3] += bf2f(w.y >> 16);
            s[4] += bf2f(w.z & 0xffffu); s[5] += bf2f(w.z >> 16); s[6] += bf2f(w.w & 0xffffu); s[7] += bf2f(w.w >> 16); }
        __syncthreads();
#pragma unroll
        for (int e = 0; e < 8; ++e) part[kg * 128 + dch * 8 + e] = s[e];
        __syncthreads();
        if (C.tid < 128) { float v = 0.f;
#pragma unroll
            for (int g = 0; g < 32; ++g) v += part[g * 128 + C.tid];
            v *= (1.f / 256.f);
            const unsigned hb = f2bf(v); const float lo = v - bf2f(hb);
            KMH[(size_t)u * 128 + C.tid] = (bf16)hb; KML[(size_t)u * 128 + C.tid] = (bf16)f2bf(lo); }
    }
    __syncthreads();
}

DI float log_sigmoid_f(float x) { const float t = __builtin_amdgcn_exp2f(-fabsf(x) * 1.4426950408889634f); return fminf(x, 0.f) - 0.6931471805599453f * __builtin_amdgcn_logf(1.f + t); }
DI float gelu_tanh_f(float x) { return 0.5f * x * (1.f + tanhf(0.7978845608028654f * (x + 0.044715f * x * x * x))); }
DI f32x4 mfma16(bf16x8 a, bf16x8 b, f32x4 c) { return __builtin_amdgcn_mfma_f32_16x16x32_bf16(a, b, c, 0, 0, 0); }

#ifndef OP_DUP
#define OP_DUP 0
#endif
DI void oddprep_phase(KA a, const Ctx& C, int j  ) {
    unsigned char* ws = a->ws;
    const float* FG = (const float*)(ws + WS_FG); float* CUM = (float*)(ws + WS_CUM);
    const bf16* QKV = (const bf16*)(ws + WS_QKV);
    for (int u = blockIdx.x; u < 8 + 128 + 64; u += C.G) {
      for (int oprep_ = 0; oprep_ < ((u >= 136 ? (OP_DUP & 4) : (u < 8 ? (OP_DUP & 1) : (OP_DUP & 2))) ? 2 : 1); ++oprep_) {
        if (u >= 8 + 128) {
            const int hw = (u - 136) >> 2, part = (u - 136) & 3, h = hw >> 1, which = hw & 1; const int col = (which ? O_KC : O_QC) + h * 128;
            LAS float* wm = (LAS float*)(C.lds + RING_OFF);
            float mx = 0.f;
#pragma unroll 2
            for (int r = part * 2048 + C.tid; r < part * 2048 + 2048; r += NWAVES * 64) { float ss = 0.f;
#pragma unroll
                for (int i = 0; i < 16; ++i) { const v4u w = *(const GAS v4u*)(QKV + (size_t)r * NO + col + 8 * i);
                    const float a0 = bf2f(w.x & 0xffffu), a1 = bf2f(w.x >> 16), a2 = bf2f(w.y & 0xffffu), a3 = bf2f(w.y >> 16), a4 = bf2f(w.z & 0xffffu), a5 = bf2f(w.z >> 16), a6 = bf2f(w.w & 0xffffu), a7 = bf2f(w.w >> 16);
                    ss += (a0 * a0 + a1 * a1) + (a2 * a2 + a3 * a3) + (a4 * a4 + a5 * a5) + (a6 * a6 + a7 * a7); }
                mx = fmaxf(mx, ss); }
#pragma unroll
            for (int o = 1; o < 64; o <<= 1) mx = fmaxf(mx, __shfl_xor(mx, o));
            __syncthreads();
            if (C.lane == 0) wm[C.wave] = mx;
            __syncthreads();
            if (C.tid == 0) { float m = 0.f; for (int w = 0; w < NWAVES; ++w) m = fmaxf(m, wm[w]);
                __hip_atomic_fetch_max((gu32*)(ws + WS_CTL) + CW_FOXN + 16 * j + h * 2 + which, __builtin_bit_cast(unsigned, sqrtf(m)), RLX_AGENT); }
            __syncthreads();
        } else if (u < 8) {
            const int h = u; const float fb = a->fox_forget_b[j * 8 + h];
            LAS float* wtot = (LAS float*)(C.lds + RING_OFF);
            float v[16]; float run = 0.f;
#pragma unroll
            for (int i = 0; i < 16; ++i) { run += log_sigmoid_f(FG[(size_t)h * S + C.tid * 16 + i] + fb); v[i] = run; }
            float sc = run;
#pragma unroll
            for (int o = 1; o < 64; o <<= 1) { const float n = __shfl_up(sc, o); if (C.lane >= o) sc += n; }
            __syncthreads();
            if (C.lane == 63) wtot[C.wave] = sc;
            __syncthreads();
            float base = sc - run;
            for (int w = 0; w < C.wave; ++w) base += wtot[w];
#pragma unroll
            for (int i = 0; i < 16; ++i) CUM[(size_t)h * S + C.tid * 16 + i] = base + v[i];
            __syncthreads();
        } else {
            const int cu = u - 8, kind = cu >> 6, hd = (cu >> 5) & 1, n0 = (cu & 31) * 16;
            const int srccol = (kind ? O_VCMP : O_KCMP) + hd * 128;
            const float* pos = (kind ? a->nsa_v_pos : a->nsa_k_pos) + (size_t)j * 32 * 128;
            const bf16* w1t = (const bf16*)(ws + WS_W1T) + (size_t)(j * 2 + kind) * 128 * 4096;
            const bf16* w2t = (const bf16*)(ws + WS_W2T) + (size_t)(j * 2 + kind) * 128 * 128;
            bf16* dst = (bf16*)(ws + (kind ? WS_VC : WS_KC));
            LAS float* red = (LAS float*)(C.lds + RING_OFF);
            LAS bf16* h1b = (LAS bf16*)(C.lds + RING_OFF + 65536);
            const int row = C.lane & 15, kg = C.lane >> 4;
            f32x4 acc[8];
#pragma unroll
            for (int cb = 0; cb < 8; ++cb) acc[cb] = (f32x4){0.f, 0.f, 0.f, 0.f};
#define CMP_LOAD(step_, w_, q0_, q1_, b_) do { const int l_ = C.wave * 4 + ((step_) >> 2), d_ = 32 * ((step_) & 3) + 8 * kg; int tok_ = 16 * (n0 + row) + l_; if (tok_ > S - 1) tok_ = S - 1; \
                w_ = *(const GAS v4u*)(QKV + (size_t)tok_ * NO + srccol + d_); q0_ = *(const f32x4*)(pos + l_ * 128 + d_); q1_ = *(const f32x4*)(pos + l_ * 128 + d_ + 4);          \
                _Pragma("unroll") for (int cb = 0; cb < 8; ++cb) b_[cb] = *(const GAS bf16x8*)(w1t + (size_t)(cb * 16 + row) * 4096 + l_ * 128 + d_); } while (0)
#define CMP_MMA(w_, q0_, q1_, b_) do { v4u aw; aw.x = pk2(bf2f(w_.x & 0xffffu) + q0_.x, bf2f(w_.x >> 16) + q0_.y); aw.y = pk2(bf2f(w_.y & 0xffffu) + q0_.z, bf2f(w_.y >> 16) + q0_.w);                 \
                aw.z = pk2(bf2f(w_.z & 0xffffu) + q1_.x, bf2f(w_.z >> 16) + q1_.y); aw.w = pk2(bf2f(w_.w & 0xffffu) + q1_.z, bf2f(w_.w >> 16) + q1_.w);                                            \
                const bf16x8 af = __builtin_bit_cast(bf16x8, aw); _Pragma("unroll") for (int cb = 0; cb < 8; ++cb) acc[cb] = mfma16(af, b_[cb], acc[cb]); } while (0)
            { v4u wa, wb; f32x4 pa0, pa1, pb0, pb1; bf16x8 ba[8], bb[8];
              CMP_LOAD(0, wa, pa0, pa1, ba);
#pragma unroll 1
              for (int st = 0; st < 16; st += 2) { CMP_LOAD(st + 1, wb, pb0, pb1, bb); CMP_MMA(wa, pa0, pa1, ba); if (st + 2 < 16) CMP_LOAD(st + 2, wa, pa0, pa1, ba); CMP_MMA(wb, pb0, pb1, bb); } }
#undef CMP_LOAD
#undef CMP_MMA
            __syncthreads();
#pragma unroll
            for (int cb = 0; cb < 8; ++cb)
#pragma unroll
                for (int e = 0; e < 4; ++e) red[(C.wave * 16 + 4 * kg + e) * 128 + cb * 16 + row] = acc[cb][e];
            __syncthreads();
            for (int e = C.tid; e < 16 * 128; e += NWAVES * 64) { float v = 0.f;
#pragma unroll
                for (int w = 0; w < 8; ++w) v += red[w * 2048 + e];
                h1b[(e >> 7) * 136 + (e & 127)] = (bf16)f2bf(gelu_tanh_f(v)); }
            __syncthreads();
            {
                f32x4 o = {0.f, 0.f, 0.f, 0.f};
#pragma unroll
                for (int ks = 0; ks < 4; ++ks) { const bf16x8 af = *(const LAS bf16x8*)(h1b + row * 136 + 32 * ks + 8 * kg);
                    const bf16x8 bfr = *(const GAS bf16x8*)(w2t + (size_t)(C.wave * 16 + row) * 128 + 32 * ks + 8 * kg);
                    o = mfma16(af, bfr, o); }
#pragma unroll
                for (int e = 0; e < 4; ++e) { const int n = n0 + 4 * kg + e; dst[(size_t)n * 256 + hd * 128 + C.wave * 16 + row] = (n < NCMP) ? (bf16)f2bf(o[e]) : (bf16)0; }
            }
            __syncthreads();
        }
      }
    }
}

DI void moba_combine_phase(const Ctx& C, const bf16* PO, const float* PML, bf16* O) {
    constexpr float C2 = 0.08838834764831845f * 1.4426950408889634f;
    for (int item = C.gw; item < 8 * S; item += C.NGW) {
        const int token = item >> 3, h = item & 7; const int nsel = (token >> 8) < 3 ? (token >> 8) : 3;
        const size_t pb = ((size_t)h * S + token) * 4;
        const f32x4 ml01 = *(const f32x4*)(PML + pb * 2), ml23 = *(const f32x4*)(PML + pb * 2 + 4);
        const float m0 = ml01.x, l0 = ml01.y, m1 = ml01.z, l1 = ml01.w, m2 = ml23.x, l2 = ml23.y, m3 = ml23.z, l3 = ml23.w;
        float M = m3; if (nsel > 0) M = fmaxf(M, m0); if (nsel > 1) M = fmaxf(M, m1); if (nsel > 2) M = fmaxf(M, m2);
        const float w3 = l3 * __builtin_amdgcn_exp2f((m3 - M) * C2);
        const float w0 = nsel > 0 ? l0 * __builtin_amdgcn_exp2f((m0 - M) * C2) : 0.f, w1 = nsel > 1 ? l1 * __builtin_amdgcn_exp2f((m1 - M) * C2) : 0.f, w2 = nsel > 2 ? l2 * __builtin_amdgcn_exp2f((m2 - M) * C2) : 0.f;
        const GAS unsigned* po = (const GAS unsigned*)(PO + pb * 128) + C.lane;
        const unsigned u3 = po[3 * 64]; float a0 = w3 * bf2f(u3 & 0xffffu), a1 = w3 * bf2f(u3 >> 16);
        if (nsel > 0) { const unsigned u = po[0]; a0 += w0 * bf2f(u & 0xffffu); a1 += w0 * bf2f(u >> 16); }
        if (nsel > 1) { const unsigned u = po[64]; a0 += w1 * bf2f(u & 0xffffu); a1 += w1 * bf2f(u >> 16); }
        if (nsel > 2) { const unsigned u = po[128]; a0 += w2 * bf2f(u & 0xffffu); a1 += w2 * bf2f(u >> 16); }
        const float inv = 1.f / (w0 + w1 + w2 + w3);
        *((GAS unsigned*)(O + (size_t)token * DM + h * 128) + C.lane) = pk2(a0 * inv, a1 * inv);
    }
}

namespace att {
#ifndef FOX_SKIP
#define FOX_SKIP 1
#endif
#ifndef NSA_DUP
#define NSA_DUP 0
#endif
constexpr float SCALE = 0.08838834764831845f, LOG2E = 1.4426950408889634f, C2 = SCALE * LOG2E, INV_SCALE = 11.313708498984761f;
constexpr float THR = 8.f;
constexpr int KVBLK = 64, SHM_K = 16384, SHM_V = 16384;
constexpr int L_V = 0, L_K = 2 * SHM_V, L_WS = 65536, L_BIAS = L_WS + 2048, L_MISC = L_BIAS + 512, L_IMP = L_MISC + 1536, IMP_STRIDE = 132, L_SEL = L_IMP + 64 * IMP_STRIDE * 4, L_END = L_SEL + 1024;
static_assert(L_END <= RING_BYTES, "attention LDS map");
#define KSWZ(row, colB) ((row) * 256 + ((colB) ^ (((row) & 15) << 4)))
#define SBAR() __builtin_amdgcn_sched_barrier(0)
DI int v_st(int k, int c) { const int kk = (k & ~0xC) | ((k & 4) << 1) | ((k & 8) >> 1); return ((kk >> 3) * 4 + (c >> 5)) * 512 + ((kk & 7) * 32 + (c & 31)) * 2; }
DI int v_rd_base(int lane) { return ((lane & 3) << 3) | (((lane >> 2) & 3) << 6) | (((lane >> 4) & 1) << 5) | (((lane >> 5) & 1) << 8); }
constexpr int v_rd_off(int d0, int ks, int half) { return d0 * 512 + ks * 4096 + half * 2048; }
DI int crow(int r, int hi) { return (r & 3) + 8 * (r >> 2) + 4 * hi; }
DI unsigned cvtpk(float lo, float hi) { unsigned r; asm volatile("v_cvt_pk_bf16_f32 %0, %1, %2" : "=v"(r) : "v"(lo), "v"(hi)); return r; }

struct Cx {
    LAS char* lds; int tid, wid, lane, r32, hi, sr, sc, kws, vst0, vst1, vb0; LAS float* li_l; LAS float* al_l;
};
DI Cx make_cx(LAS unsigned char* lds_) {
    Cx c; c.lds = (LAS char*)lds_; c.tid = tid_fresh(); c.wid = __builtin_amdgcn_readfirstlane(c.tid >> 6); c.lane = c.tid & 63; c.r32 = c.lane & 31; c.hi = c.lane >> 5;
    c.sr = c.tid >> 4; c.sc = (c.tid & 15) * 8; c.kws = KSWZ(c.sr, c.sc * 2); c.vst0 = v_st(c.sr, c.sc); c.vst1 = v_st(32 + c.sr, c.sc);
    c.vb0 = (int)(unsigned)(uintptr_t)(c.lds + L_V) + v_rd_base(c.lane);
    c.li_l = (LAS float*)(c.lds + L_WS) + c.wid * 64; c.al_l = c.li_l + 32;
    return c;
}
struct Stage { bf16x8 k0, k1, v0, v1; float ex; };

DI void qkt(f32x16& p0, f32x16& p1, const LAS char* Kb, int r32, int hi, const bf16x8* qr) {
#pragma unroll
    for (int r = 0; r < 16; ++r) { p0[r] = 0.f; p1[r] = 0.f; }
    const LAS char* kbase = Kb + r32 * 256; const int xs = ((r32 & 15) ^ hi) << 4;
#pragma unroll
    for (int d0 = 0; d0 < 8; ++d0) { const LAS char* a = kbase + ((d0 * 32) ^ xs);
        const bf16x8 b0 = *(const LAS bf16x8*)a, b1 = *(const LAS bf16x8*)(a + 32 * 256);
        p0 = __builtin_amdgcn_mfma_f32_32x32x16_bf16(b0, qr[d0], p0, 0, 0, 0);
        p1 = __builtin_amdgcn_mfma_f32_32x32x16_bf16(b1, qr[d0], p1, 0, 0, 0); }
}
DI void partialSM(f32x16& p0, f32x16& p1, float& m_reg, float& mn, float& alpha) {
    float pmax = p0[0];
#pragma unroll
    for (int r = 1; r < 16; ++r) pmax = fmaxf(pmax, p0[r]);
#pragma unroll
    for (int r = 0; r < 16; ++r) pmax = fmaxf(pmax, p1[r]);
    { auto rr = __builtin_amdgcn_permlane32_swap(__float_as_uint(pmax), __float_as_uint(pmax), false, false);
      pmax = fmaxf(__uint_as_float(rr[0]), __uint_as_float(rr[1])); }
    if (__builtin_expect(__all((pmax - m_reg) * SCALE <= THR), 1)) { mn = m_reg; alpha = 1.f; }
    else { mn = fmaxf(m_reg, pmax); alpha = __builtin_amdgcn_exp2f((m_reg - mn) * C2); m_reg = mn; }
    const float mnL = -mn * C2;
#pragma unroll
    for (int r = 0; r < 16; ++r) p0[r] = fmaf(p0[r], C2, mnL);
#pragma unroll
    for (int r = 0; r < 16; ++r) p1[r] = fmaf(p1[r], C2, mnL);
#pragma unroll
    for (int r = 0; r < 16; ++r) p0[r] = __builtin_amdgcn_exp2f(p0[r]);
}
DI void pack_p(const f32x16& p0, const f32x16& p1, bf16x8& pa0, bf16x8& pa1, bf16x8& pa2, bf16x8& pa3) {
#define PK4(P, B_, OUT) do { unsigned a0 = cvtpk(P[B_+0], P[B_+1]), a1 = cvtpk(P[B_+2], P[B_+3]);                          \
        unsigned b0 = cvtpk(P[B_+4], P[B_+5]), b1 = cvtpk(P[B_+6], P[B_+7]);                                             \
        auto r0 = __builtin_amdgcn_permlane32_swap(a0, b0, false, false); auto r1 = __builtin_amdgcn_permlane32_swap(a1, b1, false, false); \
        v4u w = {r0[0], r1[0], r0[1], r1[1]}; OUT = __builtin_bit_cast(bf16x8, w); } while (0)
    PK4(p0, 0, pa0); PK4(p0, 8, pa1); PK4(p1, 0, pa2); PK4(p1, 8, pa3);
#undef PK4
}
DI void finishSM(f32x16& p0, f32x16& p1, float alpha, float& l_reg, bf16x8& pa0, bf16x8& pa1, bf16x8& pa2, bf16x8& pa3) {
#pragma unroll
    for (int r = 0; r < 16; ++r) p1[r] = __builtin_amdgcn_exp2f(p1[r]);
    float ps = 0;
#pragma unroll
    for (int r = 0; r < 16; ++r) ps += p0[r];
#pragma unroll
    for (int r = 0; r < 16; ++r) ps += p1[r];
    { auto rr = __builtin_amdgcn_permlane32_swap(__float_as_uint(ps), __float_as_uint(ps), false, false);
      ps = __uint_as_float(rr[0]) + __uint_as_float(rr[1]); }
    l_reg = l_reg * alpha + ps;
    pack_p(p0, p1, pa0, pa1, pa2, pa3);
}
DI void pv_tile(f32x16* o, int vb0, bf16x8 pa0, bf16x8 pa1, bf16x8 pa2, bf16x8 pa3) {
#define TRRD(dst, off) asm volatile("ds_read_b64_tr_b16 %0, %1 offset:%2" : "=&v"(dst) : "v"(vb0), "i"(off) : "memory")
#define PV_D0(d0) do { s16x4 l0, l1, l2, l3, h0, h1, h2, h3; constexpr int b_ = v_rd_off(d0, 0, 0); \
        TRRD(l0, b_); TRRD(h0, b_ + 2048); TRRD(l1, b_ + 4096); TRRD(h1, b_ + 6144); TRRD(l2, b_ + 8192); TRRD(h2, b_ + 10240); TRRD(l3, b_ + 12288); TRRD(h3, b_ + 14336); \
        asm volatile("s_waitcnt lgkmcnt(0)" ::: "memory"); SBAR();   \
        o[d0] = __builtin_amdgcn_mfma_f32_32x32x16_bf16(pa0, (bf16x8){l0[0], l0[1], l0[2], l0[3], h0[0], h0[1], h0[2], h0[3]}, o[d0], 0, 0, 0);   \
        o[d0] = __builtin_amdgcn_mfma_f32_32x32x16_bf16(pa1, (bf16x8){l1[0], l1[1], l1[2], l1[3], h1[0], h1[1], h1[2], h1[3]}, o[d0], 0, 0, 0);   \
        o[d0] = __builtin_amdgcn_mfma_f32_32x32x16_bf16(pa2, (bf16x8){l2[0], l2[1], l2[2], l2[3], h2[0], h2[1], h2[2], h2[3]}, o[d0], 0, 0, 0);   \
        o[d0] = __builtin_amdgcn_mfma_f32_32x32x16_bf16(pa3, (bf16x8){l3[0], l3[1], l3[2], l3[3], h3[0], h3[1], h3[2], h3[3]}, o[d0], 0, 0, 0); } while (0)
    PV_D0(0); PV_D0(1); PV_D0(2); PV_D0(3);
#undef PV_D0
#undef TRRD
}
DI void rescale_o(const Cx& c, f32x16* o, float alpha) {
    if (__any(alpha < 1.f)) { if (c.hi == 0) c.al_l[c.r32] = alpha; asm volatile("s_waitcnt lgkmcnt(0)" ::: "memory");
#pragma unroll
        for (int d = 0; d < 4; ++d)
#pragma unroll
            for (int r = 0; r < 16; ++r) o[d][r] *= c.al_l[crow(r, c.hi)];
    }
}
DI void mask_tile(f32x16& p0, f32x16& p1, int dq, unsigned W) {
    const float NEG = -__builtin_inff();
#pragma unroll
    for (int r = 0; r < 16; ++r) { const int cc = (r & 3) + 8 * (r >> 2);
        if ((unsigned)(dq - cc) >= W) p0[r] = NEG;
        if ((unsigned)(dq - cc - 32) >= W) p1[r] = NEG; }
}
DI void kill_tile(f32x16& p0, f32x16& p1) { const float NEG = -__builtin_inff();
#pragma unroll
    for (int r = 0; r < 16; ++r) { p0[r] = NEG; p1[r] = NEG; } }

template <int MODE, class P>
DI void run(const Cx& c, P& prob, const bf16x8* qr, float& m_reg, float& l_reg, f32x16* o) {
    const int nt = prob.ntiles();
    if (nt <= 0) return;
    Stage st;
    { const bf16 *kp, *vp; int kpitch, vpitch; prob.src(0, kp, vp, kpitch, vpitch);
      st.k0 = *(const GAS bf16x8*)(kp + (size_t)c.sr * kpitch + c.sc); st.k1 = *(const GAS bf16x8*)(kp + (size_t)(32 + c.sr) * kpitch + c.sc);
      if (MODE == 0) { st.v0 = *(const GAS bf16x8*)(vp + (size_t)c.sr * vpitch + c.sc); st.v1 = *(const GAS bf16x8*)(vp + (size_t)(32 + c.sr) * vpitch + c.sc); }
      st.ex = prob.extra(0); }
    const float inv_l = (MODE == 1) ? (l_reg > 0.f ? 1.f / l_reg : 0.f) : 0.f;
    for (int t = 0; t < nt; ++t) {
        const int buf = t & 1;
        *(LAS bf16x8*)(c.lds + L_K + buf * SHM_K + c.kws) = st.k0; *(LAS bf16x8*)(c.lds + L_K + buf * SHM_K + c.kws + 32 * 256) = st.k1;
        if (MODE == 0) { *(LAS bf16x8*)(c.lds + L_V + buf * SHM_V + c.vst0) = st.v0; *(LAS bf16x8*)(c.lds + L_V + buf * SHM_V + c.vst1) = st.v1; }
        prob.put_extra(t, buf, st.ex);
        __syncthreads();
        if (t + 1 < nt) { const bf16 *kp, *vp; int kpitch, vpitch; prob.src(t + 1, kp, vp, kpitch, vpitch);
            st.k0 = *(const GAS bf16x8*)(kp + (size_t)c.sr * kpitch + c.sc); st.k1 = *(const GAS bf16x8*)(kp + (size_t)(32 + c.sr) * kpitch + c.sc);
            if (MODE == 0) { st.v0 = *(const GAS bf16x8*)(vp + (size_t)c.sr * vpitch + c.sc); st.v1 = *(const GAS bf16x8*)(vp + (size_t)(32 + c.sr) * vpitch + c.sc); }
            st.ex = prob.extra(t + 1); }
        if (prob.active(t)) {
            f32x16 p0, p1;
            qkt(p0, p1, c.lds + L_K + buf * SHM_K, c.r32, c.hi, qr);
            prob.mask(p0, p1, t, buf);
            if (MODE == 0) {
                float mn, alpha; partialSM(p0, p1, m_reg, mn, alpha);
                rescale_o(c, o, alpha);
                bf16x8 pa0, pa1, pa2, pa3; finishSM(p0, p1, alpha, l_reg, pa0, pa1, pa2, pa3);
                pv_tile(o, c.vb0 + buf * SHM_V, pa0, pa1, pa2, pa3);
            } else {
                const float mnL = -m_reg * C2;
#pragma unroll
                for (int r = 0; r < 16; ++r) { p0[r] = __builtin_amdgcn_exp2f(fmaf(p0[r], C2, mnL)) * inv_l; p1[r] = __builtin_amdgcn_exp2f(fmaf(p1[r], C2, mnL)) * inv_l; }
                prob.post(p0, p1, t, true);
            }
        } else if (MODE == 1) { f32x16 z0, z1; prob.post(z0, z1, t, false); }
    }
    __syncthreads();
}

DI void load_q(bf16x8* qr, const bf16* Q, int pitch, int token, int col, int hi) {
#pragma unroll
    for (int d0 = 0; d0 < 8; ++d0) qr[d0] = *(const GAS bf16x8*)(Q + (size_t)token * pitch + col + d0 * 16 + hi * 8);
}
DI void row_coefs(const Cx& c, float coef, float* rc) {
    if (c.hi == 0) c.li_l[c.r32] = coef; asm volatile("s_waitcnt lgkmcnt(0)" ::: "memory");
#pragma unroll
    for (int r = 0; r < 16; ++r) rc[r] = c.li_l[crow(r, c.hi)];
    asm volatile("s_waitcnt lgkmcnt(0)" ::: "memory");
}
template <bool GQA>
DI void store_o(const Cx& c, const f32x16* o, const float* rc, bf16* O, int tok0  , int col0  ) {
#pragma unroll
    for (int r = 0; r < 16; ++r) { const int rr = crow(r, c.hi);
        const int token = GQA ? tok0 + (rr >> 2) : tok0 + rr; const int col = GQA ? col0 + (rr & 3) * 128 : col0;
#pragma unroll
        for (int d0 = 0; d0 < 4; ++d0) { const float v = o[d0][r] * rc[r]; const float vn = __shfl_xor(v, 1);
            if ((c.r32 & 1) == 0) *(GAS unsigned*)(O + (size_t)token * DM + col + d0 * 32 + c.r32) = cvtpk(v, vn); } }
}

DI void moba_gate_unit(LAS unsigned char* lds_, const bf16* QKV, const bf16* KMH, const bf16* KML, gu32* cnt  , unsigned* list  , int h, int qb) {
    if (qb == 0) return;
    const Cx c = make_cx(lds_);
    const int P0 = qb * 256, token = P0 + c.wid * 32 + c.r32;
    bf16x8 qr[8]; load_q(qr, QKV, NE, token, E_QA + h * 128, c.hi);
    unsigned taken = 0u;
    {
        f32x16 g;
#pragma unroll
        for (int r = 0; r < 16; ++r) g[r] = 0.f;
#pragma unroll
        for (int d0 = 0; d0 < 8; ++d0) { const size_t off = ((size_t)h * 32 + c.r32) * 128 + d0 * 16 + c.hi * 8;
            const bf16x8 kh = *(const GAS bf16x8*)(KMH + off), kl = *(const GAS bf16x8*)(KML + off);
            g = __builtin_amdgcn_mfma_f32_32x32x16_bf16(kh, qr[d0], g, 0, 0, 0); g = __builtin_amdgcn_mfma_f32_32x32x16_bf16(kl, qr[d0], g, 0, 0, 0); }
        const float NEG = -__builtin_inff();
#pragma unroll
        for (int it = 0; it < (BREAK == 6 ? 2 : 3); ++it) { float best = NEG; int bi = 99;
#pragma unroll
            for (int r = 0; r < 16; ++r) { const int b = crow(r, c.hi); const float v = (b < qb && !((taken >> b) & 1u)) ? g[r] : NEG; if (v > best) { best = v; bi = b; } }
            const float ob = __shfl_xor(best, 32); const int obi = __shfl_xor(bi, 32);
            if (ob > best || (ob == best && obi < bi)) { best = ob; bi = obi; }
            if (best > NEG) taken |= 1u << bi; }
    }
    const unsigned lt = (1u << c.r32) - 1u;
    unsigned my_n = 0u;
    for (int j = 0; j < qb; ++j) { const unsigned long long b = __ballot(c.hi == 0 && ((taken >> j) & 1u)); if (c.lane == j) my_n = (unsigned)__popcll(b); }
    unsigned base = 0u;
    if (c.lane < qb && my_n) base = __hip_atomic_fetch_add(cnt + h * 32 + c.lane, my_n, RLX_AGENT);
    for (int j = 0; j < qb; ++j) { const bool sl = c.hi == 0 && ((taken >> j) & 1u); const unsigned m = (unsigned)__ballot(sl); const unsigned bj = __shfl(base, j);
        if (sl) list[((size_t)h * 32 + j) * 8192 + bj + __popc(m & lt)] = (unsigned)token | ((unsigned)__popc(taken & ((1u << j) - 1u)) << 16); }
}
struct BlkProb {
    const bf16* QKV; int h, key0, causal, qlo, qpos, hi; bool wact  ;
    DI int ntiles() const { return 4; }
    DI void src(int t, const bf16*& k, const bf16*& v, int& kp, int& vp) const { const size_t kk = (size_t)(key0 + t * 64); k = QKV + kk * NE + E_KA + h * 128; v = QKV + kk * NE + E_VA + h * 128; kp = NE; vp = NE; }
    DI float extra(int) const { return 0.f; }
    DI void put_extra(int, int, float) const {}
    DI bool active(int t) const { return causal ? (key0 + t * 64 <= qlo + 31) : wact; }
    DI void mask(f32x16& p0, f32x16& p1, int t, int) const { if (causal) { const int kb = key0 + t * 64; if (kb + 63 > qlo) mask_tile(p0, p1, qpos - 4 * hi - kb, 0x7fffffffu); } }
    DI void post(f32x16&, f32x16&, int, bool) const {}
};
DI void moba_blk_unit(LAS unsigned char* lds_, const bf16* QKV, const gu32* cnt, const unsigned* list, bf16* PO, float* PML, int h, int j, int r) {
    const Cx c = make_cx(lds_);
    int token, slot; bool valid = true;
    if (r < 0) { token = j * 256 + c.wid * 32 + c.r32; slot = 3; }
    else { const int n = (int)cnt[h * 32 + j], row = r * 256 + c.wid * 32 + c.r32; valid = row < n;
        const unsigned e = list[((size_t)h * 32 + j) * 8192 + (valid ? row : 0)]; token = (int)(e & 0xffffu); slot = (int)(e >> 16); }
    bf16x8 qr[8]; load_q(qr, QKV, NE, token, E_QA + h * 128, c.hi);
    BlkProb pr; pr.QKV = QKV; pr.h = h; pr.key0 = j * 256; pr.causal = r < 0 ? 1 : 0; pr.qlo = j * 256 + c.wid * 32; pr.qpos = token; pr.hi = c.hi; pr.wact = __any(valid);
    float m_reg = -1e30f, l_reg = 0.f; f32x16 o[4];
#pragma unroll
    for (int d = 0; d < 4; ++d)
#pragma unroll
        for (int q = 0; q < 16; ++q) o[d][q] = 0.f;
    run<0>(c, pr, qr, m_reg, l_reg, o);
    const int dest = valid ? (((h * 8192 + token) << 2) + slot) : -1;
    if (valid && c.hi == 0) { GAS float* ml = (GAS float*)PML + (size_t)dest * 2; ml[0] = m_reg; ml[1] = l_reg; }
    float rc[16]; row_coefs(c, l_reg > 0.f ? 1.f / l_reg : 0.f, rc);
    int dst[16];
    { LAS int* il = (LAS int*)c.li_l; if (c.hi == 0) il[c.r32] = dest; asm volatile("s_waitcnt lgkmcnt(0)" ::: "memory");
#pragma unroll
      for (int q = 0; q < 16; ++q) dst[q] = il[crow(q, c.hi)];
      asm volatile("s_waitcnt lgkmcnt(0)" ::: "memory"); }
#pragma unroll
    for (int q = 0; q < 16; ++q) {
#pragma unroll
        for (int d0 = 0; d0 < 4; ++d0) { const float v = o[d0][q] * rc[q]; const float vn = __shfl_xor(v, 1);
            if ((c.r32 & 1) == 0 && dst[q] >= 0) *(GAS unsigned*)(PO + (size_t)dst[q] * 128 + d0 * 32 + c.r32) = cvtpk(v, vn); } }
}

struct WinProb {
    const bf16* QKV; int pitch, kcol, vcol, t0  , nt, qlo  , qpos, hi; unsigned W;
    DI int ntiles() const { return nt; }
    DI void src(int t, const bf16*& k, const bf16*& v, int& kp, int& vp) const { const size_t key0 = (size_t)(t0 + t) * 64; k = QKV + key0 * pitch + kcol; v = QKV + key0 * pitch + vcol; kp = pitch; vp = pitch; }
    DI float extra(int) const { return 0.f; }
    DI void put_extra(int, int, float) const {}
    DI bool active(int t) const { const int kb = (t0 + t) * 64; return kb <= qlo + 7 && kb + 63 >= qlo - (int)W + 1; }
    DI void mask(f32x16& p0, f32x16& p1, int t, int) const { const int kb = (t0 + t) * 64; if (kb + 63 > qlo || kb <= qlo + 7 - (int)W) mask_tile(p0, p1, qpos - 4 * hi - kb, W); }
    DI void post(f32x16&, f32x16&, int, bool) const {}
};
DI void swa_unit(LAS unsigned char* lds_, const bf16* QKV, const float* sinks, bf16* O, int kvh, int ch) {
    const Cx c = make_cx(lds_);
    const int T0 = ch * 64, token = T0 + c.wid * 8 + (c.r32 >> 2), hq = kvh * 4 + (c.r32 & 3);
    bf16x8 qr[8]; load_q(qr, QKV, NE, token, E_QB + hq * 128, c.hi);
    WinProb pr; pr.QKV = QKV; pr.pitch = NE; pr.kcol = E_KB + kvh * 128; pr.vcol = E_VB + kvh * 128; pr.t0 = ch >= 2 ? ch - 2 : 0; pr.nt = ch + 1 - pr.t0;
    pr.qlo = T0 + c.wid * 8; pr.qpos = token; pr.hi = c.hi; pr.W = 128u;
    float m_reg = sinks[hq] * INV_SCALE, l_reg = 1.f; f32x16 o[4];
#pragma unroll
    for (int d = 0; d < 4; ++d)
#pragma unroll
        for (int r = 0; r < 16; ++r) o[d][r] = 0.f;
    run<0>(c, pr, qr, m_reg, l_reg, o);
    float rc[16]; row_coefs(c, 1.f / l_reg, rc);
    store_o<true>(c, o, rc, O, T0 + c.wid * 8, 1024 + kvh * 512);
}

struct FoxProb {
    const bf16* QKV; const float* cum  ; float cb; int h, qb, qlo, qpos, hi, tid, a0  ; const LAS float* bias;
    DI int ntiles() const { return 4 * (qb + 1) - a0; }
    DI void src(int t, const bf16*& k, const bf16*& v, int& kp, int& vp) const { const size_t key0 = (size_t)(a0 + t) * 64; k = QKV + key0 * NO + O_KC + h * 128; v = QKV + key0 * NO + O_VC + h * 128; kp = NO; vp = NO; }
    DI float extra(int t) const { return tid < 64 ? cum[(a0 + t) * 64 + tid] : 0.f; }
    DI void put_extra(int, int buf, float ex) const { if (tid < 64) ((LAS float*)bias)[buf * 64 + tid] = (cb - ex) * INV_SCALE; }
    DI bool active(int t) const { return (a0 + t) * 64 <= qlo + 31; }
    DI void mask(f32x16& p0, f32x16& p1, int t, int buf) const {
        const LAS float* b = bias + buf * 64 + 4 * hi;
#pragma unroll
        for (int g = 0; g < 4; ++g) { const f32x4 b0 = *(const LAS f32x4*)(b + 8 * g), b1 = *(const LAS f32x4*)(b + 32 + 8 * g);
#pragma unroll
            for (int e = 0; e < 4; ++e) { p0[4 * g + e] += b0[e]; p1[4 * g + e] += b1[e]; } }
        const int kb = (a0 + t) * 64; if (kb + 63 > qlo) mask_tile(p0, p1, qpos + (BREAK == 8 ? 1 : 0) - 4 * hi - kb, 0x7fffffffu);
    }
    DI void post(f32x16&, f32x16&, int, bool) const {}
};
DI void fox_unit(LAS unsigned char* lds_, const bf16* QKV, const float* CUM, const float* FOXN, bf16* O, int h, int qb) {
    const Cx c = make_cx(lds_);
    const int P0 = qb * 256, token = P0 + c.wid * 32 + c.r32;
    bf16x8 qr[8]; load_q(qr, QKV, NO, token, O_QC + h * 128, c.hi);
    FoxProb pr; pr.QKV = QKV; pr.cum = CUM + (size_t)h * S; pr.cb = pr.cum[P0]; pr.h = h; pr.qb = qb; pr.qlo = P0 + c.wid * 32; pr.qpos = token; pr.hi = c.hi; pr.tid = c.tid;
    pr.bias = (const LAS float*)(c.lds + L_BIAS);
    {
        LAS int* a0w = (LAS int*)(c.lds + L_MISC);
        float dl = 0.f;
#pragma unroll
        for (int d0 = 0; d0 < 8; ++d0) { const v4u kw = *(const GAS v4u*)(QKV + (size_t)token * NO + O_KC + h * 128 + d0 * 16 + c.hi * 8); const v4u qw = __builtin_bit_cast(v4u, qr[d0]);
            dl += bf2f(qw.x & 0xffffu) * bf2f(kw.x & 0xffffu) + bf2f(qw.x >> 16) * bf2f(kw.x >> 16) + bf2f(qw.y & 0xffffu) * bf2f(kw.y & 0xffffu) + bf2f(qw.y >> 16) * bf2f(kw.y >> 16);
            dl += bf2f(qw.z & 0xffffu) * bf2f(kw.z & 0xffffu) + bf2f(qw.z >> 16) * bf2f(kw.z >> 16) + bf2f(qw.w & 0xffffu) * bf2f(kw.w & 0xffffu) + bf2f(qw.w >> 16) * bf2f(kw.w >> 16); }
        dl = (dl + __shfl_xor(dl, 32)) * SCALE;
#pragma unroll
        for (int ofs = 1; ofs < 32; ofs <<= 1) dl = fminf(dl, __shfl_xor(dl, ofs));
        LAS float* dmin = (LAS float*)(c.lds + L_MISC) + 16;
        if (c.lane == 0) dmin[c.wid] = dl;
        if (c.tid == 0) *a0w = 4 * qb;
        __syncthreads();
        float dlmin = dmin[0];
#pragma unroll
        for (int w = 1; w < NWAVES; ++w) dlmin = fminf(dlmin, dmin[w]);
        const float Bqk = FOXN[h * 2] * FOXN[h * 2 + 1] * SCALE * 1.01f + 1.f;
        const float thr = 110.f + Bqk - fmaxf(fminf(dlmin, Bqk), -Bqk) + 1.f;
        if (c.tid < 4 * qb && pr.cb - pr.cum[c.tid * 64 + 63] >= -thr) __hip_atomic_fetch_min(a0w, c.tid, __ATOMIC_RELAXED, __HIP_MEMORY_SCOPE_WORKGROUP);
        __syncthreads();
        pr.a0 = FOX_SKIP ? *a0w : 0;
        __syncthreads();
    }
    float m_reg = -1e30f, l_reg = 0.f; f32x16 o[4];
#pragma unroll
    for (int d = 0; d < 4; ++d)
#pragma unroll
        for (int r = 0; r < 16; ++r) o[d][r] = 0.f;
    run<0>(c, pr, qr, m_reg, l_reg, o);
    float rc[16]; row_coefs(c, l_reg > 0.f ? 1.f / l_reg : 0.f, rc);
    store_o<false>(c, o, rc, O, P0 + c.wid * 32, h * 128);
}

struct CmpProb {
    const bf16* KC; const bf16* VC; int kvh, nt, nmax  , wnmax  , hi, r32, wid; LAS float* imp; float carry;
    DI int ntiles() const { return nt; }
    DI void src(int t, const bf16*& k, const bf16*& v, int& kp, int& vp) const { k = KC + (size_t)t * 64 * 256 + kvh * 128; v = VC + (size_t)t * 64 * 256 + kvh * 128; kp = 256; vp = 256; }
    DI float extra(int) const { return 0.f; }
    DI void put_extra(int, int, float) const {}
    DI bool active(int t) const { return t * 64 <= wnmax; }
    DI void mask(f32x16& p0, f32x16& p1, int t, int) const { mask_tile(p0, p1, nmax - 4 * hi - t * 64, 0x7fffffffu); }
    DI void post(f32x16& p0, f32x16& p1, int t, bool act) {
        if (!act) { carry = 0.f; return; }
        float G[8], L[8];
#pragma unroll
        for (int q = 0; q < 4; ++q) { G[q] = (p0[4 * q] + p0[4 * q + 1]) + (p0[4 * q + 2] + p0[4 * q + 3]); L[q] = p0[4 * q + 3];
                                      G[4 + q] = (p1[4 * q] + p1[4 * q + 1]) + (p1[4 * q + 2] + p1[4 * q + 3]); L[4 + q] = p1[4 * q + 3]; }
        float PL[8];
#pragma unroll
        for (int q = 0; q < 8; ++q) PL[q] = __shfl_xor(L[q], 32);
        float v[8];
        if (hi) {
#pragma unroll
            for (int q = 0; q < 8; ++q) v[q] = G[q] + PL[q];
        } else {
            v[0] = G[0] + carry;
#pragma unroll
            for (int q = 1; q < 8; ++q) v[q] = G[q] + PL[q - 1];
            carry = PL[7];
        }
#pragma unroll
        for (int q = 0; q < 8; ++q) { float s = v[q]; s += __shfl_xor(s, 1); s += __shfl_xor(s, 2);
            if ((r32 & 3) == 0) imp[(wid * 8 + (r32 >> 2)) * IMP_STRIDE + 16 * t + 2 * q + hi] = s; }
    }
};
struct SlcProb {
    const bf16* QKV; int kvh, ch, qlo, qpos, hi; const LAS unsigned* sw;
    DI int ntiles() const { return ch + 1; }
    DI void src(int t, const bf16*& k, const bf16*& v, int& kp, int& vp) const { const size_t key0 = (size_t)t * 64; k = QKV + key0 * NO + O_KSLC + kvh * 128; v = QKV + key0 * NO + O_VSLC + kvh * 128; kp = NO; vp = NO; }
    DI float extra(int) const { return 0.f; }
    DI void put_extra(int, int, float) const {}
    DI bool sel(int t) const { return (sw[t >> 5] >> (t & 31)) & 1u; }
    DI bool active(int t) const { return __any(sel(t)); }
    DI void mask(f32x16& p0, f32x16& p1, int t, int) const { if (!sel(t)) kill_tile(p0, p1); else if (t == ch) mask_tile(p0, p1, qpos - 4 * hi - t * 64, 0x7fffffffu); }
    DI void post(f32x16&, f32x16&, int, bool) const {}
};
DI float sigmoid_f(float v) { return 1.f / (1.f + expf(-v)); }
#define ZERO_O(o) do { _Pragma("unroll") for (int d_ = 0; d_ < 4; ++d_) _Pragma("unroll") for (int r_ = 0; r_ < 16; ++r_) o[d_][r_] = 0.f; } while (0)
DI void nsa_unit(LAS unsigned char* lds_, const bf16* QKV, const bf16* KC, const bf16* VC, const float* FG, bf16* O, float* scr  , int kvh, int ch) {
    const int T0 = ch * 64;
    LAS float* imp = (LAS float*)((LAS char*)lds_ + L_IMP);
    LAS unsigned short* sel16 = (LAS unsigned short*)((LAS char*)lds_ + L_SEL);
    { const int t0_ = tid_fresh(); for (int e = t0_; e < 64 * IMP_STRIDE; e += NWAVES * 64) imp[e] = 0.f; }
    for (int rep_ = 0; rep_ < ((NSA_DUP & 1) ? 2 : 1); ++rep_) {
        const Cx c = make_cx(lds_); const int tl = c.wid * 8 + (c.r32 >> 2), hq = kvh * 4 + (c.r32 & 3);
        int token = T0 + tl;
        bf16x8 qr[8]; load_q(qr, QKV, NO, token, O_QD + hq * 128, c.hi);
        f32x16 o[4]; float rc[16];
        CmpProb pr; pr.KC = KC; pr.VC = VC; pr.kvh = kvh; pr.hi = c.hi; pr.r32 = c.r32; pr.wid = c.wid; pr.imp = imp; pr.carry = 0.f;
        const int nmax_chunk = (T0 + 63 - 31) >> 4;
        pr.nt = nmax_chunk / 64 + 1; pr.nmax = (token - 31) >> 4; pr.wnmax = (T0 + c.wid * 8 + 7 - 31) >> 4;
        float m_reg = -1e30f, l_reg = 0.f; ZERO_O(o);
        run<0>(c, pr, qr, m_reg, l_reg, o);
        const float g_cmp = sigmoid_f(FG[(size_t)(8 + hq * 3 + 0) * S + token]);
        row_coefs(c, l_reg > 0.f ? g_cmp / l_reg : 0.f, rc);
        { GAS f32x4* sp = (GAS f32x4*)(scr + (size_t)c.tid * 64);
#pragma unroll
        for (int d = 0; d < 4; ++d)
#pragma unroll
            for (int q = 0; q < 4; ++q) sp[d * 4 + q] = (f32x4){o[d][4 * q] * rc[4 * q], o[d][4 * q + 1] * rc[4 * q + 1], o[d][4 * q + 2] * rc[4 * q + 2], o[d][4 * q + 3] * rc[4 * q + 3]}; }
        pr.carry = 0.f;
        run<1>(c, pr, qr, m_reg, l_reg, o);
    }
    for (int rep_ = 0; rep_ < ((NSA_DUP & 2) ? 2 : 1); ++rep_) {
        const int tf_ = tid_fresh(); const int tk = tf_ >> 3, q = tf_ & 7;
        const LAS float* row = imp + tk * IMP_STRIDE;
        int kv[16], rank[16]; const int q16 = 16 * q;
#pragma unroll
        for (int e = 0; e < 16; ++e) { const int j = q16 + e; int k = __float_as_int(row[j]); if (j == 0 || j == ch || j == ch - 1) k = 0x7f800000; if (j > ch) k = -1; kv[e] = k; rank[e] = 0; }
        for (int i0 = 0; i0 <= ch; i0 += 4) { const f32x4 xr = *(const LAS f32x4*)(row + i0);
#pragma unroll
            for (int u = 0; u < 4; ++u) { const int i = i0 + u; int k = __float_as_int(xr[u]); if (i == 0 || i == ch || i == ch - 1) k = 0x7f800000; if (i > ch) k = -1; k += (i < q16) ? 1 : 0;
#pragma unroll
                for (int e = 0; e < 16; ++e) rank[e] += (k > kv[e]) ? 1 : 0; } }
#pragma unroll
        for (int e2 = 1; e2 < 16; ++e2)
#pragma unroll
            for (int e1 = 0; e1 < e2; ++e1) rank[e2] += (kv[e1] == kv[e2]) ? 1 : 0;
        unsigned m = 0u;
#pragma unroll
        for (int e = 0; e < 16; ++e) { const int j = 16 * q + e; if (j <= ch && rank[e] < (BREAK == 9 ? 15 : 16)) m |= 1u << e; }
        sel16[tk * 8 + q] = (unsigned short)m;
    }
    __syncthreads();
    for (int rep_ = 0; rep_ < ((NSA_DUP & 4) ? 2 : 1); ++rep_) {
        const Cx c = make_cx(lds_); const int tl = c.wid * 8 + (c.r32 >> 2), hq = kvh * 4 + (c.r32 & 3);
        int token = T0 + tl;
        bf16x8 qr[8]; load_q(qr, QKV, NO, token, O_QD + hq * 128, c.hi);
        f32x16 o[4]; float rc[16];
        SlcProb pr; pr.QKV = QKV; pr.kvh = kvh; pr.ch = ch; pr.qlo = T0 + c.wid * 8; pr.qpos = token; pr.hi = c.hi;
        pr.sw = (const LAS unsigned*)(c.lds + L_SEL) + tl * 4;
        float m_reg = -1e30f, l_reg = 0.f; ZERO_O(o);
        run<0>(c, pr, qr, m_reg, l_reg, o);
        const float g_slc = sigmoid_f(FG[(size_t)(8 + hq * 3 + 1) * S + token]);
        row_coefs(c, l_reg > 0.f ? g_slc / l_reg : 0.f, rc);
        { GAS f32x4* sp = (GAS f32x4*)(scr + 32768 + (size_t)c.tid * 64);
#pragma unroll
        for (int d = 0; d < 4; ++d)
#pragma unroll
            for (int q = 0; q < 4; ++q) sp[d * 4 + q] = (f32x4){o[d][4 * q] * rc[4 * q], o[d][4 * q + 1] * rc[4 * q + 1], o[d][4 * q + 2] * rc[4 * q + 2], o[d][4 * q + 3] * rc[4 * q + 3]}; }
    }
    for (int rep_ = 0; rep_ < ((NSA_DUP & 8) ? 2 : 1); ++rep_) {
        const Cx c = make_cx(lds_); const int tl = c.wid * 8 + (c.r32 >> 2), hq = kvh * 4 + (c.r32 & 3);
        int token = T0 + tl;
        bf16x8 qr[8]; load_q(qr, QKV, NO, token, O_QD + hq * 128, c.hi);
        f32x16 o[4]; float rc[16];
        WinProb pr; pr.QKV = QKV; pr.pitch = NO; pr.kcol = O_KWIN + kvh * 128; pr.vcol = O_VWIN + kvh * 128; pr.t0 = ch >= 8 ? ch - 8 : 0; pr.nt = ch + 1 - pr.t0;
        pr.qlo = T0 + c.wid * 8; pr.qpos = token; pr.hi = c.hi; pr.W = 512u;
        float m_reg = -1e30f, l_reg = 0.f; ZERO_O(o);
        run<0>(c, pr, qr, m_reg, l_reg, o);
        const float g_win = sigmoid_f(FG[(size_t)(8 + hq * 3 + 2) * S + token]);
        row_coefs(c, l_reg > 0.f ? g_win / l_reg : 0.f, rc);
        { const GAS f32x4* s0 = (const GAS f32x4*)(scr + (size_t)c.tid * 64); const GAS f32x4* s1 = (const GAS f32x4*)(scr + 32768 + (size_t)c.tid * 64);
#pragma unroll
        for (int d = 0; d < 4; ++d) {
#pragma unroll
            for (int q = 0; q < 4; ++q) { const f32x4 x = s0[d * 4 + q] + s1[d * 4 + q];
#pragma unroll
                for (int e = 0; e < 4; ++e) o[d][4 * q + e] = o[d][4 * q + e] * rc[4 * q + e] + x[e]; }
            asm volatile("" ::: "memory"); } }
#pragma unroll
        for (int r = 0; r < 16; ++r) rc[r] = 1.f;
        store_o<true>(c, o, rc, O, T0 + c.wid * 8, 1024 + kvh * 512);
    }
}
}

#if defined(CHECK) && CHECK
namespace chk {
constexpr int CW_CHK = 12288;
DI float wmax(float v) {
#pragma unroll
    for (int o = 1; o < 64; o <<= 1) v = fmaxf(v, __shfl_xor(v, o));
    return v; }
DI float wsum(float v) {
#pragma unroll
    for (int o = 1; o < 64; o <<= 1) v += __shfl_xor(v, o);
    return v; }
DI float ldbf(const bf16* p) { return bf2f((unsigned)*p); }
DI int sample_token(int i) {
    const int fixed[40] = {0, 1, 2, 15, 16, 30, 31, 32, 46, 47, 48, 63, 64, 65, 95, 126, 127, 128, 129, 191, 255, 256, 257, 300, 511, 512, 513, 767, 1023, 1024, 1025, 2047, 2048, 4095, 4096, 4097, 6000, 8000, 8190, 8191};
    if (i < 40) return fixed[i];
    return (int)(((unsigned)i * 2654435761u) >> 19) & 8191; }
DI void report(gu32* ctl, int id, bool bad, int lane) { if (bad && lane == 0) __hip_atomic_fetch_add(ctl + CW_CHK + id, 1u, RLX_AGENT); }

DI float dot128(const unsigned* qp, const bf16* krow) {
    float acc = 0.f;
#pragma unroll
    for (int i = 0; i < 16; ++i) { const v4u w = *(const GAS v4u*)(krow + 8 * i);
        acc += bf2f(qp[4 * i] & 0xffffu) * bf2f(w.x & 0xffffu) + bf2f(qp[4 * i] >> 16) * bf2f(w.x >> 16);
        acc += bf2f(qp[4 * i + 1] & 0xffffu) * bf2f(w.y & 0xffffu) + bf2f(qp[4 * i + 1] >> 16) * bf2f(w.y >> 16);
        acc += bf2f(qp[4 * i + 2] & 0xffffu) * bf2f(w.z & 0xffffu) + bf2f(qp[4 * i + 2] >> 16) * bf2f(w.z >> 16);
        acc += bf2f(qp[4 * i + 3] & 0xffffu) * bf2f(w.w & 0xffffu) + bf2f(qp[4 * i + 3] >> 16) * bf2f(w.w >> 16); }
    return acc; }
template <class Vis>
DI void naive_attn(const unsigned* qp, const bf16* K, int kpitch, const bf16* V, int vpitch, int s_lo, int s_hi, Vis vis, float sink, int lane, float& o0, float& o1) {
    const float NEG = -__builtin_inff();
    float m = sink;
    for (int s0 = s_lo; s0 <= s_hi; s0 += 64) { const int s = s0 + lane; float lg = NEG;
        if (s <= s_hi) { const float b = vis(s); if (b > NEG) lg = dot128(qp, K + (size_t)s * kpitch) * att::SCALE + b; }
        m = fmaxf(m, wmax(lg)); }
    float l = 0.f, a0 = 0.f, a1 = 0.f;
    if (m > NEG) {
        if (sink > NEG) l = expf(sink - m);
        for (int s0 = s_lo; s0 <= s_hi; s0 += 64) { const int s = s0 + lane; float p = 0.f;
            if (s <= s_hi) { const float b = vis(s); if (b > NEG) p = expf(dot128(qp, K + (size_t)s * kpitch) * att::SCALE + b - m); }
            l += wsum(p);
            const int nk = (s_hi - s0 + 1) < 64 ? (s_hi - s0 + 1) : 64;
            for (int k = 0; k < nk; ++k) { const float pk = __shfl(p, k); if (pk != 0.f) { const unsigned w = *(const GAS unsigned*)(V + (size_t)(s0 + k) * vpitch + 2 * lane); a0 += pk * bf2f(w & 0xffffu); a1 += pk * bf2f(w >> 16); } } }
    }
    const float inv = l > 0.f ? 1.f / l : 0.f; o0 = a0 * inv; o1 = a1 * inv; }
DI void load_qp(unsigned* qp, const bf16* qrow) {
#pragma unroll
    for (int i = 0; i < 16; ++i) { const v4u w = *(const GAS v4u*)(qrow + 8 * i); qp[4 * i] = w.x; qp[4 * i + 1] = w.y; qp[4 * i + 2] = w.z; qp[4 * i + 3] = w.w; } }
DI bool cmp_out(float o0, float o1, const bf16* orow, int lane) {
    const unsigned w = *(const GAS unsigned*)(orow + 2 * lane); const float f0 = bf2f(w & 0xffffu), f1 = bf2f(w >> 16);
    const float d = wmax(fmaxf(fabsf(f0 - o0), fabsf(f1 - o1))), sc = wmax(fmaxf(fabsf(o0), fabsf(o1)));
    return !(d <= 0.012f * sc + 2e-5f); }

__global__ void __launch_bounds__(256) chk_inproj(Args a, int l) {
    const int lane = threadIdx.x & 63, gw = (blockIdx.x * 256 + threadIdx.x) >> 6, nw = gridDim.x * 4; const bool odd = l & 1; const int j = l >> 1;
    gu32* ctl = (gu32*)(a.ws + WS_CTL); const bf16* QKV = (const bf16*)(a.ws + WS_QKV); const float* FG = (const float*)(a.ws + WS_FG);
    const int N = odd ? NO : NE, NS = odd ? NO_SRC : NE; const float* W = odd ? a.odd_w_in + (size_t)j * DM * NO_SRC : a.even_w_in + (size_t)j * DM * NE;
    for (int smp = gw; smp < 6000; smp += nw) {
        const int t = sample_token(smp % 97), nd = (int)(((unsigned)smp * 2246822519u) >> 8) % (odd ? 5664 : NE);
        const int sec_rope = odd ? ((nd >= O_QD && nd < O_VCMP) || (nd >= O_KSLC && nd < O_VSLC) || (nd >= O_KWIN && nd < O_VWIN)) : (nd < E_VA || (nd >= E_QB && nd < E_VB));
        const int d = nd & 127, ndp = sec_rope ? (d < 64 ? nd + 64 : nd - 64) : nd;
        const int sc0 = odd ? odd_src_col(nd) : nd, sc1 = odd ? odd_src_col(ndp) : ndp;
        const bf16* xr = (const bf16*)(a.ws + WS_H) + (size_t)t * DM; const float* mods = (const float*)(a.ws + WS_MODS) + (size_t)l * 6 * DM;
        float sq = 0.f; for (int k = lane; k < DM; k += 64) sq += ldbf(xr + k) * ldbf(xr + k);
        const float rstd = 1.f / sqrtf(wsum(sq) * (1.f / DM) + NORM_EPS);
        float s0 = 0.f, s1 = 0.f;
        for (int k = lane; k < DM; k += 64) { const float h = ldbf(xr + k) * rstd * mods[DM + k] + mods[k]; s0 += h * W[(size_t)k * NS + sc0]; s1 += h * W[(size_t)k * NS + sc1]; }
        s0 = wsum(s0); s1 = wsum(s1);
        float ref = s0;
        if (sec_rope) { const int dd = d & 63; const float inv = 1.0f / powf(10000.0f, (float)dd / 64.0f); const float ang = (float)t * inv; const float cv = cosf(ang), sv = sinf(ang);
            ref = (d < 64) ? s0 * cv - s1 * sv : s1 * sv + s0 * cv; }
        float got;
        if (odd && nd >= O_FG) got = FG[(size_t)(nd - O_FG) * S + t]; else got = ldbf(QKV + (size_t)t * N + nd);
        report(ctl, 1 + (odd ? 1 : 0), !(fabsf(got - ref) <= 0.03f * (fabsf(ref) + 0.3f)), lane);
    }
}
__global__ void __launch_bounds__(256) chk_prep(Args a, int l) {
    const int lane = threadIdx.x & 63, gw = (blockIdx.x * 256 + threadIdx.x) >> 6, nw = gridDim.x * 4; const bool odd = l & 1; const int j = l >> 1;
    gu32* ctl = (gu32*)(a.ws + WS_CTL); const bf16* QKV = (const bf16*)(a.ws + WS_QKV);
    if (!odd) {
        const bf16* KMH = (const bf16*)(a.ws + WS_KMH); const bf16* KML = (const bf16*)(a.ws + WS_KML);
        for (int u = gw; u < 256; u += nw) { const int h = u >> 5, blk = u & 31; float s0 = 0.f, s1 = 0.f;
            for (int k = 0; k < 256; ++k) { const unsigned w = *(const GAS unsigned*)(QKV + (size_t)(blk * 256 + k) * NE + E_KA + h * 128 + 2 * lane); s0 += bf2f(w & 0xffffu); s1 += bf2f(w >> 16); }
            s0 *= (1.f / 256.f); s1 *= (1.f / 256.f);
            const float g0 = ldbf(KMH + (size_t)u * 128 + 2 * lane) + ldbf(KML + (size_t)u * 128 + 2 * lane), g1 = ldbf(KMH + (size_t)u * 128 + 2 * lane + 1) + ldbf(KML + (size_t)u * 128 + 2 * lane + 1);
            const float dd = wmax(fmaxf(fabsf(g0 - s0), fabsf(g1 - s1)));
            report(ctl, 3, !(dd <= 3e-5f), lane); }
    } else {
        const float* FG = (const float*)(a.ws + WS_FG); const float* CUM = (const float*)(a.ws + WS_CUM);
        if (gw < 8) { const int h = gw;
            bool bad = false;
            if (lane == 0) { double run = 0.0; const float fb = a.fox_forget_b[j * 8 + h];
                for (int t = 0; t < S; ++t) { const double x = (double)FG[(size_t)h * S + t] + (double)fb; run += (x < 0 ? x - log1p(exp(x)) : -log1p(exp(-x)));
                    if (!(fabs((double)CUM[(size_t)h * S + t] - run) <= 2e-3 + 1e-5 * fabs(run))) bad = true; } }
            report(ctl, 4, __any(bad), lane); }
        for (int smp = gw; smp < 8 + 600; smp += nw) { if (smp < 8) continue;
            const int q = smp - 8, kind = q & 1, hd = (q >> 1) & 1, n = (q < 40) ? (q < 20 ? (q >> 2) : 510 - ((q - 20) >> 2)) : (int)(((unsigned)q * 2654435761u) >> 20) % NCMP;
            const int srccol = (kind ? O_VCMP : O_KCMP) + hd * 128;
            const float* pos = (kind ? a.nsa_v_pos : a.nsa_k_pos) + (size_t)j * 32 * 128; const float* w1 = (kind ? a.nsa_v_w1 : a.nsa_k_w1) + (size_t)j * 4096 * 128; const float* w2 = (kind ? a.nsa_v_w2 : a.nsa_k_w2) + (size_t)j * 128 * 128;
            float h0 = 0.f, h1 = 0.f;
            for (int k = 0; k < 4096; ++k) { const int ll = k >> 7, d = k & 127; const float x = ldbf(QKV + (size_t)(16 * n + ll) * NO + srccol + d) + pos[ll * 128 + d]; h0 += x * w1[(size_t)k * 128 + lane]; h1 += x * w1[(size_t)k * 128 + lane + 64]; }
            h0 = gelu_tanh_f(h0); h1 = gelu_tanh_f(h1);
            float o0 = 0.f, o1 = 0.f;
            for (int c = 0; c < 128; ++c) { const float hv = __shfl(c < 64 ? h0 : h1, c & 63); o0 += hv * w2[c * 128 + lane]; o1 += hv * w2[c * 128 + lane + 64]; }
            const bf16* dst = (const bf16*)(a.ws + (kind ? WS_VC : WS_KC)) + (size_t)n * 256 + hd * 128;
            const float f0 = ldbf(dst + lane), f1 = ldbf(dst + lane + 64);
            const float dd = wmax(fmaxf(fabsf(f0 - o0), fabsf(f1 - o1))), sc = wmax(fmaxf(fabsf(o0), fabsf(o1)));
            report(ctl, 5, !(dd <= 0.03f * sc + 1e-3f), lane); }
    }
}
__global__ void __launch_bounds__(256) chk_attn(Args a, int l) {
    __shared__ float imp_s[4][128]; __shared__ unsigned sel_s[4][4];
    const int lane = threadIdx.x & 63, wv = threadIdx.x >> 6, gw = (blockIdx.x * 256 + threadIdx.x) >> 6, nw = gridDim.x * 4; const bool odd = l & 1; const int j = l >> 1;
    gu32* ctl = (gu32*)(a.ws + WS_CTL); const bf16* QKV = (const bf16*)(a.ws + WS_QKV); const bf16* OB = (const bf16*)(a.ws + WS_O);
    const float NEG = -__builtin_inff();
    unsigned qp[64];
    if (!odd) {
        const bf16* KMH = (const bf16*)(a.ws + WS_KMH); const bf16* KML = (const bf16*)(a.ws + WS_KML);
        for (int smp = gw; smp < 1600; smp += nw) {
            const int t = sample_token(smp >> 3), h = smp & 7;
            {
                load_qp(qp, QKV + (size_t)t * NE + E_QA + h * 128);
                const int own = t >> 8;
                float g = NEG;
                if (lane < own) g = dot128(qp, KMH + ((size_t)h * 32 + lane) * 128) + dot128(qp, KML + ((size_t)h * 32 + lane) * 128);
                int rank = 0;
                for (int i = 0; i < 32; ++i) { const float gi = __shfl(g, i); rank += (gi > g || (gi == g && i < lane)) ? 1 : 0; }
                const unsigned long long bal = __ballot(lane < own && rank < 3);
                const unsigned selm = (unsigned)bal;
                float o0, o1;
                naive_attn(qp, QKV + E_KA + h * 128, NE, QKV + E_VA + h * 128, NE, 0, t, [&](int s) { const int b = s >> 8; return (b == own || ((selm >> b) & 1u)) ? 0.f : NEG; }, NEG, lane, o0, o1);
                report(ctl, 6, cmp_out(o0, o1, OB + (size_t)t * DM + h * 128, lane), lane);
            }
            {
                load_qp(qp, QKV + (size_t)t * NE + E_QB + h * 128);
                float o0, o1; const int lo = t - 127 > 0 ? t - 127 : 0;
                naive_attn(qp, QKV + E_KB + (h >> 2) * 128, NE, QKV + E_VB + (h >> 2) * 128, NE, lo, t, [&](int) { return 0.f; }, a.even_sinks[j * 8 + h], lane, o0, o1);
                report(ctl, 7, cmp_out(o0, o1, OB + (size_t)t * DM + 1024 + h * 128, lane), lane);
            }
        }
    } else {
        const float* CUM = (const float*)(a.ws + WS_CUM); const float* FG = (const float*)(a.ws + WS_FG);
        const bf16* KC = (const bf16*)(a.ws + WS_KC); const bf16* VC = (const bf16*)(a.ws + WS_VC);
        for (int smp = gw; smp < 1600; smp += nw) {
            const int t = sample_token(smp >> 3), h = smp & 7;
            {
                load_qp(qp, QKV + (size_t)t * NO + O_QC + h * 128);
                const float* ch = CUM + (size_t)h * S; const float ct = ch[t];
                float o0, o1;
                naive_attn(qp, QKV + O_KC + h * 128, NO, QKV + O_VC + h * 128, NO, 0, t, [&](int s) { return ct - ch[s]; }, NEG, lane, o0, o1);
                report(ctl, 8, cmp_out(o0, o1, OB + (size_t)t * DM + h * 128, lane), lane);
            }
            {
                const int kvh = h >> 2, cur = t >> 6, nmax = (t - 31) >> 4;
                for (int i = lane; i < 128; i += 64) imp_s[wv][i] = 0.f;
                __builtin_amdgcn_wave_barrier();
                for (int g = 0; g < 4; ++g) {
                    load_qp(qp, QKV + (size_t)t * NO + O_QD + (kvh * 4 + g) * 128);
                    float lg[8]; float m = NEG;
#pragma unroll
                    for (int i = 0; i < 8; ++i) { const int n = lane + 64 * i; lg[i] = (n <= nmax) ? dot128(qp, KC + (size_t)n * 256 + kvh * 128) * att::SCALE : NEG; m = fmaxf(m, lg[i]); }
                    m = wmax(m);
                    if (m > NEG) { float ls = 0.f;
#pragma unroll
                        for (int i = 0; i < 8; ++i) { lg[i] = (lg[i] > NEG) ? expf(lg[i] - m) : 0.f; ls += lg[i]; }
                        ls = wsum(ls);
#pragma unroll
                        for (int i = 0; i < 8; ++i) { const int n = lane + 64 * i; const float p = lg[i] / ls;
                            if (p != 0.f) { atomicAdd(&imp_s[wv][n >> 2], p); if ((n & 3) == 3 && (n >> 2) + 1 < 128) atomicAdd(&imp_s[wv][(n >> 2) + 1], p); } } }
                }
                __builtin_amdgcn_wave_barrier();
                asm volatile("s_waitcnt lgkmcnt(0)" ::: "memory");
                float v0, v1; { const int j0 = lane, j1 = lane + 64; v0 = imp_s[wv][j0]; v1 = imp_s[wv][j1];
                    if (j0 == 0 || j0 == cur || j0 == cur - 1) v0 = __builtin_inff(); if (j0 > cur) v0 = NEG;
                    if (j1 == 0 || j1 == cur || j1 == cur - 1) v1 = __builtin_inff(); if (j1 > cur) v1 = NEG; }
                int r0 = 0, r1 = 0;
                for (int i = 0; i < 128; ++i) { const float x = __shfl(i < 64 ? v0 : v1, i & 63); r0 += (x > v0 || (x == v0 && i < lane)) ? 1 : 0; r1 += (x > v1 || (x == v1 && i < lane + 64)) ? 1 : 0; }
                const unsigned long long b0 = __ballot(r0 < 16 && lane <= cur), b1 = __ballot(r1 < 16 && lane + 64 <= cur);
                if (lane == 0) { sel_s[wv][0] = (unsigned)b0; sel_s[wv][1] = (unsigned)(b0 >> 32); sel_s[wv][2] = (unsigned)b1; sel_s[wv][3] = (unsigned)(b1 >> 32); }
                __builtin_amdgcn_wave_barrier();
                asm volatile("s_waitcnt lgkmcnt(0)" ::: "memory");
                const unsigned m0 = sel_s[wv][0], m1 = sel_s[wv][1], m2 = sel_s[wv][2], m3 = sel_s[wv][3];
                load_qp(qp, QKV + (size_t)t * NO + O_QD + h * 128);
                float c0, c1, s0, s1, w0, w1;
                naive_attn(qp, KC + kvh * 128, 256, VC + kvh * 128, 256, 0, nmax, [&](int) { return 0.f; }, NEG, lane, c0, c1);
                naive_attn(qp, QKV + O_KSLC + kvh * 128, NO, QKV + O_VSLC + kvh * 128, NO, 0, t, [&](int s) { const int b = s >> 6; const unsigned mm = (b < 32) ? m0 : (b < 64 ? m1 : (b < 96 ? m2 : m3)); return ((mm >> (b & 31)) & 1u) ? 0.f : NEG; }, NEG, lane, s0, s1);
                const int lo = t - 511 > 0 ? t - 511 : 0;
                naive_attn(qp, QKV + O_KWIN + kvh * 128, NO, QKV + O_VWIN + kvh * 128, NO, lo, t, [&](int) { return 0.f; }, NEG, lane, w0, w1);
                const float* gp = FG + (size_t)(8 + h * 3) * S + t; const float g0 = att::sigmoid_f(gp[0]), g1 = att::sigmoid_f(gp[S]), g2 = att::sigmoid_f(gp[2 * S]);
                report(ctl, 9, cmp_out(g0 * c0 + g1 * s0 + g2 * w0, g0 * c1 + g1 * s1 + g2 * w1, OB + (size_t)t * DM + 1024 + h * 128, lane), lane);
            }
        }
    }
}
__global__ void chk_poison(Args a) {
    if (threadIdx.x != 0 || blockIdx.x != 0) return;
    gu32* ctl = (gu32*)(a.ws + WS_CTL);
    const unsigned allow[10] = {0, 0, 0, 0, 0, 0, 3, 0, 0, 3};
    for (int k = 1; k <= 9; ++k) if (__hip_atomic_load(ctl + CW_CHK + k, RLX_AGENT) > allow[k]) { a.out[0] = 16.f * (float)k; return; }
}
}
#endif

#ifndef MK_PER_PHASE
#define MK_PER_PHASE 0
#endif
constexpr int PH_PER_LAYER = 10, N_PHASES = 2 + 4 * PH_PER_LAYER;
#ifndef DUP_MASK
#define DUP_MASK 0
#endif
#define DUP(b) ((DUP_MASK >> (b)) & 1)
#ifndef ODD_NSPLIT
#define ODD_NSPLIT 64
#endif
#ifndef EVEN_SPLIT
#define EVEN_SPLIT 1
#endif
#ifndef STAG_UP
#define STAG_UP 0
#endif
#ifndef STAG_IN
#define STAG_IN 0
#endif
#ifndef STAG_OD
#define STAG_OD 0
#endif
__device__ __forceinline__ void stagger_start(int step_ns) {
    if (step_ns > 0) { const unsigned g = (blockIdx.x >> 3) & 3u; const unsigned long long ticks = (unsigned long long)(g * (unsigned)step_ns / 10u);
        if (ticks) { const unsigned long long t0 = __builtin_amdgcn_s_memrealtime(); while (__builtin_amdgcn_s_memrealtime() - t0 < ticks) __builtin_amdgcn_s_sleep(2); } }
}

__global__ void __launch_bounds__(NWAVES * 64, 2) fwd(Args a_unused) {
    extern __shared__ __attribute__((aligned(16))) unsigned char lds_raw[];
    LAS unsigned char* const lds = (LAS unsigned char*)lds_raw;
    volatile LAS unsigned* MISC = (volatile LAS unsigned*)(lds + MISC_OFF);
    { const int t0 = tid_fresh(); for (int u = t0; u < (LDS_BYTES - LDSCTL_OFF) / 4; u += NWAVES * 64) ((LAS unsigned*)(lds + LDSCTL_OFF))[u] = 0u; }
    __syncthreads();
    int lo, hi; { KA a = kargs(); lo = a->ph_lo; hi = a->ph_hi; }
    XcdBarrier bar; { KA a = kargs(); bar.bar = (unsigned*)((gu32*)(a->ws + WS_CTL) + CW_BAR); bar.x = 0; bar.st = nullptr;
        if (hi - lo > 1) bar = xcd_barrier_post(bar.bar, MISC + 8); }
#define IN(k) (lo <= (k) && (k) < hi)
#define SEAM(k) do { if (IN(k) && IN((k) + 1)) { xcd_barrier(bar); if (DUP(12)) xcd_barrier(bar); } } while (0)
#define DEQUEUE(idx, qhead, qslot) do { if (tid_fresh() == 0) *(qslot) = (int)__hip_atomic_fetch_add((qhead), 1u, RLX_AGENT); __syncthreads(); idx = *(qslot); __syncthreads(); } while (0)

    if (IN(0)) { if (DUP(0)) { { const Ctx C = make_ctx(lds); p0_ada(kargs(), C); } xcd_barrier(bar); }
        { const Ctx C = make_ctx(lds); p0_ada(kargs(), C); } SEAM(0); }

    for (int l = 0; l < DEPTH; ++l) {
        const int pb = 1 + PH_PER_LAYER * l, j = l >> 1; const bool odd = l & 1;
        if (IN(pb + 0) && l == 0) { KA a = kargs(); unsigned char* ws = a->ws; const Ctx C = make_ctx(lds);
            if (DUP(1)) { p0_convert(a, C); resid_init_phase(C, a->x, (bf16*)(ws + WS_H), (float*)(ws + WS_SS)); xcd_barrier(bar); }
            p0_convert(a, C); resid_init_phase(C, a->x, (bf16*)(ws + WS_H), (float*)(ws + WS_SS)); SEAM(pb + 0); }
        if (IN(pb + 1)) {
            KA a = kargs(); unsigned char* ws = a->ws;
            const int N = odd ? NO : NE;
            pg8::Gemm g{(const bf16*)(ws + WS_H), (const bf16*)(ws + WS_W + (size_t)l * W_LAYER + W_IN), S, N, DM}; pg8::StaticOrder So; So.init(S, N, (int)gridDim.x, (int)blockIdx.x);
            LAS float* etab = (LAS float*)(lds + EPITAB_OFF);
            const float* ssp = (const float*)(ws + WS_SS); const float* bip = bpart_of(ws, l, 0);
            pg8::EpiIn E{(bf16*)(ws + WS_QKV), N, (float*)(ws + WS_FG), odd ? 1 : 0, etab};
            if ((DUP(2) && !odd) || (DUP(3) && odd)) { pg8::epi_preload(So, ssp, bip, etab); pg8::gemm_phase<pg8::EpiIn, pg8::StaticOrder, true, true>(lds + RING_OFF, g, So, E); xcd_barrier(bar); }
            if (odd || !EVEN_SPLIT) { pg8::epi_preload(So, ssp, bip, etab); pg8::gemm_phase<pg8::EpiIn, pg8::StaticOrder, true, true>(lds + RING_OFF, g, So, E); }
            else {
                pg8::MapOrder Mo; Mo.init(S, 16, (int)gridDim.x, (int)blockIdx.x, 10, 2);
                pg8::epi_preload(Mo, ssp, bip, etab);
                pg8::gemm_phase<pg8::EpiIn, pg8::MapOrder, true, true>(lds + RING_OFF, g, Mo, E); }
            SEAM(pb + 1);
        }
        if (IN(pb + 2)) {
            KA a = kargs(); unsigned char* ws = a->ws; const Ctx C = make_ctx(lds);
            if (DUP(4) || (DUP(13) && !odd) || (DUP(14) && odd)) { if (!odd) kmean_phase(C, (const bf16*)(ws + WS_QKV), (bf16*)(ws + WS_KMH), (bf16*)(ws + WS_KML)); else oddprep_phase(a, C, j); xcd_barrier(bar); }
            if (!odd) kmean_phase(C, (const bf16*)(ws + WS_QKV), (bf16*)(ws + WS_KMH), (bf16*)(ws + WS_KML));
            else oddprep_phase(a, C, j);
            SEAM(pb + 2);
        }
        const int nrep = ((DUP(5) && !odd) || (DUP(6) && odd)) ? 2 : 1;
        for (int rep = 0; rep < nrep; ++rep) {
        if (IN(pb + 3)) {
            KA a = kargs(); unsigned char* ws = a->ws;
            const bf16* QKV = (const bf16*)(ws + WS_QKV); bf16* OB = (bf16*)(ws + WS_O);
            LAS unsigned char* const alds = lds + RING_OFF;
            LAS int* qslot = (LAS int*)(lds + RING_OFF + 133120 + 1536);
            gu32* qhead = (gu32*)(ws + WS_CTL) + CW_Q + 64 * (l * 4 + rep);
            const int nhost = (int)gridDim.x < 64 ? (int)gridDim.x : 64;
            if (!odd && EVEN_SPLIT && (int)blockIdx.x < nhost) {
                pg8::Gemm g{(const bf16*)(ws + WS_H), (const bf16*)(ws + WS_W + (size_t)l * W_LAYER + W_IN), S, NE, DM};
                LAS float* etab = (LAS float*)(lds + EPITAB_OFF);
                pg8::EpiIn E{(bf16*)(ws + WS_QKV), NE, (float*)(ws + WS_FG), 0, etab};
                pg8::MapOrder Mo; Mo.init(S, 2, nhost, (int)blockIdx.x, 0, 10);
                pg8::epi_preload(Mo, (const float*)(ws + WS_SS), bpart_of(ws, l, 0), etab);
                pg8::gemm_phase<pg8::EpiIn, pg8::MapOrder, true, true>(lds + RING_OFF, g, Mo, E);
                __syncthreads(); }
            gu32* fhead = (gu32*)(ws + WS_CTL) + CW_Q + 64 * (16 + l * 4 + rep);
            const int fwhich = odd ? 2 : 0; bool fmore = true;
            for (int it = 0;; ++it) {
                int idx;
                DEQUEUE(idx, qhead, qslot);
                if (idx >= 512) break;
                if (!odd) {
                    if (idx < 256) att::moba_gate_unit(alds, QKV, (const bf16*)(ws + WS_KMH), (const bf16*)(ws + WS_KML), (gu32*)(ws + WS_CTL) + CW_MCNT + 256 * (l + 4 * rep), (unsigned*)(ws + WS_MLIST), idx & 7, 31 - (idx >> 3));
                    else { const int i = idx - 256; att::swa_unit(alds, QKV, a->even_sinks + j * 8, OB, i & 1, i >> 1); }
                } else {
                    constexpr int NSPLIT = ODD_NSPLIT, NA = 2 * (128 - NSPLIT);
                    const bool is_nsa = idx < NA || idx >= NA + 256; const int i = idx < NA ? idx : idx - NA - 256, kvh = i & 1, ch = (idx < NA ? 127 : NSPLIT - 1) - (i >> 1);
                    const int fi = idx - NA, fh = fi & 7, fqb = 31 - (fi >> 3);
                    if (is_nsa) { if (DUP(11)) att::nsa_unit(alds, QKV, (const bf16*)(ws + WS_KC), (const bf16*)(ws + WS_VC), (const float*)(ws + WS_FG), OB, (float*)(ws + WS_NSASCR) + (size_t)blockIdx.x * 65536, kvh, ch);
                        att::nsa_unit(alds, QKV, (const bf16*)(ws + WS_KC), (const bf16*)(ws + WS_VC), (const float*)(ws + WS_FG), OB, (float*)(ws + WS_NSASCR) + (size_t)blockIdx.x * 65536, kvh, ch); }
                    else { if (DUP(10)) att::fox_unit(alds, QKV, (const float*)(ws + WS_CUM), (const float*)((const gu32*)(ws + WS_CTL) + CW_FOXN + 16 * j), OB, fh, fqb);
                        att::fox_unit(alds, QKV, (const float*)(ws + WS_CUM), (const float*)((const gu32*)(ws + WS_CTL) + CW_FOXN + 16 * j), OB, fh, fqb); }
                }
            }
            while (fmore) { int fi; DEQUEUE(fi, fhead, qslot); fmore = tail_item(a, ws, lds, l, fwhich, fi); __syncthreads(); }
            if (!odd) SEAM(pb + 3);
        }
        if (IN(pb + 4) && !odd) {
            KA a = kargs(); unsigned char* ws = a->ws;
            const bf16* QKV = (const bf16*)(ws + WS_QKV);
            LAS unsigned char* const alds = lds + RING_OFF;
            LAS int* qslot = (LAS int*)(lds + RING_OFF + 133120 + 1536);
            LAS int* pre = (LAS int*)(lds + RING_OFF + 133120);
            const gu32* cnt = (const gu32*)(ws + WS_CTL) + CW_MCNT + 256 * (l + 4 * rep);
            { const int tid = tid_fresh(), lane = tid & 63, wv = tid >> 6;
                const int nt = tid < 256 ? (int)((cnt[tid] + 255u) >> 8) : 0; int sc = nt;
#pragma unroll
                for (int o = 1; o < 64; o <<= 1) { const int n = __shfl_up(sc, o); if (lane >= o) sc += n; }
                if (tid < 256 && lane == 63) pre[260 + wv] = sc;
                __syncthreads();
                int base = 0; for (int w = 0; w < wv && w < 4; ++w) base += pre[260 + w];
                if (tid < 256) pre[tid + 1] = base + sc;
                if (tid == 0) pre[0] = 0;
                __syncthreads(); }
            const int total = 256 + pre[256];
            gu32* qhead = (gu32*)(ws + WS_CTL) + CW_Q + 64 * (l * 4 + 2 + rep);
            gu32* fhead = (gu32*)(ws + WS_CTL) + CW_Q + 64 * (16 + l * 4 + 2 + rep); bool fmore = true;
            for (int it = 0;; ++it) {
                int idx; DEQUEUE(idx, qhead, qslot);
                if (idx >= total) break;
                int h, jb, r;
                if (idx < 256) { h = idx & 7; jb = idx >> 3; r = -1; }
                else { const int g = idx - 256; int b0 = 0, b1 = 256; while (b1 - b0 > 1) { const int mid = (b0 + b1) >> 1; if (pre[mid] <= g) b0 = mid; else b1 = mid; } h = b0 >> 5; jb = b0 & 31; r = g - pre[b0]; }
                att::moba_blk_unit(alds, QKV, cnt, (const unsigned*)(ws + WS_MLIST), (bf16*)(ws + WS_MPO), (float*)(ws + WS_MML), h, jb, r);
            }
            while (fmore) { int fi; DEQUEUE(fi, fhead, qslot); fmore = tail_item(a, ws, lds, l, 1, fi); __syncthreads(); }
            SEAM(pb + 4);
        }
        if (IN(pb + 5) && !odd) { KA a = kargs(); unsigned char* ws = a->ws; const Ctx C = make_ctx(lds);
            moba_combine_phase(C, (const bf16*)(ws + WS_MPO), (const float*)(ws + WS_MML), (bf16*)(ws + WS_O)); }
        if (rep + 1 < nrep) xcd_barrier(bar);
        }
        if (IN(pb + 5) && IN(pb + 6)) xcd_barrier(bar);
        if (IN(pb + 6)) {
            KA a = kargs(); unsigned char* ws = a->ws; const float* mods = (const float*)(ws + WS_MODS) + (size_t)l * 6 * DM;
            pg8::Gemm g{(const bf16*)(ws + WS_O), (const bf16*)(ws + WS_W + (size_t)l * W_LAYER + W_OUT), S, DM, DM}; pg8::StaticOrder So; So.init(S, DM, (int)gridDim.x, (int)blockIdx.x);
            pg8::EpiRes E{(bf16*)(ws + WS_H), nullptr, DM, mods + 2 * DM, (float*)(ws + WS_SS)};
            if (DUP(7)) { pg8::EpiRes E2{(bf16*)(ws + WS_U), nullptr, DM, mods + 2 * DM, (float*)(ws + WS_U) + (size_t)S * DM}; pg8::gemm_phase<pg8::EpiRes, pg8::StaticOrder, true, true>(lds + RING_OFF, g, So, E2); xcd_barrier(bar); }
            pg8::gemm_phase<pg8::EpiRes, pg8::StaticOrder, true, true>(lds + RING_OFF, g, So, E);
            SEAM(pb + 6);
        }
        if (IN(pb + 8)) {
            KA a = kargs(); unsigned char* ws = a->ws;
            pg8::Gemm g{(const bf16*)(ws + WS_H), (const bf16*)(ws + WS_W + (size_t)l * W_LAYER + W_UP), S, DFF, DM}; pg8::StaticOrder So; So.init(S, DFF, (int)gridDim.x, (int)blockIdx.x);
            LAS float* etab = (LAS float*)(lds + EPITAB_OFF);
            pg8::EpiRelu2 E{(bf16*)(ws + WS_U), DFF, etab};
            pg8::epi_preload(So, (const float*)(ws + WS_SS), bpart_of(ws, l, 1), etab);
            if (DUP(8)) { pg8::gemm_phase<pg8::EpiRelu2, pg8::StaticOrder, true, true>(lds + RING_OFF, g, So, E); xcd_barrier(bar); }
            stagger_start(STAG_UP);
            pg8::gemm_phase<pg8::EpiRelu2, pg8::StaticOrder, true, true>(lds + RING_OFF, g, So, E);
            SEAM(pb + 8);
        }
        if (IN(pb + 9)) {
            KA a = kargs(); unsigned char* ws = a->ws; const float* mods = (const float*)(ws + WS_MODS) + (size_t)l * 6 * DM;
            pg8::Gemm g{(const bf16*)(ws + WS_U), (const bf16*)(ws + WS_W + (size_t)l * W_LAYER + W_DOWN), S, DM, DFF}; pg8::StaticOrder So; So.init(S, DM, (int)gridDim.x, (int)blockIdx.x);
            pg8::EpiRes E{(bf16*)(ws + WS_H), (l + 1 < DEPTH) ? nullptr : a->out, DM, mods + 5 * DM, (l + 1 < DEPTH) ? (float*)(ws + WS_SS) : nullptr};
            if (DUP(9)) { pg8::EpiRes E2{(bf16*)(ws + WS_QKV), nullptr, DM, mods + 5 * DM, (float*)(ws + WS_QKV) + (size_t)S * DM}; pg8::gemm_phase<pg8::EpiRes, pg8::StaticOrder, true, true>(lds + RING_OFF, g, So, E2); xcd_barrier(bar); }
            pg8::gemm_phase<pg8::EpiRes, pg8::StaticOrder, true, true>(lds + RING_OFF, g, So, E);
            SEAM(pb + 9);
        }
    }
    if (IN(N_PHASES - 1)) { KA a = kargs(); const Ctx C = make_ctx(lds); final_norm_phase(C, a->out, a->final_norm_g); }
#undef IN
#undef SEAM
#undef DEQUEUE
}

extern "C" void kernel_launch(void* const* d_in, const int* in_sizes, int n_in, void* d_out, int out_size, void* d_ws, size_t ws_size, hipStream_t stream) {
    static int grid = 0;
    if (grid == 0) {
        if (n_in != 21 || in_sizes[0] != S * DM || out_size != S * DM || ws_size < WS_END) {
            fprintf(stderr, "kernel_launch: unexpected shapes (n_in %d, in0 %d, out %d, ws %zu < %zu); nothing launched\n", n_in, n_in > 0 ? in_sizes[0] : -1, out_size, ws_size, (size_t)WS_END); grid = -1; return; }
        int dev = 0, cus = 0, per_cu = 0;
        if (hipGetDevice(&dev) != hipSuccess || hipDeviceGetAttribute(&cus, hipDeviceAttributeMultiprocessorCount, dev) != hipSuccess) { fprintf(stderr, "kernel_launch: device query failed\n"); grid = -1; return; }
        if (hipFuncSetAttribute((const void*)fwd, hipFuncAttributeMaxDynamicSharedMemorySize, LDS_BYTES) != hipSuccess) { fprintf(stderr, "kernel_launch: hipFuncSetAttribute failed\n"); grid = -1; return; }
        if (hipOccupancyMaxActiveBlocksPerMultiprocessor(&per_cu, (const void*)fwd, NWAVES * 64, LDS_BYTES) != hipSuccess || per_cu < 1)
            fprintf(stderr, "kernel_launch: note: occupancy query reports %d workgroups per CU\n", per_cu);
        (void)hipGetLastError();
        grid = cus;
    }
    if (grid < 0) return;
    if (hipMemsetAsync((char*)d_ws + WS_CTL, 0, CTL_ZERO_BYTES, stream) != hipSuccess) { fprintf(stderr, "kernel_launch: memset failed\n"); return; }
    Args a{};
    const float** ap = (const float**)&a;
    for (int i = 0; i < 21; ++i) ap[i] = (const float*)d_in[i];
    a.out = (float*)d_out; a.ws = (unsigned char*)d_ws;
#if defined(CHECK) && CHECK
    for (int p = 0; p < N_PHASES; ++p) { a.ph_lo = p; a.ph_hi = p + 1; hipLaunchKernelGGL(fwd, dim3(grid), dim3(NWAVES * 64), LDS_BYTES, stream, a);
        if (p >= 1 && p < N_PHASES - 1) { const int l = (p - 1) / PH_PER_LAYER, q = (p - 1) % PH_PER_LAYER; Args b = a; b.ph_lo = 0; b.ph_hi = 0;
            if (q == 3) hipLaunchKernelGGL(chk::chk_inproj, dim3(512), dim3(256), 0, stream, b, l);
            if (q == 2) hipLaunchKernelGGL(chk::chk_prep, dim3(512), dim3(256), 0, stream, b, l);
            if (q == 5) hipLaunchKernelGGL(chk::chk_attn, dim3(512), dim3(256), 0, stream, b, l); } }
    { Args b = a; b.ph_lo = 0; b.ph_hi = 0; hipLaunchKernelGGL(chk::chk_poison, dim3(1), dim3(64), 0, stream, b); }
#elif MK_PER_PHASE
    for (int p = 0; p < N_PHASES; ++p) { a.ph_lo = p; a.ph_hi = p + 1; hipLaunchKernelGGL(fwd, dim3(grid), dim3(NWAVES * 64), LDS_BYTES, stream, a); }
#else
    a.ph_lo = 0; a.ph_hi = N_PHASES;
    hipLaunchKernelGGL(fwd, dim3(grid), dim3(NWAVES * 64), LDS_BYTES, stream, a);
#endif
    const hipError_t le = hipPeekAtLastError();
    if (le != hipSuccess) fprintf(stderr, "kernel_launch: launch failed: %s\n", hipGetErrorName(le));
}
```
